# Optimizing an MI355X kernel written in HIP

```python
import jax
import jax.numpy as jnp
from jax import lax
import numpy as np

D_MODEL = 1024
BATCH = 8
SEQ = 4096
DEPTH = 4

N_MIXERS = 3
HEAD_DIM = 64
BLOCK_Q = 128
GRID_W = 64
RMS_EPS = 1e-6
D_FF = 4 * D_MODEL
A_HEADS = D_MODEL // HEAD_DIM
A_KV_HEADS = A_HEADS // 4
ROPE_THETA = 10000.0
B_GROUPS = ((128, 1), (512, 4), (2048, 16))
B_HEADS_PER_GROUP = 6
B_KV_PER_GROUP = 2
C_HEADS = D_MODEL // HEAD_DIM
C_KV_HEADS = C_HEADS // 4
C_WINDOW = 128

kernel_name = "hybrid_interleaved_bidir_encoder"


def rmsnorm(x, gain):
    xf = x.astype(jnp.float32)
    y = xf * lax.rsqrt(jnp.mean(xf * xf, axis=-1, keepdims=True) + RMS_EPS)
    return (y * gain.astype(jnp.float32)).astype(x.dtype)


def alibi_slopes(n_heads):
    return 2.0 ** (-8.0 * jnp.arange(1, n_heads + 1, dtype=jnp.float32) / n_heads)


def stack_blocks(y, batch, seq):
    y = jnp.moveaxis(y, 0, 1)
    return y.reshape((batch, seq) + y.shape[3:])


def axial_rope_angles(seq):
    rows = seq // GRID_W
    row = jnp.repeat(jnp.arange(rows, dtype=jnp.float32), GRID_W)
    col = jnp.tile(jnp.arange(GRID_W, dtype=jnp.float32), rows)
    axis_dim = HEAD_DIM // 2
    inv_freq = ROPE_THETA ** (-jnp.arange(0, axis_dim, 2, dtype=jnp.float32) / axis_dim)
    return row[:, None] * inv_freq, col[:, None] * inv_freq


def rotate(x, ang):
    shape = (ang.shape[0],) + (1,) * (x.ndim - 3) + (ang.shape[1],)
    cos = jnp.cos(ang).reshape(shape).astype(x.dtype)
    sin = jnp.sin(ang).reshape(shape).astype(x.dtype)
    x1, x2 = jnp.split(x, 2, axis=-1)
    return jnp.concatenate([x1 * cos - x2 * sin, x2 * cos + x1 * sin], axis=-1)


def axial_rope(x, ang_row, ang_col):
    half = HEAD_DIM // 2
    return jnp.concatenate([rotate(x[..., :half], ang_row), rotate(x[..., half:], ang_col)], axis=-1)


def mixer_a(h, w_qkv, q_gain, k_gain, w_o):
    b, s, _ = h.shape
    rep = A_HEADS // A_KV_HEADS
    qkv = h @ w_qkv
    q, k, v = jnp.split(qkv, [A_HEADS * HEAD_DIM, (A_HEADS + A_KV_HEADS) * HEAD_DIM], axis=-1)
    q = rmsnorm(q.reshape(b, s, A_KV_HEADS, rep, HEAD_DIM), q_gain)
    k = rmsnorm(k.reshape(b, s, A_KV_HEADS, HEAD_DIM), k_gain)
    v = v.reshape(b, s, A_KV_HEADS, HEAD_DIM)
    ang_row, ang_col = axial_rope_angles(s)
    q = axial_rope(q, ang_row, ang_col) * (HEAD_DIM ** -0.5)
    k = axial_rope(k, ang_row, ang_col)

    def block(i):
        qb = lax.dynamic_slice_in_dim(q, i * BLOCK_Q, BLOCK_Q, axis=1)
        sc = jnp.einsum('bqhgd,bkhd->bhgqk', qb, k).astype(jnp.float32)
        p = jax.nn.softmax(sc, axis=-1).astype(v.dtype)
        o = jnp.einsum('bhgqk,bkhd->bqhgd', p, v)
        return o.reshape(b, BLOCK_Q, A_HEADS * HEAD_DIM)

    o = stack_blocks(lax.map(block, jnp.arange(s // BLOCK_Q)), b, s)
    return o @ w_o


def mixer_b(h, w_qkv, w_o):
    b, s, _ = h.shape
    n_g = len(B_GROUPS)
    rep = B_HEADS_PER_GROUP // B_KV_PER_GROUP
    nq = n_g * B_HEADS_PER_GROUP * HEAD_DIM
    nk = n_g * B_KV_PER_GROUP * HEAD_DIM
    qkv = h @ w_qkv
    q, k, v = jnp.split(qkv, [nq, nq + nk], axis=-1)
    q = q.reshape(b, s, n_g, B_KV_PER_GROUP, rep, HEAD_DIM) * (HEAD_DIM ** -0.5)
    k = k.reshape(b, s, n_g, B_KV_PER_GROUP, HEAD_DIM)
    v = v.reshape(b, s, n_g, B_KV_PER_GROUP, HEAD_DIM)
    slopes = alibi_slopes(n_g * B_HEADS_PER_GROUP).reshape(n_g, B_KV_PER_GROUP, rep)
    outs, lses = [], []
    for g, (window, dil) in enumerate(B_GROUPS):
        n_side = (window // 2) // dil
        offs = jnp.arange(-n_side, n_side + 1) * dil
        bias = -slopes[g][:, :, None, None] * jnp.abs(offs).astype(jnp.float32)
        qg, kg, vg = q[:, :, g], k[:, :, g], v[:, :, g]

        def block(i, qg=qg, kg=kg, vg=vg, offs=offs, bias=bias):
            start = i * BLOCK_Q
            idx = start + jnp.arange(BLOCK_Q)[:, None] + offs[None, :]
            valid = (idx >= 0) & (idx < s)
            idx = jnp.clip(idx, 0, s - 1)
            kb = jnp.take(kg, idx, axis=1)
            vb = jnp.take(vg, idx, axis=1)
            qb = lax.dynamic_slice_in_dim(qg, start, BLOCK_Q, axis=1)
            sc = jnp.einsum('bqhgd,bqnhd->bhgqn', qb, kb).astype(jnp.float32) + bias
            sc = jnp.where(valid, sc, -jnp.inf)
            m = jnp.max(sc, axis=-1, keepdims=True)
            p = jnp.exp(sc - m)
            den = jnp.sum(p, axis=-1, keepdims=True)
            o = jnp.einsum('bhgqn,bqnhd->bqhgd', (p / den).astype(vb.dtype), vb)
            lse = (m + jnp.log(den))[..., 0].transpose(0, 3, 1, 2)
            return o, lse

        o_g, lse_g = lax.map(block, jnp.arange(s // BLOCK_Q))
        outs.append(stack_blocks(o_g, b, s))
        lses.append(stack_blocks(lse_g, b, s))
    alpha = jax.nn.softmax(jnp.stack(lses, axis=2), axis=2)
    o = jnp.stack(outs, axis=2) * alpha[..., None].astype(h.dtype)
    return o.reshape(b, s, nq) @ w_o


def mixer_c(h, w_qkv, sinks, w_o):
    b, s, _ = h.shape
    rep = C_HEADS // C_KV_HEADS
    span = BLOCK_Q + 2 * C_WINDOW
    qkv = h @ w_qkv
    q, k, v = jnp.split(qkv, [C_HEADS * HEAD_DIM, (C_HEADS + C_KV_HEADS) * HEAD_DIM], axis=-1)
    q = q.reshape(b, s, C_KV_HEADS, rep, HEAD_DIM) * (HEAD_DIM ** -0.5)
    pad = ((0, 0), (C_WINDOW, C_WINDOW), (0, 0), (0, 0))
    kp = jnp.pad(k.reshape(b, s, C_KV_HEADS, HEAD_DIM), pad)
    vp = jnp.pad(v.reshape(b, s, C_KV_HEADS, HEAD_DIM), pad)
    slopes = alibi_slopes(C_HEADS).reshape(C_KV_HEADS, rep)[:, :, None, None]
    sink = sinks.astype(jnp.float32).reshape(1, C_KV_HEADS, rep, 1, 1)

    def block(i):
        start = i * BLOCK_Q
        qb = lax.dynamic_slice_in_dim(q, start, BLOCK_Q, axis=1)
        kb = lax.dynamic_slice_in_dim(kp, start, span, axis=1)
        vb = lax.dynamic_slice_in_dim(vp, start, span, axis=1)
        tq = start + jnp.arange(BLOCK_Q)
        tk = start - C_WINDOW + jnp.arange(span)
        dist = jnp.abs(tk[None, :] - tq[:, None])
        valid = (dist <= C_WINDOW) & (tk[None, :] >= 0) & (tk[None, :] < s)
        sc = jnp.einsum('bqhgd,bkhd->bhgqk', qb, kb).astype(jnp.float32)
        sc = jnp.where(valid, sc - slopes * dist.astype(jnp.float32), -jnp.inf)
        logits = jnp.concatenate([sc, jnp.broadcast_to(sink, sc.shape[:-1] + (1,))], axis=-1)
        p = jax.nn.softmax(logits, axis=-1)[..., :-1].astype(vb.dtype)
        o = jnp.einsum('bhgqk,bkhd->bqhgd', p, vb)
        return o.reshape(b, BLOCK_Q, C_HEADS * HEAD_DIM)

    o = stack_blocks(lax.map(block, jnp.arange(s // BLOCK_Q)), b, s)
    return o @ w_o


def squared_relu_mlp(h, w1, w2):
    u = jax.nn.relu(h @ w1)
    return (u * u) @ w2


def setup_inputs(seed: int = 0) -> dict:
    key = jax.random.key(seed)
    ks = iter(jax.random.split(key, 32))
    kinds = [i % N_MIXERS for i in range(DEPTH)]
    n_a, n_b, n_c = kinds.count(0), kinds.count(1), kinds.count(2)

    def dense(k, shape):
        return jax.random.normal(k, shape, jnp.float32) * (shape[-2] ** -0.5)

    def gain(k, shape):
        return 1.0 + 0.05 * jax.random.normal(k, shape, jnp.float32)

    a_cols = (A_HEADS + 2 * A_KV_HEADS) * HEAD_DIM
    b_q = len(B_GROUPS) * B_HEADS_PER_GROUP * HEAD_DIM
    b_cols = b_q + 2 * len(B_GROUPS) * B_KV_PER_GROUP * HEAD_DIM
    c_cols = (C_HEADS + 2 * C_KV_HEADS) * HEAD_DIM
    return {
        "x": jax.random.normal(next(ks), (BATCH, SEQ, D_MODEL), jnp.float32),
        "attn_norm": gain(next(ks), (DEPTH, D_MODEL)),
        "mlp_norm": gain(next(ks), (DEPTH, D_MODEL)),
        "a_w_qkv": dense(next(ks), (n_a, D_MODEL, a_cols)),
        "a_q_gain": gain(next(ks), (n_a, HEAD_DIM)),
        "a_k_gain": gain(next(ks), (n_a, HEAD_DIM)),
        "a_w_o": dense(next(ks), (n_a, A_HEADS * HEAD_DIM, D_MODEL)),
        "b_w_qkv": dense(next(ks), (n_b, D_MODEL, b_cols)),
        "b_w_o": dense(next(ks), (n_b, b_q, D_MODEL)),
        "c_w_qkv": dense(next(ks), (n_c, D_MODEL, c_cols)),
        "c_sinks": 0.5 * jax.random.normal(next(ks), (n_c, C_HEADS), jnp.float32),
        "c_w_o": dense(next(ks), (n_c, C_HEADS * HEAD_DIM, D_MODEL)),
        "mlp_w1": dense(next(ks), (DEPTH, D_MODEL, D_FF)),
        "mlp_w2": dense(next(ks), (DEPTH, D_FF, D_MODEL)),
        "final_norm": gain(next(ks), (D_MODEL,)),
    }


def reference(x, attn_norm, mlp_norm, a_w_qkv, a_q_gain, a_k_gain, a_w_o, b_w_qkv, b_w_o,
              c_w_qkv, c_sinks, c_w_o, mlp_w1, mlp_w2, final_norm):
    h = x
    used = [0, 0, 0]
    for layer in range(DEPTH):
        kind = layer % N_MIXERS
        j = used[kind]
        used[kind] += 1
        hn = rmsnorm(h, attn_norm[layer])
        if kind == 0:
            mix = mixer_a(hn, a_w_qkv[j], a_q_gain[j], a_k_gain[j], a_w_o[j])
        elif kind == 1:
            mix = mixer_b(hn, b_w_qkv[j], b_w_o[j])
        else:
            mix = mixer_c(hn, c_w_qkv[j], c_sinks[j], c_w_o[j])
        h = h + mix
        h = h + squared_relu_mlp(rmsnorm(h, mlp_norm[layer]), mlp_w1[layer], mlp_w2[layer])
    return rmsnorm(h, final_norm)
```

```cpp
#include <hip/hip_runtime.h>
#include <hip/hip_cooperative_groups.h>
#include <cstdio>
#include <cstdint>
namespace cg = cooperative_groups;

namespace pg8 {
#define PG8_LAS __attribute__((address_space(3)))
typedef unsigned short bf16_t;
typedef short bf16x8 __attribute__((ext_vector_type(8)));
typedef float f32x4 __attribute__((ext_vector_type(4)));
typedef unsigned u32x4 __attribute__((ext_vector_type(4)));
constexpr int BM = 256, BK = 64, HALF = 128, HTB = HALF * BK * 2  , STAGE_BYTES = 8 * HTB, NXCD = 8, WGM = 8;

__host__ __device__ __forceinline__ int lds_byte(int r, int c) { const int st = (r >> 4) * 2 + (c >> 5), rr = r & 15, cc = c & 31, ob = rr * 64 + cc * 2; return st * 1024 + (ob ^ (((ob >> 9) & 1) << 5)); }
__host__ __device__ __forceinline__ void stage_rc(int b, int& R, int& C) { const int st = b / 1024, sb = b % 1024, swz = sb ^ (((sb >> 9) & 1) << 5); R = (st >> 1) * 16 + swz / 64; C = (st & 1) * 32 + (swz % 64) / 2; }
__host__ __device__ __forceinline__ int perm32(int rho) { const int n = rho >> 4, i = rho & 15; return 8 * (i >> 2) + 4 * n + (i & 3); }

struct Unit { int pm, pn; };
struct Gemm { const bf16_t* A; const bf16_t* Bt; int M, N, K; };

struct StaticOrder {
    int nM, nN, nwg, G, c;
    __host__ __device__ void init(int M, int N, int G_, int c_) { nM = M / BM; nN = N / BM; nwg = nM * nN; G = G_; c = c_; }
    __host__ __device__ bool next(int i, Unit& u) const {
        const long L = (long)i * G + c; if (L >= nwg) return false;
        int wgid = (int)L; { const int q = nwg / NXCD, r = nwg % NXCD, xcd = wgid % NXCD, off = wgid / NXCD; wgid = (xcd < r ? xcd * (q + 1) : r * (q + 1) + (xcd - r) * q) + off; }
        const int nig = WGM * nN, gid = wgid / nig, fm = gid * WGM, gsz = (nM - fm) < WGM ? (nM - fm) : WGM;
        u.pm = fm + ((wgid % nig) % gsz); u.pn = (wgid % nig) / gsz; return true;
    }
    __device__ __forceinline__ void a_ready(const Unit&) const {}
    __device__ __forceinline__ void done(const Unit&) const {}
};

__device__ __forceinline__ unsigned cvt_pk_bf16(float lo, float hi) { unsigned r; asm volatile("v_cvt_pk_bf16_f32 %0, %1, %2" : "=v"(r) : "v"(lo), "v"(hi)); return r; }
constexpr int SEQ = 4096, NBATCH = 8, MTOK = NBATCH * SEQ, DM = 1024, DFF = 4096;
constexpr float RMS_EPS = 1e-6f;
constexpr float LOG2E = 1.4426950408889634f;
constexpr float QSCALE = 0.125f * LOG2E;
constexpr float NEG_BIG = -1.0e30f;

constexpr size_t MiB = 1u << 20;
constexpr size_t WS_SS = 0;
constexpr size_t WS_TAB = 6 * MiB;
constexpr size_t WS_LSE = 2 * MiB;
constexpr size_t WS_W = 8 * MiB;
constexpr size_t WS_HB = 96 * MiB;
constexpr size_t WS_U = 160 * MiB;
constexpr size_t WS_Q = 160 * MiB, WS_K = 232 * MiB, WS_VT = 256 * MiB, WS_O = 280 * MiB;
constexpr size_t WS_SSP = 420 * MiB;
constexpr size_t WS_END = 440 * MiB;

__device__ __forceinline__ float row_ss(const float* ssp, int row) {
    const f32x4* q = (const f32x4*)(ssp + (size_t)row * 16);
    const f32x4 a = q[0], b = q[1], c = q[2], d = q[3];
    return ((a[0] + a[1]) + (a[2] + a[3])) + ((b[0] + b[1]) + (b[2] + b[3])) + (((c[0] + c[1]) + (c[2] + c[3])) + ((d[0] + d[1]) + (d[2] + d[3])));
}
__device__ __forceinline__ int perm_key(int i) { return (i & ~12) | ((i & 4) << 1) | ((i & 8) >> 1); }

template <int KIND> struct EpiQKV {
    static constexpr bool PERM = true, AFTER_DRAIN = false;
    unsigned char* ws; int ssi; int ja;
    __device__ __forceinline__ void operator()(const f32x4 (&acc)[2][2][4][2], const Unit& u, int wr, int wc, int fr, int fq) const {
        asm volatile("" : "+v"(fr), "+v"(fq));
        asm volatile("" : "+s"(wr), "+s"(wc));
        constexpr int NQH = (KIND == 1) ? 18 : 16, NKH = (KIND == 1) ? 6 : 4;
        const int hcol = 4 * u.pn + wc;
        int type, hh;
        if (hcol < NQH) { type = 0; hh = hcol; } else if (hcol < NQH + NKH) { type = 1; hh = hcol - NQH; } else if (hcol < NQH + 2 * NKH) { type = 2; hh = hcol - NQH - NKH; } else return;
        const float* ss = (const float*)(ws + WS_SSP) + (size_t)ssi * MTOK * 16;
        const f32x4* rope = (const f32x4*)(ws + WS_TAB + 1024);
        float gn[2][8];
        if (KIND == 0) {
            const float* gsrc = (const float*)(ws + WS_TAB) + ja * 128 + ((type == 0) ? 0 : 64);
            if (type < 2) {
#pragma unroll
                for (int bj = 0; bj < 2; ++bj)
#pragma unroll
                    for (int n = 0; n < 2; ++n)
#pragma unroll
                        for (int j = 0; j < 4; ++j) gn[bj][n * 4 + j] = gsrc[32 * bj + 16 * n + 4 * fq + j];
            }
        }
        int hin = hh, g = 0;
        if (KIND == 1) { if (type == 0) { g = hh / 6; hin = hh - 6 * g; } else { g = hh >> 1; hin = hh & 1; } }
        if (KIND == 1 && g == 1) body<2>(acc, u, wr, wc, fr, fq, type, hin, g, ss, rope, gn);
        else if (KIND == 1 && g == 2) body<4>(acc, u, wr, wc, fr, fq, type, hin, g, ss, rope, gn);
        else body<0>(acc, u, wr, wc, fr, fq, type, hin, g, ss, rope, gn);
    }
    template <int gsh> __device__ __forceinline__ void body(const f32x4 (&acc)[2][2][4][2], const Unit& u, int wr, int wc, int fr, int fq, int type, int hin, int g, const float* ss, const f32x4* rope, const float (&gn)[2][8]) const {
#pragma unroll
        for (int ai = 0; ai < 2; ++ai)
#pragma unroll
            for (int m = 0; m < 4; ++m) {
                int frl = fr; asm volatile("" : "+v"(frl));
                const int row = u.pm * BM + ai * HALF + wr * 64 + m * 16 + frl;
                const int b = row >> 12, t = row & (SEQ - 1);
                const float rstd = __builtin_amdgcn_rsqf(row_ss(ss, row) * (1.0f / DM) + RMS_EPS);
                float v[2][8];
#pragma unroll
                for (int bj = 0; bj < 2; ++bj)
#pragma unroll
                    for (int n = 0; n < 2; ++n)
#pragma unroll
                        for (int j = 0; j < 4; ++j) v[bj][n * 4 + j] = acc[ai][bj][m][n][j] * rstd;
                if (KIND == 0 && type < 2) {
                    float s2 = 0.f;
#pragma unroll
                    for (int bj = 0; bj < 2; ++bj)
#pragma unroll
                        for (int e = 0; e < 8; ++e) s2 += v[bj][e] * v[bj][e];
                    s2 += __shfl_xor(s2, 16); s2 += __shfl_xor(s2, 32);
                    const float r = __builtin_amdgcn_rsqf(s2 * (1.0f / 64.0f) + RMS_EPS);
#pragma unroll
                    for (int bj = 0; bj < 2; ++bj)
#pragma unroll
                        for (int e = 0; e < 8; ++e) v[bj][e] *= r * gn[bj][e];
#pragma unroll
                    for (int bj = 0; bj < 2; ++bj) {
                        const int pos = (bj == 0) ? (t >> 6) : (t & 63);
                        const f32x4 cs0 = rope[(pos * 16 + 4 * fq) >> 1], cs1 = rope[((pos * 16 + 4 * fq) >> 1) + 1];
                        const float cc[4] = {cs0[0], cs0[2], cs1[0], cs1[2]}, sn[4] = {cs0[1], cs0[3], cs1[1], cs1[3]};
#pragma unroll
                        for (int j = 0; j < 4; ++j) {
                            const float x1 = v[bj][j], x2 = v[bj][4 + j];
                            v[bj][j] = x1 * cc[j] - x2 * sn[j]; v[bj][4 + j] = x2 * cc[j] + x1 * sn[j];
                        }
                    }
                }
                if (type == 0) {
#pragma unroll
                    for (int bj = 0; bj < 2; ++bj)
#pragma unroll
                        for (int e = 0; e < 8; ++e) v[bj][e] *= QSCALE;
                }
                const int dmask = (1 << gsh) - 1;
                const int vb = (b << gsh) + (t & dmask), idx = t >> gsh, lsh = 12 - gsh;
                if (type < 2) {
                    const int nh = (type == 0) ? ((KIND == 1) ? 6 : 16) : ((KIND == 1) ? 2 : 4);
                    unsigned char* base = ws + ((type == 0) ? WS_Q : WS_K) + ((KIND == 1) ? (size_t)g * ((size_t)NBATCH * nh * SEQ * 128) : 0);
                    const unsigned off = ((unsigned)(((vb * nh + hin) << lsh) + idx) * 64u + 8u * fq) * 2u;
#pragma unroll
                    for (int bj = 0; bj < 2; ++bj) {
                        u32x4 w; w.x = cvt_pk_bf16(v[bj][0], v[bj][1]); w.y = cvt_pk_bf16(v[bj][2], v[bj][3]); w.z = cvt_pk_bf16(v[bj][4], v[bj][5]); w.w = cvt_pk_bf16(v[bj][6], v[bj][7]);
                        *(u32x4*)(base + off + 64 * bj) = w;
                    }
                } else {
                    const int nh = (KIND == 1) ? 2 : 4;
                    unsigned char* base = ws + WS_VT + ((KIND == 1) ? (size_t)g * ((size_t)NBATCH * nh * SEQ * 128) : 0);
                    unsigned off = ((unsigned)((((vb * nh + hin) * 64 + 8 * fq) << lsh) + perm_key(idx))) * 2u;
                    const unsigned dstep = 2u << lsh;
#pragma unroll
                    for (int bj = 0; bj < 2; ++bj) {
#pragma unroll
                        for (int e = 0; e < 8; ++e) {
                            const unsigned pk = cvt_pk_bf16(v[bj][e], 0.f);
                            *(bf16_t*)(base + off) = (bf16_t)(pk & 0xffffu);
                            off += dstep;
                        }
                        off += 24u * dstep;
                    }
                }
                __builtin_amdgcn_sched_barrier(0);
            }
    }
};

struct EpiRes {
    static constexpr bool PERM = true, AFTER_DRAIN = false;
    const float* hin; float* hout; bf16_t* hb; float* ssout;
    __device__ __forceinline__ void operator()(const f32x4 (&acc)[2][2][4][2], const Unit& u, int wr, int wc, int fr, int fq) const {
#pragma unroll
        for (int ai = 0; ai < 2; ++ai)
#pragma unroll
            for (int m = 0; m < 4; ++m) {
                int frl = fr; asm volatile("" : "+v"(frl));
                const int row = u.pm * BM + ai * HALF + wr * 64 + m * 16 + frl;
                float q = 0.f;
#pragma unroll
                for (int bj = 0; bj < 2; ++bj) {
                    const unsigned o = (unsigned)(row * DM + u.pn * BM + bj * HALF + wc * 32 + 8 * fq);
                    const f32x4 a0 = *(const f32x4*)((const char*)hin + o * 4u), a1 = *(const f32x4*)((const char*)hin + o * 4u + 16);
                    const f32x4 v0 = acc[ai][bj][m][0] + a0, v1 = acc[ai][bj][m][1] + a1;
                    *(f32x4*)((char*)hout + o * 4u) = v0; *(f32x4*)((char*)hout + o * 4u + 16) = v1;
                    u32x4 w; w.x = cvt_pk_bf16(v0[0], v0[1]); w.y = cvt_pk_bf16(v0[2], v0[3]); w.z = cvt_pk_bf16(v1[0], v1[1]); w.w = cvt_pk_bf16(v1[2], v1[3]);
                    *(u32x4*)((char*)hb + o * 2u) = w;
                    q += (v0[0] * v0[0] + v0[1] * v0[1]) + (v0[2] * v0[2] + v0[3] * v0[3]) + (v1[0] * v1[0] + v1[1] * v1[1]) + (v1[2] * v1[2] + v1[3] * v1[3]);
                }
                q += __shfl_xor(q, 16); q += __shfl_xor(q, 32);
                if (fq == 0) ssout[(size_t)row * 16 + u.pn * 4 + wc] = q;
            }
    }
};

struct EpiMlp1 {
    static constexpr bool PERM = true, AFTER_DRAIN = false;
    const float* ss; bf16_t* U;
    __device__ __forceinline__ void operator()(const f32x4 (&acc)[2][2][4][2], const Unit& u, int wr, int wc, int fr, int fq) const {
#pragma unroll
        for (int ai = 0; ai < 2; ++ai)
#pragma unroll
            for (int m = 0; m < 4; ++m) {
                const int row = u.pm * BM + ai * HALF + wr * 64 + m * 16 + fr;
                const float rstd = __builtin_amdgcn_rsqf(row_ss(ss, row) * (1.0f / DM) + RMS_EPS);
#pragma unroll
                for (int bj = 0; bj < 2; ++bj) {
                    f32x4 v0 = acc[ai][bj][m][0] * rstd, v1 = acc[ai][bj][m][1] * rstd;
#pragma unroll
                    for (int j = 0; j < 4; ++j) { const float a = fmaxf(v0[j], 0.f), c = fmaxf(v1[j], 0.f); v0[j] = a * a; v1[j] = c * c; }
                    u32x4 w; w.x = cvt_pk_bf16(v0[0], v0[1]); w.y = cvt_pk_bf16(v0[2], v0[3]); w.z = cvt_pk_bf16(v1[0], v1[1]); w.w = cvt_pk_bf16(v1[2], v1[3]);
                    *(u32x4*)((char*)U + (unsigned)(row * DFF + u.pn * BM + bj * HALF + wc * 32 + 8 * fq) * 2u) = w;
                }
            }
    }
};
template <class Epi, class Sched, bool ALIGN_EPI = false, bool SP2 = false>
__device__ __forceinline__ void gemm_phase(PG8_LAS unsigned char* lds, const Gemm g, const Sched& S, const Epi& E) {
    int tid_ = threadIdx.x; asm volatile("" : "+v"(tid_));
    const int tid = tid_, wid = __builtin_amdgcn_readfirstlane(tid >> 6), lane = tid & 63, wr = wid >> 2, wc = wid & 3, fr = lane & 15, fq = lane >> 4;
    const int K = g.K, nt = K / BK;
    unsigned voffA[2], voffB[2];
#pragma unroll
    for (int i = 0; i < 2; ++i) { int R, C; stage_rc(tid * 16 + i * 8192, R, C); const int Rb = Epi::PERM ? ((R & ~31) + perm32(R & 31)) : R;
        voffA[i] = (unsigned)(R * K + C) * 2u; voffB[i] = (unsigned)(Rb * K + C) * 2u; }
    const size_t kstep = (size_t)(BK * 2);
    const size_t hstep = (size_t)HALF * K * 2;
    const size_t tstep = 2 * hstep;
    const unsigned ldsw = (unsigned)wid * 1024u;
    const int aoff = lds_byte(wr * 64 + fr, fq * 8), boff = lds_byte(wc * 32 + fr, fq * 8);
#define PG8_SA(b, h) (((b) * 2 + (h)) * HTB)
#define PG8_SB(b, h) ((4 + (b) * 2 + (h)) * HTB)
#define PG8_STAGE(bufoff, gbase, voff) do { _Pragma("unroll") for (int _i = 0; _i < 2; ++_i) \
        __builtin_amdgcn_global_load_lds((const unsigned*)((const char*)(gbase) + (voff)[_i]), (PG8_LAS unsigned*)(lds + (bufoff) + ldsw + _i * 8192), 16, 0, 0); } while (0)
#define PG8_LDA(dst, b, h) do { _Pragma("unroll") for (int m = 0; m < 4; ++m) _Pragma("unroll") for (int k = 0; k < 2; ++k) dst[m][k] = *(const PG8_LAS bf16x8*)(lds + PG8_SA(b, h) + aoff + m * 2048 + k * 1024); } while (0)
#define PG8_LDB(dst, b, h) do { _Pragma("unroll") for (int n = 0; n < 2; ++n) _Pragma("unroll") for (int k = 0; k < 2; ++k) dst[n][k] = *(const PG8_LAS bf16x8*)(lds + PG8_SB(b, h) + boff + n * 2048 + k * 1024); } while (0)
#define PG8_MMA(ai, bj, At, Bt) do { __builtin_amdgcn_s_setprio(1); _Pragma("unroll") for (int m = 0; m < 4; ++m) _Pragma("unroll") for (int n = 0; n < 2; ++n) _Pragma("unroll") for (int k = 0; k < 2; ++k) \
        acc[ai][bj][m][n] = __builtin_amdgcn_mfma_f32_16x16x32_bf16(Bt[n][k], At[m][k], acc[ai][bj][m][n], 0, 0, 0); __builtin_amdgcn_s_setprio(0); } while (0)
#define PG8_WAIT_V(n) asm volatile("s_waitcnt vmcnt(" #n ")" ::: "memory")
#define PG8_WAIT_L(n) asm volatile("s_waitcnt lgkmcnt(" #n ")" ::: "memory")
#define PG8_BAR __builtin_amdgcn_s_barrier()
#define PG8_SCHED __builtin_amdgcn_sched_barrier(0)
    Unit cur, nxt; int ui = 0;
    if (!S.next(0, cur)) return;
    f32x4 acc[2][2][4][2];
#pragma unroll
    for (int a = 0; a < 2; ++a)
#pragma unroll
        for (int b = 0; b < 2; ++b)
#pragma unroll
            for (int m = 0; m < 4; ++m)
#pragma unroll
                for (int n = 0; n < 2; ++n) acc[a][b][m][n] = (f32x4){0.f, 0.f, 0.f, 0.f};
    bf16x8 At[4][2], B0[2][2], B1[2][2];
    const char* cA = (const char*)g.A + (size_t)cur.pm * tstep; const char* cB = (const char*)g.Bt + (size_t)cur.pn * tstep;
    S.a_ready(cur);
    if constexpr (SP2) {
        PG8_STAGE(PG8_SB(0, 0), cB, voffB); PG8_STAGE(PG8_SB(0, 1), cB + hstep, voffB); PG8_STAGE(PG8_SA(0, 0), cA, voffA); PG8_STAGE(PG8_SA(0, 1), cA + hstep, voffA);
        if (wr == 1) PG8_BAR;
        PG8_WAIT_V(2); PG8_BAR;
        PG8_STAGE(PG8_SB(1, 0), cB + kstep, voffB); PG8_STAGE(PG8_SA(1, 0), cA + kstep, voffA); PG8_STAGE(PG8_SB(1, 1), cB + hstep + kstep, voffB);
        PG8_WAIT_V(6); PG8_BAR;
    } else {
        PG8_STAGE(PG8_SB(0, 0), cB, voffB); PG8_STAGE(PG8_SA(0, 0), cA, voffA); PG8_STAGE(PG8_SB(0, 1), cB + hstep, voffB); PG8_STAGE(PG8_SA(0, 1), cA + hstep, voffA);
        if (wr == 1) PG8_BAR;
        PG8_WAIT_V(4); PG8_BAR;
        PG8_STAGE(PG8_SB(1, 0), cB + kstep, voffB); PG8_STAGE(PG8_SA(1, 0), cA + kstep, voffA); PG8_STAGE(PG8_SB(1, 1), cB + hstep + kstep, voffB);
        PG8_WAIT_V(6); PG8_BAR;
    }
    for (;;) {
        const bool has_next = S.next(ui + 1, nxt);
        const char* nA = has_next ? (const char*)g.A + (size_t)nxt.pm * tstep : cA; const char* nB = has_next ? (const char*)g.Bt + (size_t)nxt.pn * tstep : cB;
        for (int t = 0; t < nt; t += 2) {
            const bool last = (t == nt - 2);
            const char* a1 = cA + (size_t)(t + 1) * kstep;
            const char* a2 = last ? nA : cA + (size_t)(t + 2) * kstep; const char* b2 = last ? nB : cB + (size_t)(t + 2) * kstep;
            const char* a3 = a2 + kstep; const char* b3 = b2 + kstep;
            if (last && has_next) S.a_ready(nxt);
            if constexpr (SP2) {
            PG8_LDB(B0, 0, 0); PG8_LDB(B1, 0, 1); PG8_SCHED; PG8_LDA(At, 0, 0); PG8_STAGE(PG8_SA(1, 1), a1 + hstep, voffA);
            PG8_WAIT_V(8); PG8_WAIT_L(0); PG8_BAR; PG8_MMA(0, 0, At, B0); PG8_MMA(0, 1, At, B1); PG8_BAR; PG8_SCHED;
            PG8_LDA(At, 0, 1); PG8_STAGE(PG8_SB(0, 0), b2, voffB); PG8_STAGE(PG8_SB(0, 1), b2 + hstep, voffB); PG8_STAGE(PG8_SA(0, 0), a2, voffA);
            PG8_WAIT_V(8); PG8_WAIT_L(0); PG8_BAR; PG8_MMA(1, 0, At, B0); PG8_MMA(1, 1, At, B1); PG8_BAR; PG8_SCHED;
            PG8_LDB(B0, 1, 0); PG8_LDB(B1, 1, 1); PG8_SCHED; PG8_LDA(At, 1, 0); PG8_STAGE(PG8_SA(0, 1), a2 + hstep, voffA);
            PG8_WAIT_V(8); PG8_WAIT_L(0); PG8_BAR; PG8_MMA(0, 0, At, B0); PG8_MMA(0, 1, At, B1); PG8_BAR; PG8_SCHED;
            PG8_LDA(At, 1, 1); PG8_STAGE(PG8_SB(1, 0), b3, voffB); PG8_STAGE(PG8_SB(1, 1), b3 + hstep, voffB); PG8_STAGE(PG8_SA(1, 0), a3, voffA);
            PG8_WAIT_V(8); PG8_WAIT_L(0); PG8_BAR; PG8_MMA(1, 0, At, B0); PG8_MMA(1, 1, At, B1); PG8_BAR; PG8_SCHED;
            } else {
            PG8_LDB(B0, 0, 0); PG8_SCHED; PG8_LDA(At, 0, 0); PG8_STAGE(PG8_SA(1, 1), a1 + hstep, voffA);
            PG8_WAIT_L(8); PG8_BAR; PG8_WAIT_L(0); PG8_MMA(0, 0, At, B0); PG8_BAR; PG8_SCHED;
            PG8_LDB(B1, 0, 1); PG8_STAGE(PG8_SB(0, 0), b2, voffB);
            PG8_BAR; PG8_WAIT_L(0); PG8_MMA(0, 1, At, B1); PG8_BAR;
            PG8_LDA(At, 0, 1); PG8_STAGE(PG8_SA(0, 0), a2, voffA);
            PG8_BAR; PG8_WAIT_L(0); PG8_MMA(1, 0, At, B0); PG8_BAR; PG8_SCHED;
            PG8_STAGE(PG8_SB(0, 1), b2 + hstep, voffB);
            PG8_WAIT_V(6); PG8_BAR; PG8_MMA(1, 1, At, B1); PG8_BAR;
            PG8_LDB(B0, 1, 0); PG8_SCHED; PG8_LDA(At, 1, 0); PG8_STAGE(PG8_SA(0, 1), a2 + hstep, voffA);
            PG8_WAIT_L(8); PG8_BAR; PG8_WAIT_L(0); PG8_MMA(0, 0, At, B0); PG8_BAR; PG8_SCHED;
            PG8_LDB(B1, 1, 1); PG8_STAGE(PG8_SB(1, 0), b3, voffB);
            PG8_BAR; PG8_WAIT_L(0); PG8_MMA(0, 1, At, B1); PG8_BAR;
            PG8_LDA(At, 1, 1); PG8_STAGE(PG8_SA(1, 0), a3, voffA);
            PG8_BAR; PG8_WAIT_L(0); PG8_MMA(1, 0, At, B0); PG8_BAR; PG8_SCHED;
            PG8_STAGE(PG8_SB(1, 1), b3 + hstep, voffB);
            PG8_WAIT_V(6); PG8_BAR; PG8_MMA(1, 1, At, B1); PG8_BAR;
            }
        }
        if constexpr (ALIGN_EPI) { if (wr == 0) PG8_BAR; }
        if constexpr (!Epi::AFTER_DRAIN) { E(acc, cur, wr, wc, fr, fq); S.done(cur); }
        if (!has_next) break;
#pragma unroll
        for (int a = 0; a < 2; ++a)
#pragma unroll
            for (int b = 0; b < 2; ++b)
#pragma unroll
                for (int m = 0; m < 4; ++m)
#pragma unroll
                    for (int n = 0; n < 2; ++n) acc[a][b][m][n] = (f32x4){0.f, 0.f, 0.f, 0.f};
        cur = nxt; cA = nA; cB = nB; ++ui;
        if constexpr (ALIGN_EPI) { if (wr == 1) PG8_BAR; }
    }
    PG8_WAIT_V(0);
    if constexpr (!ALIGN_EPI) { if (wr == 0) PG8_BAR; }
    PG8_BAR;
    if constexpr (Epi::AFTER_DRAIN) { E.fused(acc, cur, wr, wc, fr, fq, lds, wid, lane); S.done(cur); }
#undef PG8_SA
#undef PG8_SB
#undef PG8_STAGE
#undef PG8_LDA
#undef PG8_LDB
#undef PG8_MMA
#undef PG8_WAIT_V
#undef PG8_WAIT_L
#undef PG8_BAR
#undef PG8_SCHED
}
}
using namespace pg8;
using pg8::bf16_t; using pg8::bf16x8; using pg8::f32x4; using pg8::u32x4; using pg8::cvt_pk_bf16;
#define LAS __attribute__((address_space(3)))
typedef float f32x16 __attribute__((ext_vector_type(16)));
typedef unsigned u32x2 __attribute__((ext_vector_type(2)));
#define LDS_WAIT() asm volatile("s_waitcnt lgkmcnt(0)" ::: "memory")

constexpr size_t WE_QKV0 = 0, WE_QKV1 = WE_QKV0 + 1536 * 1024, WE_QKV2 = WE_QKV1 + 2048 * 1024, WE_QKV3 = WE_QKV2 + 1536 * 1024;
constexpr size_t WE_WO0 = WE_QKV3 + 1536 * 1024, WE_WO1 = WE_WO0 + 1024 * 1024, WE_WO2 = WE_WO1 + 1024 * 1152, WE_WO3 = WE_WO2 + 1024 * 1024;
constexpr size_t WE_W1 = WE_WO3 + 1024 * 1024, WE_W2 = WE_W1 + 4 * (size_t)4096 * 1024, WE_END = WE_W2 + 4 * (size_t)4096 * 1024;
static_assert(WS_W + WE_END * 2 <= WS_HB, "weights fit");

struct Params { const float* in[15]; float* out; unsigned char* ws; };

__device__ __forceinline__ float wave_sum(float v) {
#pragma unroll
    for (int o = 1; o < 64; o <<= 1) v += __shfl_xor(v, o);
    return v;
}

__device__ __forceinline__ void tr_item(const float* __restrict__ W, int K, int N, int Npad, bf16_t* WT, const float* __restrict__ gain, int mode, int nheads, int nperm, LAS float* scr, int item, int lane) {
    const int nblk = Npad >> 5, kb = item / nblk, nb = item - kb * nblk, k0 = 64 * kb, R0 = 32 * nb;
    int src0 = R0; bool valid = true, perm = false;
    if (mode == 1) { const int pn = R0 >> 8, c = R0 & 255, bj = c >> 7, wc = (c >> 5) & 3, hcol = 4 * pn + wc; valid = hcol < nheads; perm = hcol < nperm; src0 = hcol * 64 + 32 * bj; }
#pragma unroll 8
    for (int i = 0; i < 32; ++i) {
        const int kk = 2 * i + (lane >> 5);
        float w = 0.f;
        if (valid) { w = W[(size_t)(k0 + kk) * N + src0 + (lane & 31)]; if (gain) w *= gain[k0 + kk]; }
        scr[kk * 33 + (lane & 31)] = w;
    }
    LDS_WAIT();
    const int c8 = lane & 7;
#pragma unroll
    for (int jj = 0; jj < 4; ++jj) {
        const int e = (lane >> 3) + 8 * jj;
        const int se = perm ? (16 * ((e >> 2) & 1) + 4 * (e >> 3) + (e & 3)) : e;
        const LAS float* s = scr + (8 * c8) * 33 + se;
        u32x4 o; o.x = cvt_pk_bf16(s[0 * 33], s[1 * 33]); o.y = cvt_pk_bf16(s[2 * 33], s[3 * 33]); o.z = cvt_pk_bf16(s[4 * 33], s[5 * 33]); o.w = cvt_pk_bf16(s[6 * 33], s[7 * 33]);
        *(u32x4*)(WT + (size_t)(R0 + e) * K + k0 + 8 * c8) = o;
    }
    LDS_WAIT();
}

__device__ __forceinline__ void prologue(const Params& p, LAS unsigned char* lds, int gw, int NGW, int wave, int lane) {
    float* ss = (float*)(p.ws + WS_SSP);
    bf16_t* WB = (bf16_t*)(p.ws + WS_W);
    if (gw == 0) {
        float* tab = (float*)(p.ws + WS_TAB);
        for (int i = lane; i < 256; i += 64) { const int ja = i >> 7, qk = (i >> 6) & 1, d = i & 63; tab[i] = (qk == 0 ? p.in[4] : p.in[5])[ja * 64 + d]; }
        for (int i = lane; i < 1024; i += 64) { const int pos = i >> 4, f = i & 15; const float ang = (float)pos * exp2f(-(float)f * 0.83048202372184059f); tab[256 + 2 * i] = cosf(ang); tab[256 + 2 * i + 1] = sinf(ang); }
    }
    LAS float* scr = (LAS float*)(lds + wave * 16384);
    const float* attn_norm = p.in[1]; const float* mlp_norm = p.in[2];
    constexpr int I_QA = 16 * (1536 / 32), I_QB = 16 * (2048 / 32), I_WO = 16 * 32, I_WOB = 18 * 32, I_W1 = 16 * 128, I_W2 = 64 * 32;
    constexpr int NITEMS = 3 * I_QA + I_QB + 3 * I_WO + I_WOB + 4 * I_W1 + 4 * I_W2;
    for (int it = gw; it < NITEMS; it += NGW) {
        int r = it;
        if (r < I_QA) { tr_item(p.in[3], 1024, 1536, 1536, WB + WE_QKV0, attn_norm + 0 * DM, 1, 24, 20, scr, r, lane); continue; } r -= I_QA;
        if (r < I_QB) { tr_item(p.in[7], 1024, 1920, 2048, WB + WE_QKV1, attn_norm + 1 * DM, 1, 30, 0, scr, r, lane); continue; } r -= I_QB;
        if (r < I_QA) { tr_item(p.in[9], 1024, 1536, 1536, WB + WE_QKV2, attn_norm + 2 * DM, 1, 24, 0, scr, r, lane); continue; } r -= I_QA;
        if (r < I_QA) { tr_item(p.in[3] + (size_t)1024 * 1536, 1024, 1536, 1536, WB + WE_QKV3, attn_norm + 3 * DM, 1, 24, 20, scr, r, lane); continue; } r -= I_QA;
        if (r < I_WO) { tr_item(p.in[6], 1024, 1024, 1024, WB + WE_WO0, nullptr, 0, 0, 0, scr, r, lane); continue; } r -= I_WO;
        if (r < I_WOB) { tr_item(p.in[8], 1152, 1024, 1024, WB + WE_WO1, nullptr, 0, 0, 0, scr, r, lane); continue; } r -= I_WOB;
        if (r < I_WO) { tr_item(p.in[11], 1024, 1024, 1024, WB + WE_WO2, nullptr, 0, 0, 0, scr, r, lane); continue; } r -= I_WO;
        if (r < I_WO) { tr_item(p.in[6] + (size_t)1024 * 1024, 1024, 1024, 1024, WB + WE_WO3, nullptr, 0, 0, 0, scr, r, lane); continue; } r -= I_WO;
        if (r < 4 * I_W1) { const int l = r / I_W1; tr_item(p.in[12] + (size_t)l * 1024 * 4096, 1024, 4096, 4096, WB + WE_W1 + (size_t)l * 4096 * 1024, mlp_norm + l * DM, 0, 0, 0, scr, r - l * I_W1, lane); continue; } r -= 4 * I_W1;
        { const int l = r / I_W2; tr_item(p.in[13] + (size_t)l * 4096 * 1024, 4096, 1024, 1024, WB + WE_W2 + (size_t)l * 4096 * 1024, nullptr, 0, 0, 0, scr, r - l * I_W2, lane); }
    }
    const float* x = p.in[0]; bf16_t* hb = (bf16_t*)(p.ws + WS_HB);
    for (int m = gw; m < MTOK; m += NGW) {
        const f32x4* xr = (const f32x4*)(x + (size_t)m * DM) + lane;
        f32x4 v[4]; float s = 0.f;
#pragma unroll
        for (int j = 0; j < 4; ++j) { v[j] = xr[64 * j]; s += (v[j].x * v[j].x + v[j].y * v[j].y) + (v[j].z * v[j].z + v[j].w * v[j].w); }
        s = wave_sum(s);
        u32x2* o8 = (u32x2*)(hb + (size_t)m * DM) + lane;
#pragma unroll
        for (int j = 0; j < 4; ++j) { u32x2 w; w.x = cvt_pk_bf16(v[j].x, v[j].y); w.y = cvt_pk_bf16(v[j].z, v[j].w); o8[64 * j] = w; }
        if (lane < 16) ss[(size_t)m * 16 + lane] = (lane == 0) ? s : 0.f;
    }
}

constexpr int AT_ROWB = 144, AT_TILEB = 64 * AT_ROWB, AT_BUFB = 2 * AT_TILEB;
template <int MODE> __device__ __forceinline__ void attn_phase(LAS unsigned char* lds, const bf16_t* __restrict__ Qg, const bf16_t* __restrict__ Kg, const bf16_t* __restrict__ Vg, bf16_t* Og, float* LSE, const float* __restrict__ sinks) {
    int tid_ = threadIdx.x; asm volatile("" : "+v"(tid_));
    const int tid = tid_, lane = tid & 63, wave = __builtin_amdgcn_readfirstlane(tid >> 6), r32 = lane & 31, hi = lane >> 5;
    constexpr int NUNITS = (MODE == 1) ? 3 * 768 : 2048;
    constexpr int HQ = (MODE == 1) ? 6 : 16, HKV = (MODE == 1) ? 2 : 4, WIN = (MODE == 1) ? 64 : 128, OPITCH = (MODE == 1) ? 1152 : 1024;
    const int srow = tid >> 3, schunk = tid & 7;
    const unsigned sdst = (unsigned)(srow * AT_ROWB + schunk * 16);
    for (int un = blockIdx.x; un < NUNITS; un += gridDim.x) {
        int g = 0, vb, hq, qb;
        if (MODE == 1) { g = un / 768; const int r = un - g * 768; const int nqbs = 4 - 2 * g;   qb = r & ((1 << nqbs) - 1); const int r2 = r >> nqbs; hq = r2 % 6; vb = r2 / 6; }
        else { qb = un & 15; hq = (un >> 4) & 15; vb = un >> 8; }
        const int gsh = 2 * g, lsh = 12 - gsh, L = 1 << lsh;
        const int kvh = (MODE == 1) ? hq / 3 : hq >> 2;
        const int q0 = qb * 256, qw = q0 + 32 * wave;
        const size_t gq = (MODE == 1) ? (size_t)g * ((size_t)NBATCH * 6 * SEQ * 64) : 0, gk = (MODE == 1) ? (size_t)g * ((size_t)NBATCH * 2 * SEQ * 64) : 0;
        bf16x8 qf[4];
        { const bf16_t* qp = Qg + gq + ((((size_t)(vb * HQ + hq)) << lsh) + qw + r32) * 64 + 8 * hi;
#pragma unroll
          for (int s = 0; s < 4; ++s) qf[s] = *(const bf16x8*)(qp + 16 * s); }
        const bf16_t* kbase = Kg + gk + (((size_t)(vb * HKV + kvh)) << lsh) * 64;
        const bf16_t* vbase = Vg + gk + ((((size_t)(vb * HKV + kvh)) * 64) << lsh);
        int lo = 0, hiT = L >> 6;
        if (MODE != 0) { lo = (q0 - WIN) >> 6; if (lo < 0) lo = 0; int h2 = ((q0 + 255 + WIN) >> 6) + 1; if (h2 < hiT) hiT = h2; }
        float slope2 = 0.f;
        if (MODE == 1) slope2 = exp2f(-8.0f * (float)(g * 6 + hq + 1) / 18.0f) * (float)(1 << gsh) * LOG2E;
        if (MODE == 2) slope2 = exp2f(-8.0f * (float)(hq + 1) / 16.0f) * LOG2E;
        float mrun = NEG_BIG, lrun = 0.f;
        if (MODE == 2) { mrun = sinks[hq] * LOG2E; lrun = (hi == 0) ? 1.f : 0.f; }
        f32x16 oacc[2];
#pragma unroll
        for (int i = 0; i < 16; ++i) { oacc[0][i] = 0.f; oacc[1][i] = 0.f; }
        u32x4 kreg, vreg;
        kreg = *(const u32x4*)(kbase + (size_t)lo * 4096 + tid * 8);
        vreg = *(const u32x4*)(vbase + ((size_t)srow << lsh) + lo * 64 + schunk * 8);
        *(LAS u32x4*)(lds + sdst) = kreg; *(LAS u32x4*)(lds + AT_TILEB + sdst) = vreg;
        __syncthreads();
        for (int kt = lo; kt < hiT; ++kt) {
            const int buf = (kt - lo) & 1;
            const bool more = (kt + 1 < hiT);
            if (more) {
                kreg = *(const u32x4*)(kbase + (size_t)(kt + 1) * 4096 + tid * 8);
                vreg = *(const u32x4*)(vbase + ((size_t)srow << lsh) + (kt + 1) * 64 + schunk * 8);
            }
            bool active = true;
            if (MODE != 0) active = !((64 * kt + 63 < qw - WIN) || (64 * kt > qw + 31 + WIN));
            if (active) {
                const LAS unsigned char* kl = lds + buf * AT_BUFB;
                const LAS unsigned char* vl = kl + AT_TILEB;
                f32x16 sacc[2];
#pragma unroll
                for (int kb = 0; kb < 2; ++kb) {
#pragma unroll
                    for (int i = 0; i < 16; ++i) sacc[kb][i] = 0.f;
#pragma unroll
                    for (int s = 0; s < 4; ++s) {
                        const bf16x8 kf = *(const LAS bf16x8*)(kl + (32 * kb + r32) * AT_ROWB + (2 * s + hi) * 16);
                        sacc[kb] = __builtin_amdgcn_mfma_f32_32x32x16_bf16(kf, qf[s], sacc[kb], 0, 0, 0);
                    }
                }
                if (MODE != 0) {
                    const float fd0 = (float)(64 * kt + 4 * hi - (qw + r32));
#pragma unroll
                    for (int kb = 0; kb < 2; ++kb)
#pragma unroll
                        for (int i = 0; i < 16; ++i) {
                            const float dist = fabsf(fd0 + (float)(32 * kb + 8 * (i >> 2) + (i & 3)));
                            sacc[kb][i] = (dist <= (float)WIN) ? (sacc[kb][i] - slope2 * dist) : NEG_BIG;
                        }
                }
                float mx = sacc[0][0];
#pragma unroll
                for (int i = 1; i < 16; ++i) mx = fmaxf(mx, sacc[0][i]);
#pragma unroll
                for (int i = 0; i < 16; ++i) mx = fmaxf(mx, sacc[1][i]);
                mx = fmaxf(mx, __shfl_xor(mx, 32));
                const float mnew = fmaxf(mrun, mx);
                const float alpha = __builtin_amdgcn_exp2f(mrun - mnew);
                mrun = mnew;
                float ps = 0.f;
#pragma unroll
                for (int kb = 0; kb < 2; ++kb)
#pragma unroll
                    for (int i = 0; i < 16; ++i) { const float pv = __builtin_amdgcn_exp2f(sacc[kb][i] - mnew); sacc[kb][i] = pv; ps += pv; }
                lrun = lrun * alpha + ps;
#pragma unroll
                for (int i = 0; i < 16; ++i) { oacc[0][i] *= alpha; oacc[1][i] *= alpha; }
                bf16x8 pf[2][2];
#pragma unroll
                for (int kb = 0; kb < 2; ++kb)
#pragma unroll
                    for (int hh = 0; hh < 2; ++hh) {
                        u32x4 w; w.x = cvt_pk_bf16(sacc[kb][8 * hh + 0], sacc[kb][8 * hh + 1]); w.y = cvt_pk_bf16(sacc[kb][8 * hh + 2], sacc[kb][8 * hh + 3]);
                        w.z = cvt_pk_bf16(sacc[kb][8 * hh + 4], sacc[kb][8 * hh + 5]); w.w = cvt_pk_bf16(sacc[kb][8 * hh + 6], sacc[kb][8 * hh + 7]);
                        pf[kb][hh] = __builtin_bit_cast(bf16x8, w);
                    }
#pragma unroll
                for (int db = 0; db < 2; ++db)
#pragma unroll
                    for (int kb = 0; kb < 2; ++kb)
#pragma unroll
                        for (int hh = 0; hh < 2; ++hh) {
                            const bf16x8 vf = *(const LAS bf16x8*)(vl + (32 * db + r32) * AT_ROWB + (2 * (2 * kb + hh) + hi) * 16);
                            oacc[db] = __builtin_amdgcn_mfma_f32_32x32x16_bf16(vf, pf[kb][hh], oacc[db], 0, 0, 0);
                        }
            }
            if (more) {
                LAS unsigned char* nb = lds + (buf ^ 1) * AT_BUFB;
                *(LAS u32x4*)(nb + sdst) = kreg; *(LAS u32x4*)(nb + AT_TILEB + sdst) = vreg;
            }
            __syncthreads();
        }
        const float ltot = lrun + __shfl_xor(lrun, 32);
        const float inv = 1.0f / ltot;
        int row, hglob;
        if (MODE == 1) { const int dmask = (1 << gsh) - 1; const int b = vb >> gsh, rr = vb & dmask; row = b * SEQ + rr + ((qw + r32) << gsh); hglob = g * 6 + hq; }
        else { row = vb * SEQ + qw + r32; hglob = hq; }
        bf16_t* op = Og + (size_t)row * OPITCH + hglob * 64 + 4 * hi;
#pragma unroll
        for (int db = 0; db < 2; ++db)
#pragma unroll
            for (int q4 = 0; q4 < 4; ++q4) {
                u32x2 w; w.x = cvt_pk_bf16(oacc[db][4 * q4 + 0] * inv, oacc[db][4 * q4 + 1] * inv); w.y = cvt_pk_bf16(oacc[db][4 * q4 + 2] * inv, oacc[db][4 * q4 + 3] * inv);
                *(u32x2*)(op + 32 * db + 8 * q4) = w;
            }
        if (MODE == 1) { if (hi == 0) LSE[(size_t)row * 18 + hglob] = mrun + __builtin_amdgcn_logf(ltot); }
    }
}

__device__ __forceinline__ void mixb_fix(bf16_t* Og, const float* LSE, int gw, int NGW, int lane) {
    asm volatile("" : "+v"(lane));
    for (int m = gw; m < MTOK; m += NGW) {
        const float* ls = LSE + (size_t)m * 18;
#pragma unroll
        for (int c3 = 0; c3 < 3; ++c3) {
            const int c = lane + 64 * c3;
            if (c < 144) {
                const int head = c >> 3, g = head / 6, kr = head - 6 * g;
                const float l0 = ls[kr], l1 = ls[6 + kr], l2 = ls[12 + kr];
                const float mx = fmaxf(l0, fmaxf(l1, l2));
                const float e0 = exp2f(l0 - mx), e1 = exp2f(l1 - mx), e2 = exp2f(l2 - mx);
                const float a = ((g == 0) ? e0 : (g == 1) ? e1 : e2) / (e0 + e1 + e2);
                u32x4* pp = (u32x4*)(Og + (size_t)m * 1152) + c;
                u32x4 w = *pp;
                unsigned ww[4] = {w.x, w.y, w.z, w.w};
#pragma unroll
                for (int k = 0; k < 4; ++k) { const float f0 = __builtin_bit_cast(float, ww[k] << 16) * a, f1 = __builtin_bit_cast(float, ww[k] & 0xffff0000u) * a; ww[k] = cvt_pk_bf16(f0, f1); }
                w.x = ww[0]; w.y = ww[1]; w.z = ww[2]; w.w = ww[3];
                *pp = w;
            }
        }
    }
}

constexpr int LDS_BYTES = 147456;
__global__ void __launch_bounds__(512, 2) fwd_kernel(Params p) {
    extern __shared__ __attribute__((aligned(16))) unsigned char lds_raw[];
    LAS unsigned char* lds = (LAS unsigned char*)lds_raw;
    cg::grid_group grid = cg::this_grid();
#define GRID_SYNC() do { asm volatile("s_waitcnt vmcnt(0) lgkmcnt(0)" ::: "memory"); grid.sync(); asm volatile("buffer_inv sc1\n\ts_waitcnt vmcnt(0)" ::: "memory"); } while (0)
    const int tid = threadIdx.x, lane = tid & 63, wave = __builtin_amdgcn_readfirstlane(tid >> 6);
    const int G = gridDim.x, gw = blockIdx.x * 8 + wave, NGW = G * 8;
    unsigned char* ws = p.ws;
    float* ss = (float*)(ws + WS_SSP); float* LSE = (float*)(ws + WS_LSE);
    bf16_t* WB = (bf16_t*)(ws + WS_W); bf16_t* HB = (bf16_t*)(ws + WS_HB); bf16_t* U = (bf16_t*)(ws + WS_U);
    bf16_t* Qb = (bf16_t*)(ws + WS_Q); bf16_t* Kb = (bf16_t*)(ws + WS_K); bf16_t* Vb = (bf16_t*)(ws + WS_VT); bf16_t* Ob = (bf16_t*)(ws + WS_O);
    float* h = p.out;

#ifndef PHMASK
#define PHMASK 0xffff
#endif
    if (PHMASK & 1) prologue(p, lds, gw, NGW, wave, lane);
    GRID_SYNC();

#pragma unroll 1
    for (int layer = 0; layer < 4; ++layer) {
        const int kind = (layer == 3) ? 0 : layer;
        const int ja = (layer == 3) ? 1 : 0;
        const size_t weq = (layer == 0) ? WE_QKV0 : (layer == 1) ? WE_QKV1 : (layer == 2) ? WE_QKV2 : WE_QKV3;
        const size_t weo = (layer == 0) ? WE_WO0 : (layer == 1) ? WE_WO1 : (layer == 2) ? WE_WO2 : WE_WO3;
        if (kind == 0 && (PHMASK & 2)) {
            pg8::Gemm g{HB, WB + weq, MTOK, 1536, DM}; pg8::StaticOrder S; S.init(MTOK, 1536, G, (int)blockIdx.x);
            pg8::EpiQKV<0> E{ws, 2 * layer, ja};
            pg8::gemm_phase<pg8::EpiQKV<0>, pg8::StaticOrder, true, true>(lds, g, S, E);
        } else if (kind == 1 && (PHMASK & 4)) {
            pg8::Gemm g{HB, WB + weq, MTOK, 2048, DM}; pg8::StaticOrder S; S.init(MTOK, 2048, G, (int)blockIdx.x);
            pg8::EpiQKV<1> E{ws, 2 * layer, 0};
            pg8::gemm_phase<pg8::EpiQKV<1>, pg8::StaticOrder, true, true>(lds, g, S, E);
        } else if (kind == 2 && (PHMASK & 8)) {
            pg8::Gemm g{HB, WB + weq, MTOK, 1536, DM}; pg8::StaticOrder S; S.init(MTOK, 1536, G, (int)blockIdx.x);
            pg8::EpiQKV<2> E{ws, 2 * layer, 0};
            pg8::gemm_phase<pg8::EpiQKV<2>, pg8::StaticOrder, true, true>(lds, g, S, E);
        }
        GRID_SYNC();
        if (kind == 0) { if (PHMASK & 16) attn_phase<0>(lds, Qb, Kb, Vb, Ob, LSE, nullptr); }
        else if (kind == 1) { if (PHMASK & 32) attn_phase<1>(lds, Qb, Kb, Vb, Ob, LSE, nullptr); GRID_SYNC(); mixb_fix(Ob, LSE, gw, NGW, lane); }
        else { if (PHMASK & 64) attn_phase<2>(lds, Qb, Kb, Vb, Ob, LSE, p.in[10]); }
        GRID_SYNC();
        if (PHMASK & 128) {
            const int Ko = (kind == 1) ? 1152 : 1024;
            pg8::Gemm g{Ob, WB + weo, MTOK, DM, Ko}; pg8::StaticOrder S; S.init(MTOK, DM, G, (int)blockIdx.x);
            pg8::EpiRes E{(layer == 0) ? p.in[0] : (const float*)h, h, HB, ss + (size_t)(2 * layer + 1) * MTOK * 16};
            pg8::gemm_phase<pg8::EpiRes, pg8::StaticOrder, true, true>(lds, g, S, E);
        }
        GRID_SYNC();
        if (PHMASK & 256) {
            pg8::Gemm g{HB, WB + WE_W1 + (size_t)layer * 4096 * 1024, MTOK, DFF, DM}; pg8::StaticOrder S; S.init(MTOK, DFF, G, (int)blockIdx.x);
            pg8::EpiMlp1 E{ss + (size_t)(2 * layer + 1) * MTOK * 16, U};
            pg8::gemm_phase<pg8::EpiMlp1, pg8::StaticOrder, true, true>(lds, g, S, E);
        }
        GRID_SYNC();
        if (PHMASK & 512) {
            pg8::Gemm g{U, WB + WE_W2 + (size_t)layer * 4096 * 1024, MTOK, DM, DFF}; pg8::StaticOrder S; S.init(MTOK, DM, G, (int)blockIdx.x);
            pg8::EpiRes E{h, h, HB, ss + (size_t)(2 * layer + 2) * MTOK * 16};
            pg8::gemm_phase<pg8::EpiRes, pg8::StaticOrder, true, true>(lds, g, S, E);
        }
        GRID_SYNC();
    }
    {
        const float* fg = p.in[14]; const float* ss8 = ss + (size_t)8 * MTOK * 16;
        int lane2 = lane; asm volatile("" : "+v"(lane2));
        for (int m = gw; m < MTOK; m += NGW) {
            const float rstd = __builtin_amdgcn_rsqf(row_ss(ss8, m) * (1.0f / DM) + RMS_EPS);
            f32x4* hr = (f32x4*)(h + (size_t)m * DM) + lane2;
#pragma unroll
            for (int j = 0; j < 4; ++j) { const f32x4 gg = ((const f32x4*)fg)[64 * j + lane2]; f32x4 v = hr[64 * j]; v = v * rstd * gg; hr[64 * j] = v; }
        }
    }
}

extern "C" void kernel_launch(void* const* d_in, const int* in_sizes, int n_in, void* d_out, int out_size, void* d_ws, size_t ws_size, hipStream_t stream) {
    static int grid = 0;
    if (grid == 0) {
        if (n_in != 15 || out_size != MTOK * DM || ws_size < WS_END) { fprintf(stderr, "kernel_launch: unexpected shapes (n_in %d out %d ws %zu)\n", n_in, out_size, ws_size); grid = -1; return; }
        int dev = 0, cus = 0, per_cu = 0;
        hipGetDevice(&dev);
        hipDeviceGetAttribute(&cus, hipDeviceAttributeMultiprocessorCount, dev);
        if (hipFuncSetAttribute((const void*)fwd_kernel, hipFuncAttributeMaxDynamicSharedMemorySize, LDS_BYTES) != hipSuccess) { fprintf(stderr, "kernel_launch: hipFuncSetAttribute failed\n"); grid = -1; return; }
        if (hipOccupancyMaxActiveBlocksPerMultiprocessor(&per_cu, (const void*)fwd_kernel, 512, LDS_BYTES) != hipSuccess || per_cu < 1) { fprintf(stderr, "kernel_launch: occupancy query gave %d\n", per_cu); per_cu = 1; }
        (void)hipGetLastError();
        grid = cus * per_cu;
    }
    if (grid < 0) return;
    Params p{};
    for (int i = 0; i < 15; ++i) p.in[i] = (const float*)d_in[i];
    p.out = (float*)d_out; p.ws = (unsigned char*)d_ws;
    void* args[] = {&p};
    hipError_t e = hipLaunchCooperativeKernel((const void*)fwd_kernel, dim3(grid), dim3(512), args, LDS_BYTES, stream);
    if (e != hipSuccess) fprintf(stderr, "cooperative launch failed: %s (grid %d)\n", hipGetErrorString(e), grid);
}
```

```cpp
#include <hip/hip_runtime.h>
#include <hip/hip_cooperative_groups.h>
#include <cstdio>
#include <cstdint>
namespace cg = cooperative_groups;

namespace pg8 {
#define PG8_LAS __attribute__((address_space(3)))
typedef unsigned short bf16_t;
typedef short bf16x8 __attribute__((ext_vector_type(8)));
typedef float f32x4 __attribute__((ext_vector_type(4)));
typedef unsigned u32x4 __attribute__((ext_vector_type(4)));
constexpr int BM = 256, BK = 64, HALF = 128, HTB = HALF * BK * 2  , STAGE_BYTES = 8 * HTB, NXCD = 8, WGM = 8;

__host__ __device__ __forceinline__ int lds_byte(int r, int c) { const int st = (r >> 4) * 2 + (c >> 5), rr = r & 15, cc = c & 31, ob = rr * 64 + cc * 2; return st * 1024 + (ob ^ (((ob >> 9) & 1) << 5)); }
__host__ __device__ __forceinline__ void stage_rc(int b, int& R, int& C) { const int st = b / 1024, sb = b % 1024, swz = sb ^ (((sb >> 9) & 1) << 5); R = (st >> 1) * 16 + swz / 64; C = (st & 1) * 32 + (swz % 64) / 2; }
__host__ __device__ __forceinline__ int perm32(int rho) { const int n = rho >> 4, i = rho & 15; return 8 * (i >> 2) + 4 * n + (i & 3); }

struct Unit { int pm, pn; };
struct Gemm { const bf16_t* A; const bf16_t* Bt; int M, N, K; };

struct StaticOrder {
    int nM, nN, nwg, G, c;
    __host__ __device__ void init(int M, int N, int G_, int c_) { nM = M / BM; nN = N / BM; nwg = nM * nN; G = G_; c = c_; }
    __host__ __device__ bool next(int i, Unit& u) const {
        const long L = (long)i * G + c; if (L >= nwg) return false;
        int wgid = (int)L; { const int q = nwg / NXCD, r = nwg % NXCD, xcd = wgid % NXCD, off = wgid / NXCD; wgid = (xcd < r ? xcd * (q + 1) : r * (q + 1) + (xcd - r) * q) + off; }
        const int nig = WGM * nN, gid = wgid / nig, fm = gid * WGM, gsz = (nM - fm) < WGM ? (nM - fm) : WGM;
        u.pm = fm + ((wgid % nig) % gsz); u.pn = (wgid % nig) / gsz; return true;
    }
    __device__ __forceinline__ void a_ready(const Unit&) const {}
    __device__ __forceinline__ void done(const Unit&) const {}
};

__device__ __forceinline__ unsigned cvt_pk_bf16(float lo, float hi) { unsigned r; asm volatile("v_cvt_pk_bf16_f32 %0, %1, %2" : "=v"(r) : "v"(lo), "v"(hi)); return r; }
constexpr int SEQ = 4096, NBATCH = 8, MTOK = NBATCH * SEQ, DM = 1024, DFF = 4096;
constexpr float RMS_EPS = 1e-6f;
constexpr float LOG2E = 1.4426950408889634f;
constexpr float QSCALE = 0.125f * LOG2E;
constexpr float NEG_BIG = -1.0e30f;

constexpr size_t MiB = 1u << 20;
constexpr size_t WS_SS = 0;
constexpr size_t WS_TAB = 6 * MiB;
constexpr size_t WS_BAR = 7 * MiB;
constexpr size_t WS_LSE = 2 * MiB;
constexpr size_t WS_W = 8 * MiB;
constexpr size_t WS_HB = 96 * MiB;
constexpr size_t WS_U = 160 * MiB;
constexpr size_t WS_Q = 160 * MiB, WS_K = 232 * MiB, WS_VT = 256 * MiB, WS_O = 280 * MiB;
constexpr size_t WS_SSP = 420 * MiB;
constexpr size_t WS_END = 440 * MiB;

__device__ __forceinline__ float row_ss(const float* ssp, int row) {
    const f32x4* q = (const f32x4*)(ssp + (size_t)row * 16);
    const f32x4 a = q[0], b = q[1], c = q[2], d = q[3];
    return ((a[0] + a[1]) + (a[2] + a[3])) + ((b[0] + b[1]) + (b[2] + b[3])) + (((c[0] + c[1]) + (c[2] + c[3])) + ((d[0] + d[1]) + (d[2] + d[3])));
}
__device__ __forceinline__ int perm_key(int i) { return (i & ~12) | ((i & 4) << 1) | ((i & 8) >> 1); }

template <int KIND> struct EpiQKV {
    static constexpr bool PERM = true, AFTER_DRAIN = false;
    unsigned char* ws; int ssi; int ja;
    __device__ __forceinline__ void operator()(const f32x4 (&acc)[2][2][4][2], const Unit& u, int wr, int wc, int fr, int fq) const {
        asm volatile("" : "+v"(fr), "+v"(fq));
        asm volatile("" : "+s"(wr), "+s"(wc));
        constexpr int NQH = (KIND == 1) ? 18 : 16, NKH = (KIND == 1) ? 6 : 4;
        const int hcol = 4 * u.pn + wc;
        int type, hh;
        if (hcol < NQH) { type = 0; hh = hcol; } else if (hcol < NQH + NKH) { type = 1; hh = hcol - NQH; } else if (hcol < NQH + 2 * NKH) { type = 2; hh = hcol - NQH - NKH; } else return;
        const float* ss = (const float*)(ws + WS_SSP) + (size_t)ssi * MTOK * 16;
        const f32x4* rope = (const f32x4*)(ws + WS_TAB + 1024);
        float gn[2][8];
        if (KIND == 0) {
            const float* gsrc = (const float*)(ws + WS_TAB) + ja * 128 + ((type == 0) ? 0 : 64);
            if (type < 2) {
#pragma unroll
                for (int bj = 0; bj < 2; ++bj)
#pragma unroll
                    for (int n = 0; n < 2; ++n)
#pragma unroll
                        for (int j = 0; j < 4; ++j) gn[bj][n * 4 + j] = gsrc[32 * bj + 16 * n + 4 * fq + j];
            }
        }
        int hin = hh, g = 0;
        if (KIND == 1) { if (type == 0) { g = hh / 6; hin = hh - 6 * g; } else { g = hh >> 1; hin = hh & 1; } }
        if (KIND == 1 && g == 1) body<2>(acc, u, wr, wc, fr, fq, type, hin, g, ss, rope, gn);
        else if (KIND == 1 && g == 2) body<4>(acc, u, wr, wc, fr, fq, type, hin, g, ss, rope, gn);
        else body<0>(acc, u, wr, wc, fr, fq, type, hin, g, ss, rope, gn);
    }
    template <int gsh> __device__ __forceinline__ void body(const f32x4 (&acc)[2][2][4][2], const Unit& u, int wr, int wc, int fr, int fq, int type, int hin, int g, const float* ss, const f32x4* rope, const float (&gn)[2][8]) const {
#pragma unroll
        for (int ai = 0; ai < 2; ++ai)
#pragma unroll
            for (int m = 0; m < 4; ++m) {
                int frl = fr; asm volatile("" : "+v"(frl));
                const int row = u.pm * BM + ai * HALF + wr * 64 + m * 16 + frl;
                const int b = row >> 12, t = row & (SEQ - 1);
                const float rstd = __builtin_amdgcn_rsqf(row_ss(ss, row) * (1.0f / DM) + RMS_EPS);
                float v[2][8];
#pragma unroll
                for (int bj = 0; bj < 2; ++bj)
#pragma unroll
                    for (int n = 0; n < 2; ++n)
#pragma unroll
                        for (int j = 0; j < 4; ++j) v[bj][n * 4 + j] = acc[ai][bj][m][n][j] * rstd;
                if (KIND == 0 && type < 2) {
                    float s2 = 0.f;
#pragma unroll
                    for (int bj = 0; bj < 2; ++bj)
#pragma unroll
                        for (int e = 0; e < 8; ++e) s2 += v[bj][e] * v[bj][e];
                    s2 += __shfl_xor(s2, 16); s2 += __shfl_xor(s2, 32);
                    const float r = __builtin_amdgcn_rsqf(s2 * (1.0f / 64.0f) + RMS_EPS);
#pragma unroll
                    for (int bj = 0; bj < 2; ++bj)
#pragma unroll
                        for (int e = 0; e < 8; ++e) v[bj][e] *= r * gn[bj][e];
#pragma unroll
                    for (int bj = 0; bj < 2; ++bj) {
                        const int pos = (bj == 0) ? (t >> 6) : (t & 63);
                        const f32x4 cs0 = rope[(pos * 16 + 4 * fq) >> 1], cs1 = rope[((pos * 16 + 4 * fq) >> 1) + 1];
                        const float cc[4] = {cs0[0], cs0[2], cs1[0], cs1[2]}, sn[4] = {cs0[1], cs0[3], cs1[1], cs1[3]};
#pragma unroll
                        for (int j = 0; j < 4; ++j) {
                            const float x1 = v[bj][j], x2 = v[bj][4 + j];
                            v[bj][j] = x1 * cc[j] - x2 * sn[j]; v[bj][4 + j] = x2 * cc[j] + x1 * sn[j];
                        }
                    }
                }
                if (type == 0) {
#pragma unroll
                    for (int bj = 0; bj < 2; ++bj)
#pragma unroll
                        for (int e = 0; e < 8; ++e) v[bj][e] *= QSCALE;
                }
                const int dmask = (1 << gsh) - 1;
                const int vb = (b << gsh) + (t & dmask), idx = t >> gsh, lsh = 12 - gsh;
                if (type < 2) {
                    const int nh = (type == 0) ? ((KIND == 1) ? 6 : 16) : ((KIND == 1) ? 2 : 4);
                    unsigned char* base = ws + ((type == 0) ? WS_Q : WS_K) + ((KIND == 1) ? (size_t)g * ((size_t)NBATCH * nh * SEQ * 128) : 0);
                    const unsigned off = ((unsigned)(((vb * nh + hin) << lsh) + idx) * 64u + 8u * fq) * 2u;
#pragma unroll
                    for (int bj = 0; bj < 2; ++bj) {
                        u32x4 w; w.x = cvt_pk_bf16(v[bj][0], v[bj][1]); w.y = cvt_pk_bf16(v[bj][2], v[bj][3]); w.z = cvt_pk_bf16(v[bj][4], v[bj][5]); w.w = cvt_pk_bf16(v[bj][6], v[bj][7]);
                        *(u32x4*)(base + off + 64 * bj) = w;
                    }
                } else {
                    const int nh = (KIND == 1) ? 2 : 4;
                    unsigned char* base = ws + WS_VT + ((KIND == 1) ? (size_t)g * ((size_t)NBATCH * nh * SEQ * 128) : 0);
                    unsigned off = ((unsigned)((((vb * nh + hin) * 64 + 8 * fq) << lsh) + perm_key(idx))) * 2u;
                    const unsigned dstep = 2u << lsh;
#pragma unroll
                    for (int bj = 0; bj < 2; ++bj) {
#pragma unroll
                        for (int e = 0; e < 8; ++e) {
                            const unsigned pk = cvt_pk_bf16(v[bj][e], 0.f);
                            *(bf16_t*)(base + off) = (bf16_t)(pk & 0xffffu);
                            off += dstep;
                        }
                        off += 24u * dstep;
                    }
                }
                __builtin_amdgcn_sched_barrier(0);
            }
    }
};

struct EpiRes {
    static constexpr bool PERM = true, AFTER_DRAIN = false;
    const float* hin; float* hout; bf16_t* hb; float* ssout;
    __device__ __forceinline__ void operator()(const f32x4 (&acc)[2][2][4][2], const Unit& u, int wr, int wc, int fr, int fq) const {
#pragma unroll
        for (int ai = 0; ai < 2; ++ai)
#pragma unroll
            for (int m = 0; m < 4; ++m) {
                int frl = fr; asm volatile("" : "+v"(frl));
                const int row = u.pm * BM + ai * HALF + wr * 64 + m * 16 + frl;
                float q = 0.f;
#pragma unroll
                for (int bj = 0; bj < 2; ++bj) {
                    const unsigned o = (unsigned)(row * DM + u.pn * BM + bj * HALF + wc * 32 + 8 * fq);
                    const f32x4 a0 = *(const f32x4*)((const char*)hin + o * 4u), a1 = *(const f32x4*)((const char*)hin + o * 4u + 16);
                    const f32x4 v0 = acc[ai][bj][m][0] + a0, v1 = acc[ai][bj][m][1] + a1;
                    *(f32x4*)((char*)hout + o * 4u) = v0; *(f32x4*)((char*)hout + o * 4u + 16) = v1;
                    u32x4 w; w.x = cvt_pk_bf16(v0[0], v0[1]); w.y = cvt_pk_bf16(v0[2], v0[3]); w.z = cvt_pk_bf16(v1[0], v1[1]); w.w = cvt_pk_bf16(v1[2], v1[3]);
                    *(u32x4*)((char*)hb + o * 2u) = w;
                    q += (v0[0] * v0[0] + v0[1] * v0[1]) + (v0[2] * v0[2] + v0[3] * v0[3]) + (v1[0] * v1[0] + v1[1] * v1[1]) + (v1[2] * v1[2] + v1[3] * v1[3]);
                }
                q += __shfl_xor(q, 16); q += __shfl_xor(q, 32);
                if (fq == 0) ssout[(size_t)row * 16 + u.pn * 4 + wc] = q;
            }
    }
};

struct EpiMlp1 {
    static constexpr bool PERM = true, AFTER_DRAIN = false;
    const float* ss; bf16_t* U;
    __device__ __forceinline__ void operator()(const f32x4 (&acc)[2][2][4][2], const Unit& u, int wr, int wc, int fr, int fq) const {
#pragma unroll
        for (int ai = 0; ai < 2; ++ai)
#pragma unroll
            for (int m = 0; m < 4; ++m) {
                const int row = u.pm * BM + ai * HALF + wr * 64 + m * 16 + fr;
                const float rstd = __builtin_amdgcn_rsqf(row_ss(ss, row) * (1.0f / DM) + RMS_EPS);
#pragma unroll
                for (int bj = 0; bj < 2; ++bj) {
                    f32x4 v0 = acc[ai][bj][m][0] * rstd, v1 = acc[ai][bj][m][1] * rstd;
#pragma unroll
                    for (int j = 0; j < 4; ++j) { const float a = fmaxf(v0[j], 0.f), c = fmaxf(v1[j], 0.f); v0[j] = a * a; v1[j] = c * c; }
                    u32x4 w; w.x = cvt_pk_bf16(v0[0], v0[1]); w.y = cvt_pk_bf16(v0[2], v0[3]); w.z = cvt_pk_bf16(v1[0], v1[1]); w.w = cvt_pk_bf16(v1[2], v1[3]);
                    *(u32x4*)((char*)U + (unsigned)(row * DFF + u.pn * BM + bj * HALF + wc * 32 + 8 * fq) * 2u) = w;
                }
            }
    }
};
template <class Epi, class Sched, bool ALIGN_EPI = false, bool SP2 = false>
__device__ __forceinline__ void gemm_phase(PG8_LAS unsigned char* lds, const Gemm g, const Sched& S, const Epi& E) {
    int tid_ = threadIdx.x; asm volatile("" : "+v"(tid_));
    const int tid = tid_, wid = __builtin_amdgcn_readfirstlane(tid >> 6), lane = tid & 63, wr = wid >> 2, wc = wid & 3, fr = lane & 15, fq = lane >> 4;
    const int K = g.K, nt = K / BK;
    unsigned voffA[2], voffB[2];
#pragma unroll
    for (int i = 0; i < 2; ++i) { int R, C; stage_rc(tid * 16 + i * 8192, R, C); const int Rb = Epi::PERM ? ((R & ~31) + perm32(R & 31)) : R;
        voffA[i] = (unsigned)(R * K + C) * 2u; voffB[i] = (unsigned)(Rb * K + C) * 2u; }
    const size_t kstep = (size_t)(BK * 2);
    const size_t hstep = (size_t)HALF * K * 2;
    const size_t tstep = 2 * hstep;
    const unsigned ldsw = (unsigned)wid * 1024u;
    const int aoff = lds_byte(wr * 64 + fr, fq * 8), boff = lds_byte(wc * 32 + fr, fq * 8);
#define PG8_SA(b, h) (((b) * 2 + (h)) * HTB)
#define PG8_SB(b, h) ((4 + (b) * 2 + (h)) * HTB)
#define PG8_STAGE(bufoff, gbase, voff) do { _Pragma("unroll") for (int _i = 0; _i < 2; ++_i) \
        __builtin_amdgcn_global_load_lds((const unsigned*)((const char*)(gbase) + (voff)[_i]), (PG8_LAS unsigned*)(lds + (bufoff) + ldsw + _i * 8192), 16, 0, 0); } while (0)
#define PG8_LDA(dst, b, h) do { _Pragma("unroll") for (int m = 0; m < 4; ++m) _Pragma("unroll") for (int k = 0; k < 2; ++k) dst[m][k] = *(const PG8_LAS bf16x8*)(lds + PG8_SA(b, h) + aoff + m * 2048 + k * 1024); } while (0)
#define PG8_LDB(dst, b, h) do { _Pragma("unroll") for (int n = 0; n < 2; ++n) _Pragma("unroll") for (int k = 0; k < 2; ++k) dst[n][k] = *(const PG8_LAS bf16x8*)(lds + PG8_SB(b, h) + boff + n * 2048 + k * 1024); } while (0)
#define PG8_MMA(ai, bj, At, Bt) do { __builtin_amdgcn_s_setprio(1); _Pragma("unroll") for (int m = 0; m < 4; ++m) _Pragma("unroll") for (int n = 0; n < 2; ++n) _Pragma("unroll") for (int k = 0; k < 2; ++k) \
        acc[ai][bj][m][n] = __builtin_amdgcn_mfma_f32_16x16x32_bf16(Bt[n][k], At[m][k], acc[ai][bj][m][n], 0, 0, 0); __builtin_amdgcn_s_setprio(0); } while (0)
#define PG8_WAIT_V(n) asm volatile("s_waitcnt vmcnt(" #n ")" ::: "memory")
#define PG8_WAIT_L(n) asm volatile("s_waitcnt lgkmcnt(" #n ")" ::: "memory")
#define PG8_BAR __builtin_amdgcn_s_barrier()
#define PG8_SCHED __builtin_amdgcn_sched_barrier(0)
    Unit cur, nxt; int ui = 0;
    if (!S.next(0, cur)) return;
    f32x4 acc[2][2][4][2];
#pragma unroll
    for (int a = 0; a < 2; ++a)
#pragma unroll
        for (int b = 0; b < 2; ++b)
#pragma unroll
            for (int m = 0; m < 4; ++m)
#pragma unroll
                for (int n = 0; n < 2; ++n) acc[a][b][m][n] = (f32x4){0.f, 0.f, 0.f, 0.f};
    bf16x8 At[4][2], B0[2][2], B1[2][2];
    const char* cA = (const char*)g.A + (size_t)cur.pm * tstep; const char* cB = (const char*)g.Bt + (size_t)cur.pn * tstep;
    S.a_ready(cur);
    if constexpr (SP2) {
        PG8_STAGE(PG8_SB(0, 0), cB, voffB); PG8_STAGE(PG8_SB(0, 1), cB + hstep, voffB); PG8_STAGE(PG8_SA(0, 0), cA, voffA); PG8_STAGE(PG8_SA(0, 1), cA + hstep, voffA);
        if (wr == 1) PG8_BAR;
        PG8_WAIT_V(2); PG8_BAR;
        PG8_STAGE(PG8_SB(1, 0), cB + kstep, voffB); PG8_STAGE(PG8_SA(1, 0), cA + kstep, voffA); PG8_STAGE(PG8_SB(1, 1), cB + hstep + kstep, voffB);
        PG8_WAIT_V(6); PG8_BAR;
    } else {
        PG8_STAGE(PG8_SB(0, 0), cB, voffB); PG8_STAGE(PG8_SA(0, 0), cA, voffA); PG8_STAGE(PG8_SB(0, 1), cB + hstep, voffB); PG8_STAGE(PG8_SA(0, 1), cA + hstep, voffA);
        if (wr == 1) PG8_BAR;
        PG8_WAIT_V(4); PG8_BAR;
        PG8_STAGE(PG8_SB(1, 0), cB + kstep, voffB); PG8_STAGE(PG8_SA(1, 0), cA + kstep, voffA); PG8_STAGE(PG8_SB(1, 1), cB + hstep + kstep, voffB);
        PG8_WAIT_V(6); PG8_BAR;
    }
    for (;;) {
        const bool has_next = S.next(ui + 1, nxt);
        const char* nA = has_next ? (const char*)g.A + (size_t)nxt.pm * tstep : cA; const char* nB = has_next ? (const char*)g.Bt + (size_t)nxt.pn * tstep : cB;
        for (int t = 0; t < nt; t += 2) {
            const bool last = (t == nt - 2);
            const char* a1 = cA + (size_t)(t + 1) * kstep;
            const char* a2 = last ? nA : cA + (size_t)(t + 2) * kstep; const char* b2 = last ? nB : cB + (size_t)(t + 2) * kstep;
            const char* a3 = a2 + kstep; const char* b3 = b2 + kstep;
            if (last && has_next) S.a_ready(nxt);
            if constexpr (SP2) {
            PG8_LDB(B0, 0, 0); PG8_LDB(B1, 0, 1); PG8_SCHED; PG8_LDA(At, 0, 0); PG8_STAGE(PG8_SA(1, 1), a1 + hstep, voffA);
            PG8_WAIT_V(8); PG8_WAIT_L(0); PG8_BAR; PG8_MMA(0, 0, At, B0); PG8_MMA(0, 1, At, B1); PG8_BAR; PG8_SCHED;
            PG8_LDA(At, 0, 1); PG8_STAGE(PG8_SB(0, 0), b2, voffB); PG8_STAGE(PG8_SB(0, 1), b2 + hstep, voffB); PG8_STAGE(PG8_SA(0, 0), a2, voffA);
            PG8_WAIT_V(8); PG8_WAIT_L(0); PG8_BAR; PG8_MMA(1, 0, At, B0); PG8_MMA(1, 1, At, B1); PG8_BAR; PG8_SCHED;
            PG8_LDB(B0, 1, 0); PG8_LDB(B1, 1, 1); PG8_SCHED; PG8_LDA(At, 1, 0); PG8_STAGE(PG8_SA(0, 1), a2 + hstep, voffA);
            PG8_WAIT_V(8); PG8_WAIT_L(0); PG8_BAR; PG8_MMA(0, 0, At, B0); PG8_MMA(0, 1, At, B1); PG8_BAR; PG8_SCHED;
            PG8_LDA(At, 1, 1); PG8_STAGE(PG8_SB(1, 0), b3, voffB); PG8_STAGE(PG8_SB(1, 1), b3 + hstep, voffB); PG8_STAGE(PG8_SA(1, 0), a3, voffA);
            PG8_WAIT_V(8); PG8_WAIT_L(0); PG8_BAR; PG8_MMA(1, 0, At, B0); PG8_MMA(1, 1, At, B1); PG8_BAR; PG8_SCHED;
            } else {
            PG8_LDB(B0, 0, 0); PG8_SCHED; PG8_LDA(At, 0, 0); PG8_STAGE(PG8_SA(1, 1), a1 + hstep, voffA);
            PG8_WAIT_L(8); PG8_BAR; PG8_WAIT_L(0); PG8_MMA(0, 0, At, B0); PG8_BAR; PG8_SCHED;
            PG8_LDB(B1, 0, 1); PG8_STAGE(PG8_SB(0, 0), b2, voffB);
            PG8_BAR; PG8_WAIT_L(0); PG8_MMA(0, 1, At, B1); PG8_BAR;
            PG8_LDA(At, 0, 1); PG8_STAGE(PG8_SA(0, 0), a2, voffA);
            PG8_BAR; PG8_WAIT_L(0); PG8_MMA(1, 0, At, B0); PG8_BAR; PG8_SCHED;
            PG8_STAGE(PG8_SB(0, 1), b2 + hstep, voffB);
            PG8_WAIT_V(6); PG8_BAR; PG8_MMA(1, 1, At, B1); PG8_BAR;
            PG8_LDB(B0, 1, 0); PG8_SCHED; PG8_LDA(At, 1, 0); PG8_STAGE(PG8_SA(0, 1), a2 + hstep, voffA);
            PG8_WAIT_L(8); PG8_BAR; PG8_WAIT_L(0); PG8_MMA(0, 0, At, B0); PG8_BAR; PG8_SCHED;
            PG8_LDB(B1, 1, 1); PG8_STAGE(PG8_SB(1, 0), b3, voffB);
            PG8_BAR; PG8_WAIT_L(0); PG8_MMA(0, 1, At, B1); PG8_BAR;
            PG8_LDA(At, 1, 1); PG8_STAGE(PG8_SA(1, 0), a3, voffA);
            PG8_BAR; PG8_WAIT_L(0); PG8_MMA(1, 0, At, B0); PG8_BAR; PG8_SCHED;
            PG8_STAGE(PG8_SB(1, 1), b3 + hstep, voffB);
            PG8_WAIT_V(6); PG8_BAR; PG8_MMA(1, 1, At, B1); PG8_BAR;
            }
        }
        if constexpr (ALIGN_EPI) { if (wr == 0) PG8_BAR; }
        if constexpr (!Epi::AFTER_DRAIN) { E(acc, cur, wr, wc, fr, fq); S.done(cur); }
        if (!has_next) break;
#pragma unroll
        for (int a = 0; a < 2; ++a)
#pragma unroll
            for (int b = 0; b < 2; ++b)
#pragma unroll
                for (int m = 0; m < 4; ++m)
#pragma unroll
                    for (int n = 0; n < 2; ++n) acc[a][b][m][n] = (f32x4){0.f, 0.f, 0.f, 0.f};
        cur = nxt; cA = nA; cB = nB; ++ui;
        if constexpr (ALIGN_EPI) { if (wr == 1) PG8_BAR; }
    }
    PG8_WAIT_V(0);
    if constexpr (!ALIGN_EPI) { if (wr == 0) PG8_BAR; }
    PG8_BAR;
    if constexpr (Epi::AFTER_DRAIN) { E.fused(acc, cur, wr, wc, fr, fq, lds, wid, lane); S.done(cur); }
#undef PG8_SA
#undef PG8_SB
#undef PG8_STAGE
#undef PG8_LDA
#undef PG8_LDB
#undef PG8_MMA
#undef PG8_WAIT_V
#undef PG8_WAIT_L
#undef PG8_BAR
#undef PG8_SCHED
}
}
using namespace pg8;
using pg8::bf16_t; using pg8::bf16x8; using pg8::f32x4; using pg8::u32x4; using pg8::cvt_pk_bf16;
#define LAS __attribute__((address_space(3)))
typedef float f32x16 __attribute__((ext_vector_type(16)));
typedef unsigned u32x2 __attribute__((ext_vector_type(2)));
#define LDS_WAIT() asm volatile("s_waitcnt lgkmcnt(0)" ::: "memory")

constexpr size_t WE_QKV0 = 0, WE_QKV1 = WE_QKV0 + 1536 * 1024, WE_QKV2 = WE_QKV1 + 2048 * 1024, WE_QKV3 = WE_QKV2 + 1536 * 1024;
constexpr size_t WE_WO0 = WE_QKV3 + 1536 * 1024, WE_WO1 = WE_WO0 + 1024 * 1024, WE_WO2 = WE_WO1 + 1024 * 1152, WE_WO3 = WE_WO2 + 1024 * 1024;
constexpr size_t WE_W1 = WE_WO3 + 1024 * 1024, WE_W2 = WE_W1 + 4 * (size_t)4096 * 1024, WE_END = WE_W2 + 4 * (size_t)4096 * 1024;
static_assert(WS_W + WE_END * 2 <= WS_HB, "weights fit");

struct Params { const float* in[15]; float* out; unsigned char* ws; };

__device__ __forceinline__ float wave_sum(float v) {
#pragma unroll
    for (int o = 1; o < 64; o <<= 1) v += __shfl_xor(v, o);
    return v;
}

__device__ __forceinline__ void tr_item(const float* __restrict__ W, int K, int N, int Npad, bf16_t* WT, const float* __restrict__ gain, int mode, int nheads, int nperm, LAS float* scr, int item, int lane) {
    const int nblk = Npad >> 5, kb = item / nblk, nb = item - kb * nblk, k0 = 64 * kb, R0 = 32 * nb;
    int src0 = R0; bool valid = true, perm = false;
    if (mode == 1) { const int pn = R0 >> 8, c = R0 & 255, bj = c >> 7, wc = (c >> 5) & 3, hcol = 4 * pn + wc; valid = hcol < nheads; perm = hcol < nperm; src0 = hcol * 64 + 32 * bj; }
#pragma unroll 8
    for (int i = 0; i < 32; ++i) {
        const int kk = 2 * i + (lane >> 5);
        float w = 0.f;
        if (valid) { w = W[(size_t)(k0 + kk) * N + src0 + (lane & 31)]; if (gain) w *= gain[k0 + kk]; }
        scr[kk * 33 + (lane & 31)] = w;
    }
    LDS_WAIT();
    const int c8 = lane & 7;
#pragma unroll
    for (int jj = 0; jj < 4; ++jj) {
        const int e = (lane >> 3) + 8 * jj;
        const int se = perm ? (16 * ((e >> 2) & 1) + 4 * (e >> 3) + (e & 3)) : e;
        const LAS float* s = scr + (8 * c8) * 33 + se;
        u32x4 o; o.x = cvt_pk_bf16(s[0 * 33], s[1 * 33]); o.y = cvt_pk_bf16(s[2 * 33], s[3 * 33]); o.z = cvt_pk_bf16(s[4 * 33], s[5 * 33]); o.w = cvt_pk_bf16(s[6 * 33], s[7 * 33]);
        *(u32x4*)(WT + (size_t)(R0 + e) * K + k0 + 8 * c8) = o;
    }
    LDS_WAIT();
}

__device__ __forceinline__ void prologue(const Params& p, LAS unsigned char* lds, int gw, int NGW, int wave, int lane) {
    float* ss = (float*)(p.ws + WS_SSP);
    bf16_t* WB = (bf16_t*)(p.ws + WS_W);
    if (gw == 0) {
        float* tab = (float*)(p.ws + WS_TAB);
        for (int i = lane; i < 256; i += 64) { const int ja = i >> 7, qk = (i >> 6) & 1, d = i & 63; tab[i] = (qk == 0 ? p.in[4] : p.in[5])[ja * 64 + d]; }
        for (int i = lane; i < 1024; i += 64) { const int pos = i >> 4, f = i & 15; const float ang = (float)pos * exp2f(-(float)f * 0.83048202372184059f); tab[256 + 2 * i] = cosf(ang); tab[256 + 2 * i + 1] = sinf(ang); }
    }
    LAS float* scr = (LAS float*)(lds + wave * 16384);
    const float* attn_norm = p.in[1]; const float* mlp_norm = p.in[2];
    constexpr int I_QA = 16 * (1536 / 32), I_QB = 16 * (2048 / 32), I_WO = 16 * 32, I_WOB = 18 * 32, I_W1 = 16 * 128, I_W2 = 64 * 32;
    constexpr int NITEMS = 3 * I_QA + I_QB + 3 * I_WO + I_WOB + 4 * I_W1 + 4 * I_W2;
    for (int it = gw; it < NITEMS; it += NGW) {
        int r = it;
        if (r < I_QA) { tr_item(p.in[3], 1024, 1536, 1536, WB + WE_QKV0, attn_norm + 0 * DM, 1, 24, 20, scr, r, lane); continue; } r -= I_QA;
        if (r < I_QB) { tr_item(p.in[7], 1024, 1920, 2048, WB + WE_QKV1, attn_norm + 1 * DM, 1, 30, 0, scr, r, lane); continue; } r -= I_QB;
        if (r < I_QA) { tr_item(p.in[9], 1024, 1536, 1536, WB + WE_QKV2, attn_norm + 2 * DM, 1, 24, 0, scr, r, lane); continue; } r -= I_QA;
        if (r < I_QA) { tr_item(p.in[3] + (size_t)1024 * 1536, 1024, 1536, 1536, WB + WE_QKV3, attn_norm + 3 * DM, 1, 24, 20, scr, r, lane); continue; } r -= I_QA;
        if (r < I_WO) { tr_item(p.in[6], 1024, 1024, 1024, WB + WE_WO0, nullptr, 0, 0, 0, scr, r, lane); continue; } r -= I_WO;
        if (r < I_WOB) { tr_item(p.in[8], 1152, 1024, 1024, WB + WE_WO1, nullptr, 0, 0, 0, scr, r, lane); continue; } r -= I_WOB;
        if (r < I_WO) { tr_item(p.in[11], 1024, 1024, 1024, WB + WE_WO2, nullptr, 0, 0, 0, scr, r, lane); continue; } r -= I_WO;
        if (r < I_WO) { tr_item(p.in[6] + (size_t)1024 * 1024, 1024, 1024, 1024, WB + WE_WO3, nullptr, 0, 0, 0, scr, r, lane); continue; } r -= I_WO;
        if (r < 4 * I_W1) { const int l = r / I_W1; tr_item(p.in[12] + (size_t)l * 1024 * 4096, 1024, 4096, 4096, WB + WE_W1 + (size_t)l * 4096 * 1024, mlp_norm + l * DM, 0, 0, 0, scr, r - l * I_W1, lane); continue; } r -= 4 * I_W1;
        { const int l = r / I_W2; tr_item(p.in[13] + (size_t)l * 4096 * 1024, 4096, 1024, 1024, WB + WE_W2 + (size_t)l * 4096 * 1024, nullptr, 0, 0, 0, scr, r - l * I_W2, lane); }
    }
    const float* x = p.in[0]; bf16_t* hb = (bf16_t*)(p.ws + WS_HB);
    for (int m = gw; m < MTOK; m += NGW) {
        const f32x4* xr = (const f32x4*)(x + (size_t)m * DM) + lane;
        f32x4 v[4]; float s = 0.f;
#pragma unroll
        for (int j = 0; j < 4; ++j) { v[j] = xr[64 * j]; s += (v[j].x * v[j].x + v[j].y * v[j].y) + (v[j].z * v[j].z + v[j].w * v[j].w); }
        s = wave_sum(s);
        u32x2* o8 = (u32x2*)(hb + (size_t)m * DM) + lane;
#pragma unroll
        for (int j = 0; j < 4; ++j) { u32x2 w; w.x = cvt_pk_bf16(v[j].x, v[j].y); w.y = cvt_pk_bf16(v[j].z, v[j].w); o8[64 * j] = w; }
        if (lane < 16) ss[(size_t)m * 16 + lane] = (lane == 0) ? s : 0.f;
    }
}

constexpr int AT_ROWB = 144, AT_TILEB = 64 * AT_ROWB, AT_BUFB = 2 * AT_TILEB;
template <int MODE> __device__ __forceinline__ void attn_phase(LAS unsigned char* lds, const bf16_t* __restrict__ Qg, const bf16_t* __restrict__ Kg, const bf16_t* __restrict__ Vg, bf16_t* Og, float* LSE, const float* __restrict__ sinks) {
    int tid_ = threadIdx.x; asm volatile("" : "+v"(tid_));
    const int tid = tid_, lane = tid & 63, wave = __builtin_amdgcn_readfirstlane(tid >> 6), r32 = lane & 31, hi = lane >> 5;
    constexpr int NUNITS = (MODE == 1) ? 3 * 768 : 2048;
    constexpr int HQ = (MODE == 1) ? 6 : 16, HKV = (MODE == 1) ? 2 : 4, WIN = (MODE == 1) ? 64 : 128, OPITCH = (MODE == 1) ? 1152 : 1024;
    const int srow = tid >> 3, schunk = tid & 7;
    const unsigned sdst = (unsigned)(srow * AT_ROWB + schunk * 16);
    for (int un = blockIdx.x; un < NUNITS; un += gridDim.x) {
        int g = 0, vb, hq, qb;
        if (MODE == 1) { g = un / 768; const int r = un - g * 768; const int nqbs = 4 - 2 * g;   qb = r & ((1 << nqbs) - 1); const int r2 = r >> nqbs; hq = r2 % 6; vb = r2 / 6; }
        else { qb = un & 15; hq = (un >> 4) & 15; vb = un >> 8; }
        const int gsh = 2 * g, lsh = 12 - gsh, L = 1 << lsh;
        const int kvh = (MODE == 1) ? hq / 3 : hq >> 2;
        const int q0 = qb * 256, qw = q0 + 32 * wave;
        const size_t gq = (MODE == 1) ? (size_t)g * ((size_t)NBATCH * 6 * SEQ * 64) : 0, gk = (MODE == 1) ? (size_t)g * ((size_t)NBATCH * 2 * SEQ * 64) : 0;
        bf16x8 qf[4];
        { const bf16_t* qp = Qg + gq + ((((size_t)(vb * HQ + hq)) << lsh) + qw + r32) * 64 + 8 * hi;
#pragma unroll
          for (int s = 0; s < 4; ++s) qf[s] = *(const bf16x8*)(qp + 16 * s); }
        const bf16_t* kbase = Kg + gk + (((size_t)(vb * HKV + kvh)) << lsh) * 64;
        const bf16_t* vbase = Vg + gk + ((((size_t)(vb * HKV + kvh)) * 64) << lsh);
        int lo = 0, hiT = L >> 6;
        if (MODE != 0) { lo = (q0 - WIN) >> 6; if (lo < 0) lo = 0; int h2 = ((q0 + 255 + WIN) >> 6) + 1; if (h2 < hiT) hiT = h2; }
        float slope2 = 0.f;
        if (MODE == 1) slope2 = exp2f(-8.0f * (float)(g * 6 + hq + 1) / 18.0f) * (float)(1 << gsh) * LOG2E;
        if (MODE == 2) slope2 = exp2f(-8.0f * (float)(hq + 1) / 16.0f) * LOG2E;
        float mrun = NEG_BIG, lrun = 0.f;
        if (MODE == 2) { mrun = sinks[hq] * LOG2E; lrun = (hi == 0) ? 1.f : 0.f; }
        f32x16 oacc[2];
#pragma unroll
        for (int i = 0; i < 16; ++i) { oacc[0][i] = 0.f; oacc[1][i] = 0.f; }
        u32x4 kreg, vreg;
        kreg = *(const u32x4*)(kbase + (size_t)lo * 4096 + tid * 8);
        vreg = *(const u32x4*)(vbase + ((size_t)srow << lsh) + lo * 64 + schunk * 8);
        *(LAS u32x4*)(lds + sdst) = kreg; *(LAS u32x4*)(lds + AT_TILEB + sdst) = vreg;
        __syncthreads();
        for (int kt = lo; kt < hiT; ++kt) {
            const int buf = (kt - lo) & 1;
            const bool more = (kt + 1 < hiT);
            if (more) {
                kreg = *(const u32x4*)(kbase + (size_t)(kt + 1) * 4096 + tid * 8);
                vreg = *(const u32x4*)(vbase + ((size_t)srow << lsh) + (kt + 1) * 64 + schunk * 8);
            }
            bool active = true;
            if (MODE != 0) active = !((64 * kt + 63 < qw - WIN) || (64 * kt > qw + 31 + WIN));
            if (active) {
                const LAS unsigned char* kl = lds + buf * AT_BUFB;
                const LAS unsigned char* vl = kl + AT_TILEB;
                f32x16 sacc[2];
#pragma unroll
                for (int kb = 0; kb < 2; ++kb) {
#pragma unroll
                    for (int i = 0; i < 16; ++i) sacc[kb][i] = 0.f;
#pragma unroll
                    for (int s = 0; s < 4; ++s) {
                        const bf16x8 kf = *(const LAS bf16x8*)(kl + (32 * kb + r32) * AT_ROWB + (2 * s + hi) * 16);
                        sacc[kb] = __builtin_amdgcn_mfma_f32_32x32x16_bf16(kf, qf[s], sacc[kb], 0, 0, 0);
                    }
                }
                if (MODE != 0) {
                    const float fd0 = (float)(64 * kt + 4 * hi - (qw + r32));
#pragma unroll
                    for (int kb = 0; kb < 2; ++kb)
#pragma unroll
                        for (int i = 0; i < 16; ++i) {
                            const float dist = fabsf(fd0 + (float)(32 * kb + 8 * (i >> 2) + (i & 3)));
                            sacc[kb][i] = (dist <= (float)WIN) ? (sacc[kb][i] - slope2 * dist) : NEG_BIG;
                        }
                }
                float mx = sacc[0][0];
#pragma unroll
                for (int i = 1; i < 16; ++i) mx = fmaxf(mx, sacc[0][i]);
#pragma unroll
                for (int i = 0; i < 16; ++i) mx = fmaxf(mx, sacc[1][i]);
                mx = fmaxf(mx, __shfl_xor(mx, 32));
                const float mnew = fmaxf(mrun, mx);
                const float alpha = __builtin_amdgcn_exp2f(mrun - mnew);
                mrun = mnew;
                float ps = 0.f;
#pragma unroll
                for (int kb = 0; kb < 2; ++kb)
#pragma unroll
                    for (int i = 0; i < 16; ++i) { const float pv = __builtin_amdgcn_exp2f(sacc[kb][i] - mnew); sacc[kb][i] = pv; ps += pv; }
                lrun = lrun * alpha + ps;
#pragma unroll
                for (int i = 0; i < 16; ++i) { oacc[0][i] *= alpha; oacc[1][i] *= alpha; }
                bf16x8 pf[2][2];
#pragma unroll
                for (int kb = 0; kb < 2; ++kb)
#pragma unroll
                    for (int hh = 0; hh < 2; ++hh) {
                        u32x4 w; w.x = cvt_pk_bf16(sacc[kb][8 * hh + 0], sacc[kb][8 * hh + 1]); w.y = cvt_pk_bf16(sacc[kb][8 * hh + 2], sacc[kb][8 * hh + 3]);
                        w.z = cvt_pk_bf16(sacc[kb][8 * hh + 4], sacc[kb][8 * hh + 5]); w.w = cvt_pk_bf16(sacc[kb][8 * hh + 6], sacc[kb][8 * hh + 7]);
                        pf[kb][hh] = __builtin_bit_cast(bf16x8, w);
                    }
#pragma unroll
                for (int db = 0; db < 2; ++db)
#pragma unroll
                    for (int kb = 0; kb < 2; ++kb)
#pragma unroll
                        for (int hh = 0; hh < 2; ++hh) {
                            const bf16x8 vf = *(const LAS bf16x8*)(vl + (32 * db + r32) * AT_ROWB + (2 * (2 * kb + hh) + hi) * 16);
                            oacc[db] = __builtin_amdgcn_mfma_f32_32x32x16_bf16(vf, pf[kb][hh], oacc[db], 0, 0, 0);
                        }
            }
            if (more) {
                LAS unsigned char* nb = lds + (buf ^ 1) * AT_BUFB;
                *(LAS u32x4*)(nb + sdst) = kreg; *(LAS u32x4*)(nb + AT_TILEB + sdst) = vreg;
            }
            __syncthreads();
        }
        const float ltot = lrun + __shfl_xor(lrun, 32);
        const float inv = 1.0f / ltot;
        int row, hglob;
        if (MODE == 1) { const int dmask = (1 << gsh) - 1; const int b = vb >> gsh, rr = vb & dmask; row = b * SEQ + rr + ((qw + r32) << gsh); hglob = g * 6 + hq; }
        else { row = vb * SEQ + qw + r32; hglob = hq; }
        bf16_t* op = Og + (size_t)row * OPITCH + hglob * 64 + 4 * hi;
#pragma unroll
        for (int db = 0; db < 2; ++db)
#pragma unroll
            for (int q4 = 0; q4 < 4; ++q4) {
                u32x2 w; w.x = cvt_pk_bf16(oacc[db][4 * q4 + 0] * inv, oacc[db][4 * q4 + 1] * inv); w.y = cvt_pk_bf16(oacc[db][4 * q4 + 2] * inv, oacc[db][4 * q4 + 3] * inv);
                *(u32x2*)(op + 32 * db + 8 * q4) = w;
            }
        if (MODE == 1) { if (hi == 0) LSE[(size_t)row * 18 + hglob] = mrun + __builtin_amdgcn_logf(ltot); }
    }
}

__device__ __forceinline__ void mixb_fix(bf16_t* Og, const float* LSE, int gw, int NGW, int lane) {
    asm volatile("" : "+v"(lane));
    for (int m = gw; m < MTOK; m += NGW) {
        const float* ls = LSE + (size_t)m * 18;
#pragma unroll
        for (int c3 = 0; c3 < 3; ++c3) {
            const int c = lane + 64 * c3;
            if (c < 144) {
                const int head = c >> 3, g = head / 6, kr = head - 6 * g;
                const float l0 = ls[kr], l1 = ls[6 + kr], l2 = ls[12 + kr];
                const float mx = fmaxf(l0, fmaxf(l1, l2));
                const float e0 = exp2f(l0 - mx), e1 = exp2f(l1 - mx), e2 = exp2f(l2 - mx);
                const float a = ((g == 0) ? e0 : (g == 1) ? e1 : e2) / (e0 + e1 + e2);
                u32x4* pp = (u32x4*)(Og + (size_t)m * 1152) + c;
                u32x4 w = *pp;
                unsigned ww[4] = {w.x, w.y, w.z, w.w};
#pragma unroll
                for (int k = 0; k < 4; ++k) { const float f0 = __builtin_bit_cast(float, ww[k] << 16) * a, f1 = __builtin_bit_cast(float, ww[k] & 0xffff0000u) * a; ww[k] = cvt_pk_bf16(f0, f1); }
                w.x = ww[0]; w.y = ww[1]; w.z = ww[2]; w.w = ww[3];
                *pp = w;
            }
        }
    }
}

#define XB_TMO      128
#define XB_XCNT(j)  (256  + 64 * (j))
#define XB_XSUB(j)  (1280 + 64 * (j))
#define XB_XGEN(j)  (2304 + 64 * (j))
#define XB_TOP      3328
#define XB_TOPGEN   3392
#define XCD_BAR_WORDS 3456
#define XB_SPIN_CAP (1u << 18)

__device__ __forceinline__ unsigned xb_ld(unsigned* p)              { return __hip_atomic_load(p, __ATOMIC_RELAXED, __HIP_MEMORY_SCOPE_AGENT); }
__device__ __forceinline__ unsigned xb_add(unsigned* p, unsigned v) { return __hip_atomic_fetch_add(p, v, __ATOMIC_RELAXED, __HIP_MEMORY_SCOPE_AGENT); }
__device__ __forceinline__ unsigned xb_xcc_id() { return (unsigned)__builtin_amdgcn_s_getreg((3 << 11) | 20) & 0xFu; }
#define XB_SPIN(cond, bar) do { unsigned _sp = 0; while (cond) { __builtin_amdgcn_s_sleep(1); \
    if ((++_sp & 255u) == 0u) { if (xb_ld(&(bar)[XB_TMO])) break; if (_sp > XB_SPIN_CAP) { atomicAdd(&(bar)[XB_TMO], 1u); break; } } } } while (0)

struct XcdBarrier {
    unsigned* bar; unsigned x;
    volatile LAS unsigned* st;
};

__device__ __forceinline__ XcdBarrier xcd_barrier_post(unsigned* bar, volatile LAS unsigned* st) {
    XcdBarrier b; b.bar = bar; b.x = xb_xcc_id(); b.st = st;
    if (threadIdx.x == 0) (void)xb_add(&bar[XB_XCNT(b.x)], 1u);
    return b;
}
__device__ __forceinline__ void xcd_barrier_complete(unsigned* bar, unsigned x, unsigned& nloc, unsigned& nx) {
    const unsigned G = gridDim.x * gridDim.y * gridDim.z;
    unsigned sum, cnt, mine, sp = 0u;
    for (;;) {
        sum = 0u; cnt = 0u; mine = 0u;
#pragma unroll
        for (unsigned j = 0; j < 16; ++j) { const unsigned c = xb_ld(&bar[XB_XCNT(j)]); sum += c; cnt += (c > 0u) ? 1u : 0u; mine = (j == x) ? c : mine; }
        if (sum == G) break;
        __builtin_amdgcn_s_sleep(1);
        if ((++sp & 255u) == 0u) { if (xb_ld(&bar[XB_TMO])) break; if (sp > XB_SPIN_CAP) { atomicAdd(&bar[XB_TMO], 1u); break; } }
    }
    nloc = mine > 0u ? mine : 1u; nx = cnt > 0u ? cnt : 1u;
}

__device__ __forceinline__ void xcd_barrier(const XcdBarrier& b) {
    asm volatile("s_waitcnt vmcnt(0)" ::: "memory");
    __syncthreads();
    if (threadIdx.x == 0) {
        unsigned* bar = b.bar;
        __builtin_amdgcn_s_waitcnt(0);
        unsigned nloc = b.st[0], nx = b.st[1];
        if (nloc == 0u) { xcd_barrier_complete(bar, b.x, nloc, nx); b.st[0] = nloc; b.st[1] = nx; }
        const unsigned old = xb_add(&bar[XB_XSUB(b.x)], 1u);
        const unsigned gen = old / nloc;
        if (old + 1u == (gen + 1u) * nloc) {
            __builtin_amdgcn_fence(__ATOMIC_RELEASE, "agent");
            asm volatile("s_waitcnt vmcnt(0)" ::: "memory");
            const unsigned og = xb_add(&bar[XB_TOP], 1u);
            const unsigned tg = og / nx;
            if (og + 1u == (tg + 1u) * nx) xb_add(&bar[XB_TOPGEN], 1u);
            else XB_SPIN(xb_ld(&bar[XB_TOPGEN]) == tg, bar);
            __builtin_amdgcn_fence(__ATOMIC_ACQUIRE, "agent");
            xb_add(&bar[XB_XGEN(b.x)], 1u);
            asm volatile("s_waitcnt vmcnt(0)" ::: "memory");
        } else {
            XB_SPIN(xb_ld(&bar[XB_XGEN(b.x)]) == gen, bar);
            __builtin_amdgcn_fence(__ATOMIC_ACQUIRE, "agent");
            asm volatile("s_waitcnt vmcnt(0)" ::: "memory");
        }
    }
    __syncthreads();
}

constexpr int LDS_BYTES = 147456;
__global__ void __launch_bounds__(512, 2) fwd_kernel(Params p) {
    extern __shared__ __attribute__((aligned(16))) unsigned char lds_raw[];
    LAS unsigned char* lds = (LAS unsigned char*)lds_raw;
    cg::grid_group grid = cg::this_grid();
    volatile LAS unsigned* xst = (volatile LAS unsigned*)(lds + LDS_BYTES - 64);
    if (threadIdx.x < 2) xst[threadIdx.x] = 0u;
    __syncthreads();
    XcdBarrier xbar = xcd_barrier_post((unsigned*)(p.ws + WS_BAR), xst);
#define GRID_SYNC() do { asm volatile("s_waitcnt vmcnt(0) lgkmcnt(0)" ::: "memory"); grid.sync(); asm volatile("buffer_inv sc1\n\ts_waitcnt vmcnt(0)" ::: "memory"); GRID_SYNC2(); } while (0)
#define XBAR_SYNC() do { xcd_barrier(xbar); asm volatile("buffer_inv sc1\n\ts_waitcnt vmcnt(0)" ::: "memory"); } while (0)
#ifdef PROBE_DUP_SYNC
#define GRID_SYNC2() do { grid.sync(); asm volatile("buffer_inv sc1\n\ts_waitcnt vmcnt(0)" ::: "memory"); } while (0)
#else
#define GRID_SYNC2() do { } while (0)
#endif
    const int tid = threadIdx.x, lane = tid & 63, wave = __builtin_amdgcn_readfirstlane(tid >> 6);
    const int G = gridDim.x, gw = blockIdx.x * 8 + wave, NGW = G * 8;
    unsigned char* ws = p.ws;
    float* ss = (float*)(ws + WS_SSP); float* LSE = (float*)(ws + WS_LSE);
    bf16_t* WB = (bf16_t*)(ws + WS_W); bf16_t* HB = (bf16_t*)(ws + WS_HB); bf16_t* U = (bf16_t*)(ws + WS_U);
    bf16_t* Qb = (bf16_t*)(ws + WS_Q); bf16_t* Kb = (bf16_t*)(ws + WS_K); bf16_t* Vb = (bf16_t*)(ws + WS_VT); bf16_t* Ob = (bf16_t*)(ws + WS_O);
    float* h = p.out;

#ifndef PHMASK
#define PHMASK 0xffff
#endif
    if (PHMASK & 1) prologue(p, lds, gw, NGW, wave, lane);
#ifdef PROBE_DUP_PRO
    __syncthreads(); prologue(p, lds, gw, NGW, wave, lane);
#endif
    GRID_SYNC();

#pragma unroll 1
    for (int layer = 0; layer < 4; ++layer) {
        const int kind = (layer == 3) ? 0 : layer;
        const int ja = (layer == 3) ? 1 : 0;
        const size_t weq = (layer == 0) ? WE_QKV0 : (layer == 1) ? WE_QKV1 : (layer == 2) ? WE_QKV2 : WE_QKV3;
        const size_t weo = (layer == 0) ? WE_WO0 : (layer == 1) ? WE_WO1 : (layer == 2) ? WE_WO2 : WE_WO3;
        if (kind == 0 && (PHMASK & 2)) {
            pg8::Gemm g{HB, WB + weq, MTOK, 1536, DM}; pg8::StaticOrder S; S.init(MTOK, 1536, G, (int)blockIdx.x);
            pg8::EpiQKV<0> E{ws, 2 * layer, ja};
            pg8::gemm_phase<pg8::EpiQKV<0>, pg8::StaticOrder, true, true>(lds, g, S, E);
        } else if (kind == 1 && (PHMASK & 4)) {
            pg8::Gemm g{HB, WB + weq, MTOK, 2048, DM}; pg8::StaticOrder S; S.init(MTOK, 2048, G, (int)blockIdx.x);
            pg8::EpiQKV<1> E{ws, 2 * layer, 0};
            pg8::gemm_phase<pg8::EpiQKV<1>, pg8::StaticOrder, true, true>(lds, g, S, E);
        } else if (kind == 2 && (PHMASK & 8)) {
            pg8::Gemm g{HB, WB + weq, MTOK, 1536, DM}; pg8::StaticOrder S; S.init(MTOK, 1536, G, (int)blockIdx.x);
            pg8::EpiQKV<2> E{ws, 2 * layer, 0};
            pg8::gemm_phase<pg8::EpiQKV<2>, pg8::StaticOrder, true, true>(lds, g, S, E);
        }
        XBAR_SYNC();
        if (kind == 0) { if (PHMASK & 16) attn_phase<0>(lds, Qb, Kb, Vb, Ob, LSE, nullptr);
#ifdef PROBE_DUP_A
            __syncthreads(); attn_phase<0>(lds, Qb, Kb, Vb, Ob, LSE, nullptr);
#endif
        }
        else if (kind == 1) { if (PHMASK & 32) attn_phase<1>(lds, Qb, Kb, Vb, Ob, LSE, nullptr);
#ifdef PROBE_DUP_BC
            __syncthreads(); attn_phase<1>(lds, Qb, Kb, Vb, Ob, LSE, nullptr);
#endif
            XBAR_SYNC(); mixb_fix(Ob, LSE, gw, NGW, lane); }
        else { if (PHMASK & 64) attn_phase<2>(lds, Qb, Kb, Vb, Ob, LSE, p.in[10]);
#ifdef PROBE_DUP_BC
            __syncthreads(); attn_phase<2>(lds, Qb, Kb, Vb, Ob, LSE, p.in[10]);
#endif
        }
        XBAR_SYNC();
        if (PHMASK & 128) {
            const int Ko = (kind == 1) ? 1152 : 1024;
            pg8::Gemm g{Ob, WB + weo, MTOK, DM, Ko}; pg8::StaticOrder S; S.init(MTOK, DM, G, (int)blockIdx.x);
            pg8::EpiRes E{(layer == 0) ? p.in[0] : (const float*)h, h, HB, ss + (size_t)(2 * layer + 1) * MTOK * 16};
            pg8::gemm_phase<pg8::EpiRes, pg8::StaticOrder, true, true>(lds, g, S, E);
        }
        XBAR_SYNC();
        if (PHMASK & 256) {
            pg8::Gemm g{HB, WB + WE_W1 + (size_t)layer * 4096 * 1024, MTOK, DFF, DM}; pg8::StaticOrder S; S.init(MTOK, DFF, G, (int)blockIdx.x);
            pg8::EpiMlp1 E{ss + (size_t)(2 * layer + 1) * MTOK * 16, U};
            pg8::gemm_phase<pg8::EpiMlp1, pg8::StaticOrder, true, true>(lds, g, S, E);
#ifdef PROBE_DUP_MLP1
            __syncthreads(); pg8::gemm_phase<pg8::EpiMlp1, pg8::StaticOrder, true, true>(lds, g, S, E);
#endif
        }
        XBAR_SYNC();
        if (PHMASK & 512) {
            pg8::Gemm g{U, WB + WE_W2 + (size_t)layer * 4096 * 1024, MTOK, DM, DFF}; pg8::StaticOrder S; S.init(MTOK, DM, G, (int)blockIdx.x);
            pg8::EpiRes E{h, h, HB, ss + (size_t)(2 * layer + 2) * MTOK * 16};
            pg8::gemm_phase<pg8::EpiRes, pg8::StaticOrder, true, true>(lds, g, S, E);
        }
        XBAR_SYNC();
    }
    {
        const float* fg = p.in[14]; const float* ss8 = ss + (size_t)8 * MTOK * 16;
        int lane2 = lane; asm volatile("" : "+v"(lane2));
        for (int m = gw; m < MTOK; m += NGW) {
            const float rstd = __builtin_amdgcn_rsqf(row_ss(ss8, m) * (1.0f / DM) + RMS_EPS);
            f32x4* hr = (f32x4*)(h + (size_t)m * DM) + lane2;
#pragma unroll
            for (int j = 0; j < 4; ++j) { const f32x4 gg = ((const f32x4*)fg)[64 * j + lane2]; f32x4 v = hr[64 * j]; v = v * rstd * gg; hr[64 * j] = v; }
        }
    }
}

extern "C" void kernel_launch(void* const* d_in, const int* in_sizes, int n_in, void* d_out, int out_size, void* d_ws, size_t ws_size, hipStream_t stream) {
    static int grid = 0;
    if (grid == 0) {
        if (n_in != 15 || out_size != MTOK * DM || ws_size < WS_END) { fprintf(stderr, "kernel_launch: unexpected shapes (n_in %d out %d ws %zu)\n", n_in, out_size, ws_size); grid = -1; return; }
        int dev = 0, cus = 0, per_cu = 0;
        hipGetDevice(&dev);
        hipDeviceGetAttribute(&cus, hipDeviceAttributeMultiprocessorCount, dev);
        if (hipFuncSetAttribute((const void*)fwd_kernel, hipFuncAttributeMaxDynamicSharedMemorySize, LDS_BYTES) != hipSuccess) { fprintf(stderr, "kernel_launch: hipFuncSetAttribute failed\n"); grid = -1; return; }
        if (hipOccupancyMaxActiveBlocksPerMultiprocessor(&per_cu, (const void*)fwd_kernel, 512, LDS_BYTES) != hipSuccess || per_cu < 1) { fprintf(stderr, "kernel_launch: occupancy query gave %d\n", per_cu); per_cu = 1; }
        (void)hipGetLastError();
        grid = cus * per_cu;
    }
    if (grid < 0) return;
    if (hipMemsetAsync((char*)d_ws + WS_BAR, 0, 16384, stream) != hipSuccess) { fprintf(stderr, "kernel_launch: hipMemsetAsync failed\n"); return; }
    Params p{};
    for (int i = 0; i < 15; ++i) p.in[i] = (const float*)d_in[i];
    p.out = (float*)d_out; p.ws = (unsigned char*)d_ws;
    void* args[] = {&p};
    hipError_t e = hipLaunchCooperativeKernel((const void*)fwd_kernel, dim3(grid), dim3(512), args, LDS_BYTES, stream);
    if (e != hipSuccess) fprintf(stderr, "cooperative launch failed: %s (grid %d)\n", hipGetErrorString(e), grid);
}
```

```cpp
#include <hip/hip_runtime.h>
#include <hip/hip_cooperative_groups.h>
#include <cstdio>
#include <cstdint>
namespace cg = cooperative_groups;

namespace pg8 {
#define PG8_LAS __attribute__((address_space(3)))
typedef unsigned short bf16_t;
typedef short bf16x8 __attribute__((ext_vector_type(8)));
typedef float f32x4 __attribute__((ext_vector_type(4)));
typedef unsigned u32x4 __attribute__((ext_vector_type(4)));
constexpr int BM = 256, BK = 64, HALF = 128, HTB = HALF * BK * 2  , STAGE_BYTES = 8 * HTB, NXCD = 8, WGM = 8;

__host__ __device__ __forceinline__ int lds_byte(int r, int c) { const int st = (r >> 4) * 2 + (c >> 5), rr = r & 15, cc = c & 31, ob = rr * 64 + cc * 2; return st * 1024 + (ob ^ (((ob >> 9) & 1) << 5)); }
__host__ __device__ __forceinline__ void stage_rc(int b, int& R, int& C) { const int st = b / 1024, sb = b % 1024, swz = sb ^ (((sb >> 9) & 1) << 5); R = (st >> 1) * 16 + swz / 64; C = (st & 1) * 32 + (swz % 64) / 2; }
__host__ __device__ __forceinline__ int perm32(int rho) { const int n = rho >> 4, i = rho & 15; return 8 * (i >> 2) + 4 * n + (i & 3); }

struct Unit { int pm, pn; };
struct Gemm { const bf16_t* A; const bf16_t* Bt; int M, N, K; };

struct StaticOrder {
    int nM, nN, nwg, G, c;
    __host__ __device__ void init(int M, int N, int G_, int c_) { nM = M / BM; nN = N / BM; nwg = nM * nN; G = G_; c = c_; }
    __host__ __device__ bool next(int i, Unit& u) const {
        const long L = (long)i * G + c; if (L >= nwg) return false;
        int wgid = (int)L; { const int q = nwg / NXCD, r = nwg % NXCD, xcd = wgid % NXCD, off = wgid / NXCD; wgid = (xcd < r ? xcd * (q + 1) : r * (q + 1) + (xcd - r) * q) + off; }
        const int nig = WGM * nN, gid = wgid / nig, fm = gid * WGM, gsz = (nM - fm) < WGM ? (nM - fm) : WGM;
        u.pm = fm + ((wgid % nig) % gsz); u.pn = (wgid % nig) / gsz; return true;
    }
    __device__ __forceinline__ void a_ready(const Unit&) const {}
    __device__ __forceinline__ void done(const Unit&) const {}
};

__device__ __forceinline__ unsigned cvt_pk_bf16(float lo, float hi) { unsigned r; asm volatile("v_cvt_pk_bf16_f32 %0, %1, %2" : "=v"(r) : "v"(lo), "v"(hi)); return r; }
constexpr int SEQ = 4096, NBATCH = 8, MTOK = NBATCH * SEQ, DM = 1024, DFF = 4096;
constexpr float RMS_EPS = 1e-6f;
constexpr float LOG2E = 1.4426950408889634f;
constexpr float QSCALE = 0.125f * LOG2E;
constexpr float NEG_BIG = -1.0e30f;

constexpr size_t MiB = 1u << 20;
constexpr size_t WS_SS = 0;
constexpr size_t WS_TAB = 6 * MiB;
constexpr size_t WS_BAR = 7 * MiB;
constexpr size_t WS_LSE = 2 * MiB;
constexpr size_t WS_W = 8 * MiB;
constexpr size_t WS_HB = 96 * MiB;
constexpr size_t WS_U = 160 * MiB;
constexpr size_t WS_Q = 160 * MiB, WS_K = 232 * MiB, WS_VT = 256 * MiB, WS_O = 280 * MiB;
constexpr size_t WS_SSP = 420 * MiB;
constexpr size_t WS_END = 440 * MiB;

constexpr int LDS_RSTD = 131072;
constexpr int LDS_ROPE = 139264;
constexpr int LDS_GAIN = 147456;
constexpr int LDS_BYTES = 163840;
__device__ __forceinline__ float row_ss(const float* ssp, int row) {
    const f32x4* q = (const f32x4*)(ssp + (size_t)row * 16);
    const f32x4 a = q[0], b = q[1], c = q[2], d = q[3];
    return ((a[0] + a[1]) + (a[2] + a[3])) + ((b[0] + b[1]) + (b[2] + b[3])) + (((c[0] + c[1]) + (c[2] + c[3])) + ((d[0] + d[1]) + (d[2] + d[3])));
}
__device__ __forceinline__ int perm_key(int i) { return (i & ~12) | ((i & 4) << 1) | ((i & 8) >> 1); }

template <int KIND> struct EpiQKV {
    static constexpr bool PERM = true, AFTER_DRAIN = false;
    unsigned char* ws; PG8_LAS unsigned char* lds; int ja; mutable int cnt;
    __device__ __forceinline__ void operator()(const f32x4 (&acc)[2][2][4][2], const Unit& u, int wr, int wc, int fr, int fq) const {
        asm volatile("" : "+v"(fr), "+v"(fq));
        asm volatile("" : "+s"(wr), "+s"(wc));
        constexpr int NQH = (KIND == 1) ? 18 : 16, NKH = (KIND == 1) ? 6 : 4;
        const int hcol = 4 * u.pn + wc;
        int type, hh;
        if (hcol < NQH) { type = 0; hh = hcol; } else if (hcol < NQH + NKH) { type = 1; hh = hcol - NQH; } else if (hcol < NQH + 2 * NKH) { type = 2; hh = hcol - NQH - NKH; } else { ++cnt; return; }
        const PG8_LAS float* ss = (const PG8_LAS float*)(lds + LDS_RSTD) + 256 * cnt;
        ++cnt;
        const PG8_LAS f32x4* rope = (const PG8_LAS f32x4*)(lds + LDS_ROPE);
        float gn[2][8];
        if (KIND == 0) {
            const PG8_LAS float* gsrc = (const PG8_LAS float*)(lds + LDS_GAIN) + ja * 128 + ((type == 0) ? 0 : 64);
            if (type < 2) {
#pragma unroll
                for (int bj = 0; bj < 2; ++bj)
#pragma unroll
                    for (int n = 0; n < 2; ++n)
#pragma unroll
                        for (int j = 0; j < 4; ++j) gn[bj][n * 4 + j] = gsrc[32 * bj + 16 * n + 4 * fq + j];
            }
        }
        int hin = hh, g = 0;
        if (KIND == 1) { if (type == 0) { g = hh / 6; hin = hh - 6 * g; } else { g = hh >> 1; hin = hh & 1; } }
        if (KIND == 1 && g == 1) body<2>(acc, u, wr, wc, fr, fq, type, hin, g, ss, rope, gn);
        else if (KIND == 1 && g == 2) body<4>(acc, u, wr, wc, fr, fq, type, hin, g, ss, rope, gn);
        else body<0>(acc, u, wr, wc, fr, fq, type, hin, g, ss, rope, gn);
    }
    template <int gsh> __device__ __forceinline__ void body(const f32x4 (&acc)[2][2][4][2], const Unit& u, int wr, int wc, int fr, int fq, int type, int hin, int g, const PG8_LAS float* ss, const PG8_LAS f32x4* rope, const float (&gn)[2][8]) const {
#pragma unroll
        for (int ai = 0; ai < 2; ++ai)
#pragma unroll
            for (int m = 0; m < 4; ++m) {
                int frl = fr; asm volatile("" : "+v"(frl));
                const int row = u.pm * BM + ai * HALF + wr * 64 + m * 16 + frl;
                const int b = row >> 12, t = row & (SEQ - 1);
                const float rstd = ss[ai * HALF + wr * 64 + m * 16 + frl];
                float v[2][8];
#pragma unroll
                for (int bj = 0; bj < 2; ++bj)
#pragma unroll
                    for (int n = 0; n < 2; ++n)
#pragma unroll
                        for (int j = 0; j < 4; ++j) v[bj][n * 4 + j] = acc[ai][bj][m][n][j] * rstd;
                if (KIND == 0 && type < 2) {
                    float s2 = 0.f;
#pragma unroll
                    for (int bj = 0; bj < 2; ++bj)
#pragma unroll
                        for (int e = 0; e < 8; ++e) s2 += v[bj][e] * v[bj][e];
                    s2 += __shfl_xor(s2, 16); s2 += __shfl_xor(s2, 32);
                    const float r = __builtin_amdgcn_rsqf(s2 * (1.0f / 64.0f) + RMS_EPS);
#pragma unroll
                    for (int bj = 0; bj < 2; ++bj)
#pragma unroll
                        for (int e = 0; e < 8; ++e) v[bj][e] *= r * gn[bj][e];
#pragma unroll
                    for (int bj = 0; bj < 2; ++bj) {
                        const int pos = (bj == 0) ? (t >> 6) : (t & 63);
                        const f32x4 cs0 = rope[(pos * 16 + 4 * fq) >> 1], cs1 = rope[((pos * 16 + 4 * fq) >> 1) + 1];
                        const float cc[4] = {cs0[0], cs0[2], cs1[0], cs1[2]}, sn[4] = {cs0[1], cs0[3], cs1[1], cs1[3]};
#pragma unroll
                        for (int j = 0; j < 4; ++j) {
                            const float x1 = v[bj][j], x2 = v[bj][4 + j];
                            v[bj][j] = x1 * cc[j] - x2 * sn[j]; v[bj][4 + j] = x2 * cc[j] + x1 * sn[j];
                        }
                    }
                }
                if (type == 0) {
#pragma unroll
                    for (int bj = 0; bj < 2; ++bj)
#pragma unroll
                        for (int e = 0; e < 8; ++e) v[bj][e] *= QSCALE;
                }
                const int dmask = (1 << gsh) - 1;
                const int vb = (b << gsh) + (t & dmask), idx = t >> gsh, lsh = 12 - gsh;
                if (type < 2) {
                    const int nh = (type == 0) ? ((KIND == 1) ? 6 : 16) : ((KIND == 1) ? 2 : 4);
                    unsigned char* base = ws + ((type == 0) ? WS_Q : WS_K) + ((KIND == 1) ? (size_t)g * ((size_t)NBATCH * nh * SEQ * 128) : 0);
                    const unsigned off = ((unsigned)(((vb * nh + hin) << lsh) + idx) * 64u + 8u * fq) * 2u;
#pragma unroll
                    for (int bj = 0; bj < 2; ++bj) {
                        u32x4 w; w.x = cvt_pk_bf16(v[bj][0], v[bj][1]); w.y = cvt_pk_bf16(v[bj][2], v[bj][3]); w.z = cvt_pk_bf16(v[bj][4], v[bj][5]); w.w = cvt_pk_bf16(v[bj][6], v[bj][7]);
                        *(u32x4*)(base + off + 64 * bj) = w;
                    }
                } else {
                    const int nh = (KIND == 1) ? 2 : 4;
                    unsigned char* base = ws + WS_VT + ((KIND == 1) ? (size_t)g * ((size_t)NBATCH * nh * SEQ * 128) : 0);
                    unsigned off = ((unsigned)((((vb * nh + hin) * 64 + 8 * fq) << lsh) + perm_key(idx))) * 2u;
                    const unsigned dstep = 2u << lsh;
#pragma unroll
                    for (int bj = 0; bj < 2; ++bj) {
#pragma unroll
                        for (int e = 0; e < 8; ++e) {
                            const unsigned pk = cvt_pk_bf16(v[bj][e], 0.f);
                            *(bf16_t*)(base + off) = (bf16_t)(pk & 0xffffu);
                            off += dstep;
                        }
                        off += 24u * dstep;
                    }
                }
                __builtin_amdgcn_sched_barrier(0);
            }
    }
};

struct EpiRes {
    static constexpr bool PERM = true, AFTER_DRAIN = false;
    const float* hin; float* hout; bf16_t* hb; float* ssout;
    __device__ __forceinline__ void operator()(const f32x4 (&acc)[2][2][4][2], const Unit& u, int wr, int wc, int fr, int fq) const {
        asm volatile("" : "+v"(fr), "+v"(fq));
        const unsigned o0 = (unsigned)((u.pm * BM + wr * 64 + fr) * DM + u.pn * BM + wc * 32 + 8 * fq);
        f32x4 hv[2][4];
#pragma unroll
        for (int bj = 0; bj < 2; ++bj) { hv[0][2 * bj] = *(const f32x4*)((const char*)hin + (o0 + bj * HALF) * 4u); hv[0][2 * bj + 1] = *(const f32x4*)((const char*)hin + (o0 + bj * HALF) * 4u + 16); }
#pragma unroll
        for (int it = 0; it < 8; ++it) {
            const int ai = it >> 2, m = it & 3, cur = it & 1, nxt = cur ^ 1;
            if (it + 1 < 8) {
                const int ai2 = (it + 1) >> 2, m2 = (it + 1) & 3;
                const unsigned o2 = o0 + (unsigned)((ai2 * HALF + m2 * 16) * DM);
#pragma unroll
                for (int bj = 0; bj < 2; ++bj) { hv[nxt][2 * bj] = *(const f32x4*)((const char*)hin + (o2 + bj * HALF) * 4u); hv[nxt][2 * bj + 1] = *(const f32x4*)((const char*)hin + (o2 + bj * HALF) * 4u + 16); }
            }
            const unsigned o1 = o0 + (unsigned)((ai * HALF + m * 16) * DM);
            float q = 0.f;
#pragma unroll
            for (int bj = 0; bj < 2; ++bj) {
                const unsigned o = o1 + bj * HALF;
                const f32x4 v0 = acc[ai][bj][m][0] + hv[cur][2 * bj], v1 = acc[ai][bj][m][1] + hv[cur][2 * bj + 1];
                *(f32x4*)((char*)hout + o * 4u) = v0; *(f32x4*)((char*)hout + o * 4u + 16) = v1;
                u32x4 w; w.x = cvt_pk_bf16(v0[0], v0[1]); w.y = cvt_pk_bf16(v0[2], v0[3]); w.z = cvt_pk_bf16(v1[0], v1[1]); w.w = cvt_pk_bf16(v1[2], v1[3]);
                *(u32x4*)((char*)hb + o * 2u) = w;
                q += (v0[0] * v0[0] + v0[1] * v0[1]) + (v0[2] * v0[2] + v0[3] * v0[3]) + (v1[0] * v1[0] + v1[1] * v1[1]) + (v1[2] * v1[2] + v1[3] * v1[3]);
            }
            q += __shfl_xor(q, 16); q += __shfl_xor(q, 32);
            const int row = u.pm * BM + ai * HALF + wr * 64 + m * 16 + fr;
            if (fq == 0) ssout[(size_t)row * 16 + u.pn * 4 + wc] = q;
        }
    }
};

struct EpiMlp1 {
    static constexpr bool PERM = true, AFTER_DRAIN = false;
    PG8_LAS unsigned char* lds; bf16_t* U; mutable int cnt;
    __device__ __forceinline__ void operator()(const f32x4 (&acc)[2][2][4][2], const Unit& u, int wr, int wc, int fr, int fq) const {
        const PG8_LAS float* ss = (const PG8_LAS float*)(lds + LDS_RSTD) + 256 * cnt;
        ++cnt;
#pragma unroll
        for (int ai = 0; ai < 2; ++ai)
#pragma unroll
            for (int m = 0; m < 4; ++m) {
                const int row = u.pm * BM + ai * HALF + wr * 64 + m * 16 + fr;
                const float rstd = ss[ai * HALF + wr * 64 + m * 16 + fr];
#pragma unroll
                for (int bj = 0; bj < 2; ++bj) {
                    f32x4 v0 = acc[ai][bj][m][0] * rstd, v1 = acc[ai][bj][m][1] * rstd;
#pragma unroll
                    for (int j = 0; j < 4; ++j) { const float a = fmaxf(v0[j], 0.f), c = fmaxf(v1[j], 0.f); v0[j] = a * a; v1[j] = c * c; }
                    u32x4 w; w.x = cvt_pk_bf16(v0[0], v0[1]); w.y = cvt_pk_bf16(v0[2], v0[3]); w.z = cvt_pk_bf16(v1[0], v1[1]); w.w = cvt_pk_bf16(v1[2], v1[3]);
                    *(u32x4*)((char*)U + (unsigned)(row * DFF + u.pn * BM + bj * HALF + wc * 32 + 8 * fq) * 2u) = w;
                }
            }
    }
};
template <class Epi, class Sched, bool ALIGN_EPI = false, bool SP2 = false>
__device__ __forceinline__ void gemm_phase(PG8_LAS unsigned char* lds, const Gemm g, const Sched& S, const Epi& E) {
    int tid_ = threadIdx.x; asm volatile("" : "+v"(tid_));
    const int tid = tid_, wid = __builtin_amdgcn_readfirstlane(tid >> 6), lane = tid & 63, wr = wid >> 2, wc = wid & 3, fr = lane & 15, fq = lane >> 4;
    const int K = g.K, nt = K / BK;
    unsigned voffA[2], voffB[2];
#pragma unroll
    for (int i = 0; i < 2; ++i) { int R, C; stage_rc(tid * 16 + i * 8192, R, C); const int Rb = Epi::PERM ? ((R & ~31) + perm32(R & 31)) : R;
        voffA[i] = (unsigned)(R * K + C) * 2u; voffB[i] = (unsigned)(Rb * K + C) * 2u; }
    const size_t kstep = (size_t)(BK * 2);
    const size_t hstep = (size_t)HALF * K * 2;
    const size_t tstep = 2 * hstep;
    const unsigned ldsw = (unsigned)wid * 1024u;
    const int aoff = lds_byte(wr * 64 + fr, fq * 8), boff = lds_byte(wc * 32 + fr, fq * 8);
#define PG8_SA(b, h) (((b) * 2 + (h)) * HTB)
#define PG8_SB(b, h) ((4 + (b) * 2 + (h)) * HTB)
#define PG8_STAGE(bufoff, gbase, voff) do { _Pragma("unroll") for (int _i = 0; _i < 2; ++_i) \
        __builtin_amdgcn_global_load_lds((const unsigned*)((const char*)(gbase) + (voff)[_i]), (PG8_LAS unsigned*)(lds + (bufoff) + ldsw + _i * 8192), 16, 0, 0); } while (0)
#define PG8_LDA(dst, b, h) do { _Pragma("unroll") for (int m = 0; m < 4; ++m) _Pragma("unroll") for (int k = 0; k < 2; ++k) dst[m][k] = *(const PG8_LAS bf16x8*)(lds + PG8_SA(b, h) + aoff + m * 2048 + k * 1024); } while (0)
#define PG8_LDB(dst, b, h) do { _Pragma("unroll") for (int n = 0; n < 2; ++n) _Pragma("unroll") for (int k = 0; k < 2; ++k) dst[n][k] = *(const PG8_LAS bf16x8*)(lds + PG8_SB(b, h) + boff + n * 2048 + k * 1024); } while (0)
#define PG8_MMA(ai, bj, At, Bt) do { __builtin_amdgcn_s_setprio(1); _Pragma("unroll") for (int m = 0; m < 4; ++m) _Pragma("unroll") for (int n = 0; n < 2; ++n) _Pragma("unroll") for (int k = 0; k < 2; ++k) \
        acc[ai][bj][m][n] = __builtin_amdgcn_mfma_f32_16x16x32_bf16(Bt[n][k], At[m][k], acc[ai][bj][m][n], 0, 0, 0); __builtin_amdgcn_s_setprio(0); } while (0)
#define PG8_WAIT_V(n) asm volatile("s_waitcnt vmcnt(" #n ")" ::: "memory")
#define PG8_WAIT_L(n) asm volatile("s_waitcnt lgkmcnt(" #n ")" ::: "memory")
#define PG8_BAR __builtin_amdgcn_s_barrier()
#define PG8_SCHED __builtin_amdgcn_sched_barrier(0)
    Unit cur, nxt; int ui = 0;
    if (!S.next(0, cur)) return;
    f32x4 acc[2][2][4][2];
#pragma unroll
    for (int a = 0; a < 2; ++a)
#pragma unroll
        for (int b = 0; b < 2; ++b)
#pragma unroll
            for (int m = 0; m < 4; ++m)
#pragma unroll
                for (int n = 0; n < 2; ++n) acc[a][b][m][n] = (f32x4){0.f, 0.f, 0.f, 0.f};
    bf16x8 At[4][2], B0[2][2], B1[2][2];
    const char* cA = (const char*)g.A + (size_t)cur.pm * tstep; const char* cB = (const char*)g.Bt + (size_t)cur.pn * tstep;
    S.a_ready(cur);
    if constexpr (SP2) {
        PG8_STAGE(PG8_SB(0, 0), cB, voffB); PG8_STAGE(PG8_SB(0, 1), cB + hstep, voffB); PG8_STAGE(PG8_SA(0, 0), cA, voffA); PG8_STAGE(PG8_SA(0, 1), cA + hstep, voffA);
        if (wr == 1) PG8_BAR;
        PG8_WAIT_V(2); PG8_BAR;
        PG8_STAGE(PG8_SB(1, 0), cB + kstep, voffB); PG8_STAGE(PG8_SA(1, 0), cA + kstep, voffA); PG8_STAGE(PG8_SB(1, 1), cB + hstep + kstep, voffB);
        PG8_WAIT_V(6); PG8_BAR;
    } else {
        PG8_STAGE(PG8_SB(0, 0), cB, voffB); PG8_STAGE(PG8_SA(0, 0), cA, voffA); PG8_STAGE(PG8_SB(0, 1), cB + hstep, voffB); PG8_STAGE(PG8_SA(0, 1), cA + hstep, voffA);
        if (wr == 1) PG8_BAR;
        PG8_WAIT_V(4); PG8_BAR;
        PG8_STAGE(PG8_SB(1, 0), cB + kstep, voffB); PG8_STAGE(PG8_SA(1, 0), cA + kstep, voffA); PG8_STAGE(PG8_SB(1, 1), cB + hstep + kstep, voffB);
        PG8_WAIT_V(6); PG8_BAR;
    }
    for (;;) {
        const bool has_next = S.next(ui + 1, nxt);
        const char* nA = has_next ? (const char*)g.A + (size_t)nxt.pm * tstep : cA; const char* nB = has_next ? (const char*)g.Bt + (size_t)nxt.pn * tstep : cB;
        for (int t = 0; t < nt; t += 2) {
            const bool last = (t == nt - 2);
            const char* a1 = cA + (size_t)(t + 1) * kstep;
            const char* a2 = last ? nA : cA + (size_t)(t + 2) * kstep; const char* b2 = last ? nB : cB + (size_t)(t + 2) * kstep;
            const char* a3 = a2 + kstep; const char* b3 = b2 + kstep;
            if (last && has_next) S.a_ready(nxt);
            if constexpr (SP2) {
            PG8_LDB(B0, 0, 0); PG8_LDB(B1, 0, 1); PG8_SCHED; PG8_LDA(At, 0, 0); PG8_STAGE(PG8_SA(1, 1), a1 + hstep, voffA);
            PG8_WAIT_V(8); PG8_WAIT_L(0); PG8_BAR; PG8_MMA(0, 0, At, B0); PG8_MMA(0, 1, At, B1); PG8_BAR; PG8_SCHED;
            PG8_LDA(At, 0, 1); PG8_STAGE(PG8_SB(0, 0), b2, voffB); PG8_STAGE(PG8_SB(0, 1), b2 + hstep, voffB); PG8_STAGE(PG8_SA(0, 0), a2, voffA);
            PG8_WAIT_V(8); PG8_WAIT_L(0); PG8_BAR; PG8_MMA(1, 0, At, B0); PG8_MMA(1, 1, At, B1); PG8_BAR; PG8_SCHED;
            PG8_LDB(B0, 1, 0); PG8_LDB(B1, 1, 1); PG8_SCHED; PG8_LDA(At, 1, 0); PG8_STAGE(PG8_SA(0, 1), a2 + hstep, voffA);
            PG8_WAIT_V(8); PG8_WAIT_L(0); PG8_BAR; PG8_MMA(0, 0, At, B0); PG8_MMA(0, 1, At, B1); PG8_BAR; PG8_SCHED;
            PG8_LDA(At, 1, 1); PG8_STAGE(PG8_SB(1, 0), b3, voffB); PG8_STAGE(PG8_SB(1, 1), b3 + hstep, voffB); PG8_STAGE(PG8_SA(1, 0), a3, voffA);
            PG8_WAIT_V(8); PG8_WAIT_L(0); PG8_BAR; PG8_MMA(1, 0, At, B0); PG8_MMA(1, 1, At, B1); PG8_BAR; PG8_SCHED;
            } else {
            PG8_LDB(B0, 0, 0); PG8_SCHED; PG8_LDA(At, 0, 0); PG8_STAGE(PG8_SA(1, 1), a1 + hstep, voffA);
            PG8_WAIT_L(8); PG8_BAR; PG8_WAIT_L(0); PG8_MMA(0, 0, At, B0); PG8_BAR; PG8_SCHED;
            PG8_LDB(B1, 0, 1); PG8_STAGE(PG8_SB(0, 0), b2, voffB);
            PG8_BAR; PG8_WAIT_L(0); PG8_MMA(0, 1, At, B1); PG8_BAR;
            PG8_LDA(At, 0, 1); PG8_STAGE(PG8_SA(0, 0), a2, voffA);
            PG8_BAR; PG8_WAIT_L(0); PG8_MMA(1, 0, At, B0); PG8_BAR; PG8_SCHED;
            PG8_STAGE(PG8_SB(0, 1), b2 + hstep, voffB);
            PG8_WAIT_V(6); PG8_BAR; PG8_MMA(1, 1, At, B1); PG8_BAR;
            PG8_LDB(B0, 1, 0); PG8_SCHED; PG8_LDA(At, 1, 0); PG8_STAGE(PG8_SA(0, 1), a2 + hstep, voffA);
            PG8_WAIT_L(8); PG8_BAR; PG8_WAIT_L(0); PG8_MMA(0, 0, At, B0); PG8_BAR; PG8_SCHED;
            PG8_LDB(B1, 1, 1); PG8_STAGE(PG8_SB(1, 0), b3, voffB);
            PG8_BAR; PG8_WAIT_L(0); PG8_MMA(0, 1, At, B1); PG8_BAR;
            PG8_LDA(At, 1, 1); PG8_STAGE(PG8_SA(1, 0), a3, voffA);
            PG8_BAR; PG8_WAIT_L(0); PG8_MMA(1, 0, At, B0); PG8_BAR; PG8_SCHED;
            PG8_STAGE(PG8_SB(1, 1), b3 + hstep, voffB);
            PG8_WAIT_V(6); PG8_BAR; PG8_MMA(1, 1, At, B1); PG8_BAR;
            }
        }
        if constexpr (ALIGN_EPI) { if (wr == 0) PG8_BAR; }
        if constexpr (!Epi::AFTER_DRAIN) { E(acc, cur, wr, wc, fr, fq); S.done(cur); }
        if (!has_next) break;
#pragma unroll
        for (int a = 0; a < 2; ++a)
#pragma unroll
            for (int b = 0; b < 2; ++b)
#pragma unroll
                for (int m = 0; m < 4; ++m)
#pragma unroll
                    for (int n = 0; n < 2; ++n) acc[a][b][m][n] = (f32x4){0.f, 0.f, 0.f, 0.f};
        cur = nxt; cA = nA; cB = nB; ++ui;
        if constexpr (ALIGN_EPI) { if (wr == 1) PG8_BAR; }
    }
    PG8_WAIT_V(0);
    if constexpr (!ALIGN_EPI) { if (wr == 0) PG8_BAR; }
    PG8_BAR;
    if constexpr (Epi::AFTER_DRAIN) { E.fused(acc, cur, wr, wc, fr, fq, lds, wid, lane); S.done(cur); }
#undef PG8_SA
#undef PG8_SB
#undef PG8_STAGE
#undef PG8_LDA
#undef PG8_LDB
#undef PG8_MMA
#undef PG8_WAIT_V
#undef PG8_WAIT_L
#undef PG8_BAR
#undef PG8_SCHED
}
}
using namespace pg8;
using pg8::bf16_t; using pg8::bf16x8; using pg8::f32x4; using pg8::u32x4; using pg8::cvt_pk_bf16;
#define LAS __attribute__((address_space(3)))
typedef float f32x16 __attribute__((ext_vector_type(16)));
typedef unsigned u32x2 __attribute__((ext_vector_type(2)));
#define LDS_WAIT() asm volatile("s_waitcnt lgkmcnt(0)" ::: "memory")
typedef float f32x2_t __attribute__((ext_vector_type(2)));
typedef __bf16 bf16x2_t __attribute__((ext_vector_type(2)));
__device__ __forceinline__ unsigned cvtpk_s(float lo, float hi) { f32x2_t v = {lo, hi}; bf16x2_t b = __builtin_convertvector(v, bf16x2_t); return __builtin_bit_cast(unsigned, b); }

constexpr size_t WE_QKV0 = 0, WE_QKV1 = WE_QKV0 + 1536 * 1024, WE_QKV2 = WE_QKV1 + 2048 * 1024, WE_QKV3 = WE_QKV2 + 1536 * 1024;
constexpr size_t WE_WO0 = WE_QKV3 + 1536 * 1024, WE_WO1 = WE_WO0 + 1024 * 1024, WE_WO2 = WE_WO1 + 1024 * 1152, WE_WO3 = WE_WO2 + 1024 * 1024;
constexpr size_t WE_W1 = WE_WO3 + 1024 * 1024, WE_W2 = WE_W1 + 4 * (size_t)4096 * 1024, WE_END = WE_W2 + 4 * (size_t)4096 * 1024;
static_assert(WS_W + WE_END * 2 <= WS_HB, "weights fit");

struct Params { const float* in[15]; float* out; unsigned char* ws; };

__device__ __forceinline__ float wave_sum(float v) {
#pragma unroll
    for (int o = 1; o < 64; o <<= 1) v += __shfl_xor(v, o);
    return v;
}

__device__ __forceinline__ void tr_item(const float* __restrict__ W, int K, int N, int Npad, bf16_t* WT, const float* __restrict__ gain, int mode, int nheads, int nperm, LAS float* scr, int item, int lane) {
    const int nblk = Npad >> 5, kb = item / nblk, nb = item - kb * nblk, k0 = 64 * kb, R0 = 32 * nb;
    int src0 = R0; bool valid = true, perm = false;
    if (mode == 1) { const int pn = R0 >> 8, c = R0 & 255, bj = c >> 7, wc = (c >> 5) & 3, hcol = 4 * pn + wc; valid = hcol < nheads; perm = hcol < nperm; src0 = hcol * 64 + 32 * bj; }
#pragma unroll 8
    for (int i = 0; i < 32; ++i) {
        const int kk = 2 * i + (lane >> 5);
        float w = 0.f;
        if (valid) { w = W[(size_t)(k0 + kk) * N + src0 + (lane & 31)]; if (gain) w *= gain[k0 + kk]; }
        scr[kk * 33 + (lane & 31)] = w;
    }
    LDS_WAIT();
    const int c8 = lane & 7;
#pragma unroll
    for (int jj = 0; jj < 4; ++jj) {
        const int e = (lane >> 3) + 8 * jj;
        const int se = perm ? (16 * ((e >> 2) & 1) + 4 * (e >> 3) + (e & 3)) : e;
        const LAS float* s = scr + (8 * c8) * 33 + se;
        u32x4 o; o.x = cvt_pk_bf16(s[0 * 33], s[1 * 33]); o.y = cvt_pk_bf16(s[2 * 33], s[3 * 33]); o.z = cvt_pk_bf16(s[4 * 33], s[5 * 33]); o.w = cvt_pk_bf16(s[6 * 33], s[7 * 33]);
        *(u32x4*)(WT + (size_t)(R0 + e) * K + k0 + 8 * c8) = o;
    }
    LDS_WAIT();
}

__device__ __forceinline__ void prologue(const Params& p, LAS unsigned char* lds, int gw, int NGW, int wave, int lane) {
    float* ss = (float*)(p.ws + WS_SSP);
    bf16_t* WB = (bf16_t*)(p.ws + WS_W);
    LAS float* scr = (LAS float*)(lds + wave * 16384);
    const float* attn_norm = p.in[1]; const float* mlp_norm = p.in[2];
    constexpr int I_QA = 16 * (1536 / 32), I_QB = 16 * (2048 / 32), I_WO = 16 * 32, I_WOB = 18 * 32, I_W1 = 16 * 128, I_W2 = 64 * 32;
    constexpr int NITEMS = 3 * I_QA + I_QB + 3 * I_WO + I_WOB + 4 * I_W1 + 4 * I_W2;
    for (int it = gw; it < NITEMS; it += NGW) {
        int r = it;
        if (r < I_QA) { tr_item(p.in[3], 1024, 1536, 1536, WB + WE_QKV0, attn_norm + 0 * DM, 1, 24, 20, scr, r, lane); continue; } r -= I_QA;
        if (r < I_QB) { tr_item(p.in[7], 1024, 1920, 2048, WB + WE_QKV1, attn_norm + 1 * DM, 1, 30, 0, scr, r, lane); continue; } r -= I_QB;
        if (r < I_QA) { tr_item(p.in[9], 1024, 1536, 1536, WB + WE_QKV2, attn_norm + 2 * DM, 1, 24, 0, scr, r, lane); continue; } r -= I_QA;
        if (r < I_QA) { tr_item(p.in[3] + (size_t)1024 * 1536, 1024, 1536, 1536, WB + WE_QKV3, attn_norm + 3 * DM, 1, 24, 20, scr, r, lane); continue; } r -= I_QA;
        if (r < I_WO) { tr_item(p.in[6], 1024, 1024, 1024, WB + WE_WO0, nullptr, 0, 0, 0, scr, r, lane); continue; } r -= I_WO;
        if (r < I_WOB) { tr_item(p.in[8], 1152, 1024, 1024, WB + WE_WO1, nullptr, 0, 0, 0, scr, r, lane); continue; } r -= I_WOB;
        if (r < I_WO) { tr_item(p.in[11], 1024, 1024, 1024, WB + WE_WO2, nullptr, 0, 0, 0, scr, r, lane); continue; } r -= I_WO;
        if (r < I_WO) { tr_item(p.in[6] + (size_t)1024 * 1024, 1024, 1024, 1024, WB + WE_WO3, nullptr, 0, 0, 0, scr, r, lane); continue; } r -= I_WO;
        if (r < 4 * I_W1) { const int l = r / I_W1; tr_item(p.in[12] + (size_t)l * 1024 * 4096, 1024, 4096, 4096, WB + WE_W1 + (size_t)l * 4096 * 1024, mlp_norm + l * DM, 0, 0, 0, scr, r - l * I_W1, lane); continue; } r -= 4 * I_W1;
        { const int l = r / I_W2; tr_item(p.in[13] + (size_t)l * 4096 * 1024, 4096, 1024, 1024, WB + WE_W2 + (size_t)l * 4096 * 1024, nullptr, 0, 0, 0, scr, r - l * I_W2, lane); }
    }
    const float* x = p.in[0]; bf16_t* hb = (bf16_t*)(p.ws + WS_HB);
    for (int m = gw; m < MTOK; m += NGW) {
        const f32x4* xr = (const f32x4*)(x + (size_t)m * DM) + lane;
        f32x4 v[4]; float s = 0.f;
#pragma unroll
        for (int j = 0; j < 4; ++j) { v[j] = xr[64 * j]; s += (v[j].x * v[j].x + v[j].y * v[j].y) + (v[j].z * v[j].z + v[j].w * v[j].w); }
        s = wave_sum(s);
        u32x2* o8 = (u32x2*)(hb + (size_t)m * DM) + lane;
#pragma unroll
        for (int j = 0; j < 4; ++j) { u32x2 w; w.x = cvt_pk_bf16(v[j].x, v[j].y); w.y = cvt_pk_bf16(v[j].z, v[j].w); o8[64 * j] = w; }
        if (lane < 16) ss[(size_t)m * 16 + lane] = (lane == 0) ? s : 0.f;
    }
}

constexpr int AT_ROWB = 144, AT_TILEB = 64 * AT_ROWB, AT_BUFB = 2 * AT_TILEB;
template <int MODE> __device__ __forceinline__ void attn_phase(LAS unsigned char* lds, const bf16_t* __restrict__ Qg, const bf16_t* __restrict__ Kg, const bf16_t* __restrict__ Vg, bf16_t* Og, float* LSE, const float* __restrict__ sinks) {
    int tid_ = threadIdx.x; asm volatile("" : "+v"(tid_));
    const int tid = tid_, lane = tid & 63, wave = __builtin_amdgcn_readfirstlane(tid >> 6), r32 = lane & 31, hi = lane >> 5;
    constexpr int NQ = (MODE == 0) ? 2 : 1;
    constexpr int QU = 256 * NQ;
    constexpr int NUNITS = (MODE == 1) ? 3 * 768 : 2048 / NQ;
    constexpr int HQ = (MODE == 1) ? 6 : 16, HKV = (MODE == 1) ? 2 : 4, WIN = (MODE == 1) ? 64 : 128, OPITCH = (MODE == 1) ? 1152 : 1024;
    const int srow = tid >> 3, schunk = tid & 7;
    const unsigned sdst = (unsigned)(srow * AT_ROWB + schunk * 16);
    for (int un = blockIdx.x; un < NUNITS; un += gridDim.x) {
        int g = 0, vb, hq, qb;
        if (MODE == 1) { g = un / 768; const int r = un - g * 768; const int nqbs = 4 - 2 * g;   qb = r & ((1 << nqbs) - 1); const int r2 = r >> nqbs; hq = r2 % 6; vb = r2 / 6; }
        else if (MODE == 0) { qb = un & 7; hq = (un >> 3) & 15; vb = un >> 7; }
        else { qb = un & 15; hq = (un >> 4) & 15; vb = un >> 8; }
        const int gsh = 2 * g, lsh = 12 - gsh, L = 1 << lsh;
        const int kvh = (MODE == 1) ? hq / 3 : hq >> 2;
        const int q0 = qb * QU, qw = q0 + 32 * NQ * wave;
        const size_t gq = (MODE == 1) ? (size_t)g * ((size_t)NBATCH * 6 * SEQ * 64) : 0, gk = (MODE == 1) ? (size_t)g * ((size_t)NBATCH * 2 * SEQ * 64) : 0;
        bf16x8 qf[NQ][4];
#pragma unroll
        for (int j = 0; j < NQ; ++j) {
            const bf16_t* qp = Qg + gq + ((((size_t)(vb * HQ + hq)) << lsh) + qw + 32 * j + r32) * 64 + 8 * hi;
#pragma unroll
            for (int s = 0; s < 4; ++s) qf[j][s] = *(const bf16x8*)(qp + 16 * s);
        }
        const bf16_t* kbase = Kg + gk + (((size_t)(vb * HKV + kvh)) << lsh) * 64;
        const bf16_t* vbase = Vg + gk + ((((size_t)(vb * HKV + kvh)) * 64) << lsh);
        int lo = 0, hiT = L >> 6;
        if (MODE != 0) { lo = (q0 - WIN) >> 6; if (lo < 0) lo = 0; int h2 = ((q0 + 255 + WIN) >> 6) + 1; if (h2 < hiT) hiT = h2; }
        float slope2 = 0.f;
        if (MODE == 1) slope2 = exp2f(-8.0f * (float)(g * 6 + hq + 1) / 18.0f) * (float)(1 << gsh) * LOG2E;
        if (MODE == 2) slope2 = exp2f(-8.0f * (float)(hq + 1) / 16.0f) * LOG2E;
        float mrun[NQ], lrun[NQ];
        f32x16 oacc[NQ][2];
#pragma unroll
        for (int j = 0; j < NQ; ++j) {
            mrun[j] = NEG_BIG; lrun[j] = 0.f;
            if (MODE == 2) { mrun[j] = sinks[hq] * LOG2E; lrun[j] = (hi == 0) ? 1.f : 0.f; }
#pragma unroll
            for (int i = 0; i < 16; ++i) { oacc[j][0][i] = 0.f; oacc[j][1][i] = 0.f; }
        }
        u32x4 kreg, vreg;
        kreg = *(const u32x4*)(kbase + (size_t)lo * 4096 + tid * 8);
        vreg = *(const u32x4*)(vbase + ((size_t)srow << lsh) + lo * 64 + schunk * 8);
        *(LAS u32x4*)(lds + sdst) = kreg; *(LAS u32x4*)(lds + AT_TILEB + sdst) = vreg;
        __syncthreads();
        for (int kt = lo; kt < hiT; ++kt) {
            const int buf = (kt - lo) & 1;
            const bool more = (kt + 1 < hiT);
            if (more) {
                kreg = *(const u32x4*)(kbase + (size_t)(kt + 1) * 4096 + tid * 8);
                vreg = *(const u32x4*)(vbase + ((size_t)srow << lsh) + (kt + 1) * 64 + schunk * 8);
            }
            bool active = true;
            if (MODE != 0) active = !((64 * kt + 63 < qw - WIN) || (64 * kt > qw + 31 + WIN));
            if (active) {
                const LAS unsigned char* kl = lds + buf * AT_BUFB;
                const LAS unsigned char* vl = kl + AT_TILEB;
                f32x16 sacc[NQ][2];
#pragma unroll
                for (int kb = 0; kb < 2; ++kb) {
#pragma unroll
                    for (int j = 0; j < NQ; ++j)
#pragma unroll
                        for (int i = 0; i < 16; ++i) sacc[j][kb][i] = 0.f;
#pragma unroll
                    for (int s = 0; s < 4; ++s) {
                        const bf16x8 kf = *(const LAS bf16x8*)(kl + (32 * kb + r32) * AT_ROWB + (2 * s + hi) * 16);
#pragma unroll
                        for (int j = 0; j < NQ; ++j) sacc[j][kb] = __builtin_amdgcn_mfma_f32_32x32x16_bf16(kf, qf[j][s], sacc[j][kb], 0, 0, 0);
                    }
                }
                bf16x8 pf[NQ][2][2];
#pragma unroll
                for (int j = 0; j < NQ; ++j) {
                    if (MODE != 0) {
                        const float fd0 = (float)(64 * kt + 4 * hi - (qw + r32));
#pragma unroll
                        for (int kb = 0; kb < 2; ++kb)
#pragma unroll
                            for (int i = 0; i < 16; ++i) {
                                const float dist = fabsf(fd0 + (float)(32 * kb + 8 * (i >> 2) + (i & 3)));
                                sacc[j][kb][i] = (dist <= (float)WIN) ? (sacc[j][kb][i] - slope2 * dist) : NEG_BIG;
                            }
                    }
                    float mx = sacc[j][0][0];
#pragma unroll
                    for (int i = 1; i < 16; ++i) mx = fmaxf(mx, sacc[j][0][i]);
#pragma unroll
                    for (int i = 0; i < 16; ++i) mx = fmaxf(mx, sacc[j][1][i]);
                    mx = fmaxf(mx, __shfl_xor(mx, 32));
                    if (__builtin_amdgcn_ballot_w64(mx > mrun[j]) != 0ull) {
                        const float mnew = fmaxf(mrun[j], mx);
                        const float alpha = __builtin_amdgcn_exp2f(mrun[j] - mnew);
                        mrun[j] = mnew;
                        lrun[j] *= alpha;
#pragma unroll
                        for (int i = 0; i < 16; ++i) { oacc[j][0][i] *= alpha; oacc[j][1][i] *= alpha; }
                    }
                    const float mcur = mrun[j];
                    float ps = 0.f;
#pragma unroll
                    for (int kb = 0; kb < 2; ++kb)
#pragma unroll
                        for (int i = 0; i < 16; ++i) { const float pv = __builtin_amdgcn_exp2f(sacc[j][kb][i] - mcur); sacc[j][kb][i] = pv; ps += pv; }
                    lrun[j] += ps;
#pragma unroll
                    for (int kb = 0; kb < 2; ++kb)
#pragma unroll
                        for (int hh = 0; hh < 2; ++hh) {
                            u32x4 w; w.x = cvtpk_s(sacc[j][kb][8 * hh + 0], sacc[j][kb][8 * hh + 1]); w.y = cvtpk_s(sacc[j][kb][8 * hh + 2], sacc[j][kb][8 * hh + 3]);
                            w.z = cvtpk_s(sacc[j][kb][8 * hh + 4], sacc[j][kb][8 * hh + 5]); w.w = cvtpk_s(sacc[j][kb][8 * hh + 6], sacc[j][kb][8 * hh + 7]);
                            pf[j][kb][hh] = __builtin_bit_cast(bf16x8, w);
                        }
                }
#pragma unroll
                for (int db = 0; db < 2; ++db)
#pragma unroll
                    for (int kb = 0; kb < 2; ++kb)
#pragma unroll
                        for (int hh = 0; hh < 2; ++hh) {
                            const bf16x8 vf = *(const LAS bf16x8*)(vl + (32 * db + r32) * AT_ROWB + (2 * (2 * kb + hh) + hi) * 16);
#pragma unroll
                            for (int j = 0; j < NQ; ++j) oacc[j][db] = __builtin_amdgcn_mfma_f32_32x32x16_bf16(vf, pf[j][kb][hh], oacc[j][db], 0, 0, 0);
                        }
            }
            if (more) {
                LAS unsigned char* nb = lds + (buf ^ 1) * AT_BUFB;
                *(LAS u32x4*)(nb + sdst) = kreg; *(LAS u32x4*)(nb + AT_TILEB + sdst) = vreg;
            }
            __syncthreads();
        }
#pragma unroll
        for (int j = 0; j < NQ; ++j) {
            const float ltot = lrun[j] + __shfl_xor(lrun[j], 32);
            const float inv = 1.0f / ltot;
            int row, hglob;
            if (MODE == 1) { const int dmask = (1 << gsh) - 1; const int b = vb >> gsh, rr = vb & dmask; row = b * SEQ + rr + ((qw + r32) << gsh); hglob = g * 6 + hq; }
            else { row = vb * SEQ + qw + 32 * j + r32; hglob = hq; }
            bf16_t* op = Og + (size_t)row * OPITCH + hglob * 64 + 4 * hi;
#pragma unroll
            for (int db = 0; db < 2; ++db)
#pragma unroll
                for (int q4 = 0; q4 < 4; ++q4) {
                    u32x2 w; w.x = cvtpk_s(oacc[j][db][4 * q4 + 0] * inv, oacc[j][db][4 * q4 + 1] * inv); w.y = cvtpk_s(oacc[j][db][4 * q4 + 2] * inv, oacc[j][db][4 * q4 + 3] * inv);
                    *(u32x2*)(op + 32 * db + 8 * q4) = w;
                }
            if (MODE == 1) { if (hi == 0) LSE[(size_t)row * 18 + hglob] = mrun[j] + __builtin_amdgcn_logf(ltot); }
        }
    }
}

__device__ __forceinline__ void mixb_fix(bf16_t* Og, const float* LSE, int gw, int NGW, int lane) {
    asm volatile("" : "+v"(lane));
    for (int m = gw; m < MTOK; m += NGW) {
        const float* ls = LSE + (size_t)m * 18;
#pragma unroll
        for (int c3 = 0; c3 < 3; ++c3) {
            const int c = lane + 64 * c3;
            if (c < 144) {
                const int head = c >> 3, g = head / 6, kr = head - 6 * g;
                const float l0 = ls[kr], l1 = ls[6 + kr], l2 = ls[12 + kr];
                const float mx = fmaxf(l0, fmaxf(l1, l2));
                const float e0 = exp2f(l0 - mx), e1 = exp2f(l1 - mx), e2 = exp2f(l2 - mx);
                const float a = ((g == 0) ? e0 : (g == 1) ? e1 : e2) / (e0 + e1 + e2);
                u32x4* pp = (u32x4*)(Og + (size_t)m * 1152) + c;
                u32x4 w = *pp;
                unsigned ww[4] = {w.x, w.y, w.z, w.w};
#pragma unroll
                for (int k = 0; k < 4; ++k) { const float f0 = __builtin_bit_cast(float, ww[k] << 16) * a, f1 = __builtin_bit_cast(float, ww[k] & 0xffff0000u) * a; ww[k] = cvt_pk_bf16(f0, f1); }
                w.x = ww[0]; w.y = ww[1]; w.z = ww[2]; w.w = ww[3];
                *pp = w;
            }
        }
    }
}

#define XB_TMO      128
#define XB_XCNT(j)  (256  + 64 * (j))
#define XB_XSUB(j)  (1280 + 64 * (j))
#define XB_XGEN(j)  (2304 + 64 * (j))
#define XB_TOP      3328
#define XB_TOPGEN   3392
#define XCD_BAR_WORDS 3456
#define XB_SPIN_CAP (1u << 18)

__device__ __forceinline__ unsigned xb_ld(unsigned* p)              { return __hip_atomic_load(p, __ATOMIC_RELAXED, __HIP_MEMORY_SCOPE_AGENT); }
__device__ __forceinline__ unsigned xb_add(unsigned* p, unsigned v) { return __hip_atomic_fetch_add(p, v, __ATOMIC_RELAXED, __HIP_MEMORY_SCOPE_AGENT); }
__device__ __forceinline__ unsigned xb_xcc_id() { return (unsigned)__builtin_amdgcn_s_getreg((3 << 11) | 20) & 0xFu; }
#define XB_SPIN(cond, bar) do { unsigned _sp = 0; while (cond) { __builtin_amdgcn_s_sleep(1); \
    if ((++_sp & 255u) == 0u) { if (xb_ld(&(bar)[XB_TMO])) break; if (_sp > XB_SPIN_CAP) { atomicAdd(&(bar)[XB_TMO], 1u); break; } } } } while (0)

struct XcdBarrier {
    unsigned* bar; unsigned x;
    volatile LAS unsigned* st;
};

__device__ __forceinline__ XcdBarrier xcd_barrier_post(unsigned* bar, volatile LAS unsigned* st) {
    XcdBarrier b; b.bar = bar; b.x = xb_xcc_id(); b.st = st;
    if (threadIdx.x == 0) (void)xb_add(&bar[XB_XCNT(b.x)], 1u);
    return b;
}
__device__ __forceinline__ void xcd_barrier_complete(unsigned* bar, unsigned x, unsigned& nloc, unsigned& nx) {
    const unsigned G = gridDim.x * gridDim.y * gridDim.z;
    unsigned sum, cnt, mine, sp = 0u;
    for (;;) {
        sum = 0u; cnt = 0u; mine = 0u;
#pragma unroll
        for (unsigned j = 0; j < 16; ++j) { const unsigned c = xb_ld(&bar[XB_XCNT(j)]); sum += c; cnt += (c > 0u) ? 1u : 0u; mine = (j == x) ? c : mine; }
        if (sum == G) break;
        __builtin_amdgcn_s_sleep(1);
        if ((++sp & 255u) == 0u) { if (xb_ld(&bar[XB_TMO])) break; if (sp > XB_SPIN_CAP) { atomicAdd(&bar[XB_TMO], 1u); break; } }
    }
    nloc = mine > 0u ? mine : 1u; nx = cnt > 0u ? cnt : 1u;
}

__device__ __forceinline__ void xcd_barrier(const XcdBarrier& b) {
    asm volatile("s_waitcnt vmcnt(0)" ::: "memory");
    __syncthreads();
    if (threadIdx.x == 0) {
        unsigned* bar = b.bar;
        __builtin_amdgcn_s_waitcnt(0);
        unsigned nloc = b.st[0], nx = b.st[1];
        if (nloc == 0u) { xcd_barrier_complete(bar, b.x, nloc, nx); b.st[0] = nloc; b.st[1] = nx; }
        const unsigned old = xb_add(&bar[XB_XSUB(b.x)], 1u);
        const unsigned gen = old / nloc;
        if (old + 1u == (gen + 1u) * nloc) {
            __builtin_amdgcn_fence(__ATOMIC_RELEASE, "agent");
            asm volatile("s_waitcnt vmcnt(0)" ::: "memory");
            const unsigned og = xb_add(&bar[XB_TOP], 1u);
            const unsigned tg = og / nx;
            if (og + 1u == (tg + 1u) * nx) xb_add(&bar[XB_TOPGEN], 1u);
            else XB_SPIN(xb_ld(&bar[XB_TOPGEN]) == tg, bar);
            __builtin_amdgcn_fence(__ATOMIC_ACQUIRE, "agent");
            xb_add(&bar[XB_XGEN(b.x)], 1u);
            asm volatile("s_waitcnt vmcnt(0)" ::: "memory");
        } else {
            XB_SPIN(xb_ld(&bar[XB_XGEN(b.x)]) == gen, bar);
            __builtin_amdgcn_fence(__ATOMIC_ACQUIRE, "agent");
            asm volatile("s_waitcnt vmcnt(0)" ::: "memory");
        }
    }
    __syncthreads();
}

__device__ __forceinline__ void fill_rstd(LAS unsigned char* lds, const pg8::StaticOrder& S, const float* ssp) {
    LAS float* rs = (LAS float*)(lds + LDS_RSTD);
    int tid = threadIdx.x; asm volatile("" : "+v"(tid));
    for (int i0 = 0; i0 < 8; i0 += 2) {
        pg8::Unit u; const int i = i0 + (tid >> 8);
        if (S.next(i, u)) rs[i * 256 + (tid & 255)] = __builtin_amdgcn_rsqf(row_ss(ssp, u.pm * 256 + (tid & 255)) * (1.0f / DM) + RMS_EPS);
    }
    __syncthreads();
}

__global__ void __launch_bounds__(512, 2) fwd_kernel(Params p) {
    extern __shared__ __attribute__((aligned(16))) unsigned char lds_raw[];
    LAS unsigned char* lds = (LAS unsigned char*)lds_raw;
    cg::grid_group grid = cg::this_grid();
    volatile LAS unsigned* xst = (volatile LAS unsigned*)(lds + LDS_BYTES - 64);
    if (threadIdx.x < 2) xst[threadIdx.x] = 0u;
    __syncthreads();
    XcdBarrier xbar = xcd_barrier_post((unsigned*)(p.ws + WS_BAR), xst);
    {
        LAS float* rope = (LAS float*)(lds + LDS_ROPE); LAS float* gl = (LAS float*)(lds + LDS_GAIN);
        for (int i = threadIdx.x; i < 1024; i += 512) { const int pos = i >> 4, f = i & 15; const float ang = (float)pos * exp2f(-(float)f * 0.83048202372184059f); rope[2 * i] = cosf(ang); rope[2 * i + 1] = sinf(ang); }
        if (threadIdx.x < 256) { const int i = threadIdx.x, ja = i >> 7, qk = (i >> 6) & 1, d = i & 63; gl[i] = (qk == 0 ? p.in[4] : p.in[5])[ja * 64 + d]; }
    }
#define GRID_SYNC() do { asm volatile("s_waitcnt vmcnt(0) lgkmcnt(0)" ::: "memory"); grid.sync(); asm volatile("buffer_inv sc1\n\ts_waitcnt vmcnt(0)" ::: "memory"); GRID_SYNC2(); } while (0)
#define XBAR_SYNC() do { xcd_barrier(xbar); asm volatile("buffer_inv sc1\n\ts_waitcnt vmcnt(0)" ::: "memory"); } while (0)
#ifdef PROBE_DUP_SYNC
#define GRID_SYNC2() do { grid.sync(); asm volatile("buffer_inv sc1\n\ts_waitcnt vmcnt(0)" ::: "memory"); } while (0)
#else
#define GRID_SYNC2() do { } while (0)
#endif
    const int tid = threadIdx.x, lane = tid & 63, wave = __builtin_amdgcn_readfirstlane(tid >> 6);
    const int G = gridDim.x, gw = blockIdx.x * 8 + wave, NGW = G * 8;
    unsigned char* ws = p.ws;
#define WSP() ({ unsigned char* q_ = ws; asm volatile("" : "+s"(q_)); q_; })
#define SSP(i) ((float*)(WSP() + WS_SSP) + (size_t)(i) * MTOK * 16)
#define LSE_ ((float*)(WSP() + WS_LSE))
#define WB_ ((bf16_t*)(WSP() + WS_W))
#define HB_ ((bf16_t*)(WSP() + WS_HB))
#define U_ ((bf16_t*)(WSP() + WS_U))
#define Qb_ ((bf16_t*)(WSP() + WS_Q))
#define Kb_ ((bf16_t*)(WSP() + WS_K))
#define Vb_ ((bf16_t*)(WSP() + WS_VT))
#define Ob_ ((bf16_t*)(WSP() + WS_O))
    float* h = p.out;

#ifndef PHMASK
#define PHMASK 0xffff
#endif
    if (PHMASK & 1) prologue(p, lds, gw, NGW, wave, lane);
#ifdef PROBE_DUP_PRO
    __syncthreads(); prologue(p, lds, gw, NGW, wave, lane);
#endif
    GRID_SYNC();

#pragma unroll 1
    for (int layer = 0; layer < 4; ++layer) {
        const int kind = (layer == 3) ? 0 : layer;
        const int ja = (layer == 3) ? 1 : 0;
        const size_t weq = (layer == 0) ? WE_QKV0 : (layer == 1) ? WE_QKV1 : (layer == 2) ? WE_QKV2 : WE_QKV3;
        const size_t weo = (layer == 0) ? WE_WO0 : (layer == 1) ? WE_WO1 : (layer == 2) ? WE_WO2 : WE_WO3;
        if (kind == 0 && (PHMASK & 2)) {
            pg8::Gemm g{HB_, WB_ + weq, MTOK, 1536, DM}; pg8::StaticOrder S; S.init(MTOK, 1536, G, (int)blockIdx.x);
            fill_rstd(lds, S, SSP(2 * layer));
            pg8::EpiQKV<0> E{WSP(), lds, ja, 0};
            pg8::gemm_phase<pg8::EpiQKV<0>, pg8::StaticOrder, true, true>(lds, g, S, E);
        } else if (kind == 1 && (PHMASK & 4)) {
            pg8::Gemm g{HB_, WB_ + weq, MTOK, 2048, DM}; pg8::StaticOrder S; S.init(MTOK, 2048, G, (int)blockIdx.x);
            fill_rstd(lds, S, SSP(2 * layer));
            pg8::EpiQKV<1> E{WSP(), lds, 0, 0};
            pg8::gemm_phase<pg8::EpiQKV<1>, pg8::StaticOrder, true, true>(lds, g, S, E);
        } else if (kind == 2 && (PHMASK & 8)) {
            pg8::Gemm g{HB_, WB_ + weq, MTOK, 1536, DM}; pg8::StaticOrder S; S.init(MTOK, 1536, G, (int)blockIdx.x);
            fill_rstd(lds, S, SSP(2 * layer));
            pg8::EpiQKV<2> E{WSP(), lds, 0, 0};
            pg8::gemm_phase<pg8::EpiQKV<2>, pg8::StaticOrder, true, true>(lds, g, S, E);
        }
        XBAR_SYNC();
        if (kind == 0) { if (PHMASK & 16) attn_phase<0>(lds, Qb_, Kb_, Vb_, Ob_, LSE_, nullptr);
#ifdef PROBE_DUP_A
            __syncthreads(); attn_phase<0>(lds, Qb_, Kb_, Vb_, Ob_, LSE_, nullptr);
#endif
        }
        else if (kind == 1) { if (PHMASK & 32) attn_phase<1>(lds, Qb_, Kb_, Vb_, Ob_, LSE_, nullptr);
#ifdef PROBE_DUP_BC
            __syncthreads(); attn_phase<1>(lds, Qb_, Kb_, Vb_, Ob_, LSE_, nullptr);
#endif
            XBAR_SYNC(); mixb_fix(Ob_, LSE_, gw, NGW, lane); }
        else { if (PHMASK & 64) attn_phase<2>(lds, Qb_, Kb_, Vb_, Ob_, LSE_, p.in[10]);
#ifdef PROBE_DUP_BC
            __syncthreads(); attn_phase<2>(lds, Qb_, Kb_, Vb_, Ob_, LSE_, p.in[10]);
#endif
        }
        XBAR_SYNC();
        if (PHMASK & 128) {
            const int Ko = (kind == 1) ? 1152 : 1024;
            pg8::Gemm g{Ob_, WB_ + weo, MTOK, DM, Ko}; pg8::StaticOrder S; S.init(MTOK, DM, G, (int)blockIdx.x);
            pg8::EpiRes E{(layer == 0) ? p.in[0] : (const float*)h, h, HB_, SSP(2 * layer + 1)};
            pg8::gemm_phase<pg8::EpiRes, pg8::StaticOrder, true, true>(lds, g, S, E);
        }
        XBAR_SYNC();
        if (PHMASK & 256) {
            pg8::Gemm g{HB_, WB_ + WE_W1 + (size_t)layer * 4096 * 1024, MTOK, DFF, DM}; pg8::StaticOrder S; S.init(MTOK, DFF, G, (int)blockIdx.x);
            fill_rstd(lds, S, SSP(2 * layer + 1));
            pg8::EpiMlp1 E{lds, U_, 0};
            pg8::gemm_phase<pg8::EpiMlp1, pg8::StaticOrder, true, true>(lds, g, S, E);
#ifdef PROBE_DUP_MLP1
            __syncthreads(); pg8::gemm_phase<pg8::EpiMlp1, pg8::StaticOrder, true, true>(lds, g, S, E);
#endif
        }
        XBAR_SYNC();
        if (PHMASK & 512) {
            pg8::Gemm g{U_, WB_ + WE_W2 + (size_t)layer * 4096 * 1024, MTOK, DM, DFF}; pg8::StaticOrder S; S.init(MTOK, DM, G, (int)blockIdx.x);
            pg8::EpiRes E{h, h, HB_, SSP(2 * layer + 2)};
            pg8::gemm_phase<pg8::EpiRes, pg8::StaticOrder, true, true>(lds, g, S, E);
        }
        XBAR_SYNC();
    }
    {
        const float* fg = p.in[14]; const float* ss8 = SSP(8);
        int lane2 = lane; asm volatile("" : "+v"(lane2));
        for (int m = gw; m < MTOK; m += NGW) {
            const float rstd = __builtin_amdgcn_rsqf(row_ss(ss8, m) * (1.0f / DM) + RMS_EPS);
            f32x4* hr = (f32x4*)(h + (size_t)m * DM) + lane2;
#pragma unroll
            for (int j = 0; j < 4; ++j) { const f32x4 gg = ((const f32x4*)fg)[64 * j + lane2]; f32x4 v = hr[64 * j]; v = v * rstd * gg; hr[64 * j] = v; }
        }
    }
}

extern "C" void kernel_launch(void* const* d_in, const int* in_sizes, int n_in, void* d_out, int out_size, void* d_ws, size_t ws_size, hipStream_t stream) {
    static int grid = 0;
    if (grid == 0) {
        if (n_in != 15 || out_size != MTOK * DM || ws_size < WS_END) { fprintf(stderr, "kernel_launch: unexpected shapes (n_in %d out %d ws %zu)\n", n_in, out_size, ws_size); grid = -1; return; }
        int dev = 0, cus = 0, per_cu = 0;
        hipGetDevice(&dev);
        hipDeviceGetAttribute(&cus, hipDeviceAttributeMultiprocessorCount, dev);
        if (hipFuncSetAttribute((const void*)fwd_kernel, hipFuncAttributeMaxDynamicSharedMemorySize, LDS_BYTES) != hipSuccess) { fprintf(stderr, "kernel_launch: hipFuncSetAttribute failed\n"); grid = -1; return; }
        if (hipOccupancyMaxActiveBlocksPerMultiprocessor(&per_cu, (const void*)fwd_kernel, 512, LDS_BYTES) != hipSuccess || per_cu < 1) { fprintf(stderr, "kernel_launch: occupancy query gave %d\n", per_cu); per_cu = 1; }
        (void)hipGetLastError();
        grid = cus * per_cu;
    }
    if (grid < 0) return;
    if (hipMemsetAsync((char*)d_ws + WS_BAR, 0, 16384, stream) != hipSuccess) { fprintf(stderr, "kernel_launch: hipMemsetAsync failed\n"); return; }
    Params p{};
    for (int i = 0; i < 15; ++i) p.in[i] = (const float*)d_in[i];
    p.out = (float*)d_out; p.ws = (unsigned char*)d_ws;
    void* args[] = {&p};
    hipError_t e = hipLaunchCooperativeKernel((const void*)fwd_kernel, dim3(grid), dim3(512), args, LDS_BYTES, stream);
    if (e != hipSuccess) fprintf(stderr, "cooperative launch failed: %s (grid %d)\n", hipGetErrorString(e), grid);
}
```

```cpp
#include <hip/hip_runtime.h>
#include <hip/hip_cooperative_groups.h>
#include <cstdio>
#include <cstdint>
namespace cg = cooperative_groups;

namespace pg8 {
#define PG8_LAS __attribute__((address_space(3)))
typedef unsigned short bf16_t;
typedef short bf16x8 __attribute__((ext_vector_type(8)));
typedef float f32x4 __attribute__((ext_vector_type(4)));
typedef unsigned u32x4 __attribute__((ext_vector_type(4)));
constexpr int BM = 256, BK = 64, HALF = 128, HTB = HALF * BK * 2  , STAGE_BYTES = 8 * HTB, NXCD = 8, WGM = 8;

__host__ __device__ __forceinline__ int lds_byte(int r, int c) { const int st = (r >> 4) * 2 + (c >> 5), rr = r & 15, cc = c & 31, ob = rr * 64 + cc * 2; return st * 1024 + (ob ^ (((ob >> 9) & 1) << 5)); }
__host__ __device__ __forceinline__ void stage_rc(int b, int& R, int& C) { const int st = b / 1024, sb = b % 1024, swz = sb ^ (((sb >> 9) & 1) << 5); R = (st >> 1) * 16 + swz / 64; C = (st & 1) * 32 + (swz % 64) / 2; }
__host__ __device__ __forceinline__ int perm32(int rho) { const int n = rho >> 4, i = rho & 15; return 8 * (i >> 2) + 4 * n + (i & 3); }

struct Unit { int pm, pn; };
struct Gemm { const bf16_t* A; const bf16_t* Bt; int M, N, K; };

struct StaticOrder {
    int nM, nN, nwg, G, c;
    __host__ __device__ void init(int M, int N, int G_, int c_) { nM = M / BM; nN = N / BM; nwg = nM * nN; G = G_; c = c_; }
    __host__ __device__ bool next(int i, Unit& u) const {
        const long L = (long)i * G + c; if (L >= nwg) return false;
        int wgid = (int)L; { const int q = nwg / NXCD, r = nwg % NXCD, xcd = wgid % NXCD, off = wgid / NXCD; wgid = (xcd < r ? xcd * (q + 1) : r * (q + 1) + (xcd - r) * q) + off; }
        const int nig = WGM * nN, gid = wgid / nig, fm = gid * WGM, gsz = (nM - fm) < WGM ? (nM - fm) : WGM;
        u.pm = fm + ((wgid % nig) % gsz); u.pn = (wgid % nig) / gsz; return true;
    }
    __device__ __forceinline__ void a_ready(const Unit&) const {}
    __device__ __forceinline__ void done(const Unit&) const {}
};

__device__ __forceinline__ unsigned cvt_pk_bf16(float lo, float hi) { unsigned r; asm volatile("v_cvt_pk_bf16_f32 %0, %1, %2" : "=v"(r) : "v"(lo), "v"(hi)); return r; }
constexpr int SEQ = 4096, NBATCH = 8, MTOK = NBATCH * SEQ, DM = 1024, DFF = 4096;
constexpr float RMS_EPS = 1e-6f;
constexpr float LOG2E = 1.4426950408889634f;
constexpr float QSCALE = 0.125f * LOG2E;
constexpr float NEG_BIG = -1.0e30f;

constexpr size_t MiB = 1u << 20;
constexpr size_t WS_SS = 0;
constexpr size_t WS_TAB = 6 * MiB;
constexpr size_t WS_BAR = 7 * MiB;
constexpr size_t WS_LSE = 2 * MiB;
constexpr size_t WS_W = 8 * MiB;
constexpr size_t WS_HB = 96 * MiB;
constexpr size_t WS_U = 160 * MiB;
constexpr size_t WS_Q = 160 * MiB, WS_K = 232 * MiB, WS_VT = 256 * MiB, WS_O = 280 * MiB;
constexpr size_t WS_SSP = 420 * MiB;
constexpr size_t WS_END = 440 * MiB;

constexpr int LDS_RSTD = 131072;
constexpr int LDS_ROPE = 139264;
constexpr int LDS_GAIN = 147456;
constexpr int LDS_BYTES = 163840;
__device__ __forceinline__ float row_ss(const float* ssp, int row) {
    const f32x4* q = (const f32x4*)(ssp + (size_t)row * 16);
    const f32x4 a = q[0], b = q[1], c = q[2], d = q[3];
    return ((a[0] + a[1]) + (a[2] + a[3])) + ((b[0] + b[1]) + (b[2] + b[3])) + (((c[0] + c[1]) + (c[2] + c[3])) + ((d[0] + d[1]) + (d[2] + d[3])));
}
__device__ __forceinline__ int perm_key(int i) { return (i & ~12) | ((i & 4) << 1) | ((i & 8) >> 1); }

template <int KIND> struct EpiQKV {
    static constexpr bool PERM = true, AFTER_DRAIN = false;
    unsigned char* ws; PG8_LAS unsigned char* lds; int ja; mutable int cnt;
    __device__ __forceinline__ void operator()(const f32x4 (&acc)[2][2][4][2], const Unit& u, int wr, int wc, int fr, int fq) const {
        asm volatile("" : "+v"(fr), "+v"(fq));
        asm volatile("" : "+s"(wr), "+s"(wc));
        constexpr int NQH = (KIND == 1) ? 18 : 16, NKH = (KIND == 1) ? 6 : 4;
        const int hcol = 4 * u.pn + wc;
        int type, hh;
        if (hcol < NQH) { type = 0; hh = hcol; } else if (hcol < NQH + NKH) { type = 1; hh = hcol - NQH; } else if (hcol < NQH + 2 * NKH) { type = 2; hh = hcol - NQH - NKH; } else { ++cnt; return; }
        const PG8_LAS float* ss = (const PG8_LAS float*)(lds + LDS_RSTD) + 256 * cnt;
        ++cnt;
        const PG8_LAS f32x4* rope = (const PG8_LAS f32x4*)(lds + LDS_ROPE);
        float gn[2][8];
        if (KIND == 0) {
            const PG8_LAS float* gsrc = (const PG8_LAS float*)(lds + LDS_GAIN) + ja * 128 + ((type == 0) ? 0 : 64);
            if (type < 2) {
#pragma unroll
                for (int bj = 0; bj < 2; ++bj)
#pragma unroll
                    for (int n = 0; n < 2; ++n)
#pragma unroll
                        for (int j = 0; j < 4; ++j) gn[bj][n * 4 + j] = gsrc[32 * bj + 16 * n + 4 * fq + j];
            }
        }
        int hin = hh, g = 0;
        if (KIND == 1) { if (type == 0) { g = hh / 6; hin = hh - 6 * g; } else { g = hh >> 1; hin = hh & 1; } }
        if (KIND == 1 && g == 1) body<2>(acc, u, wr, wc, fr, fq, type, hin, g, ss, rope, gn);
        else if (KIND == 1 && g == 2) body<4>(acc, u, wr, wc, fr, fq, type, hin, g, ss, rope, gn);
        else body<0>(acc, u, wr, wc, fr, fq, type, hin, g, ss, rope, gn);
    }
    template <int gsh> __device__ __forceinline__ void body(const f32x4 (&acc)[2][2][4][2], const Unit& u, int wr, int wc, int fr, int fq, int type, int hin, int g, const PG8_LAS float* ss, const PG8_LAS f32x4* rope, const float (&gn)[2][8]) const {
#pragma unroll
        for (int ai = 0; ai < 2; ++ai)
#pragma unroll
            for (int m = 0; m < 4; ++m) {
                int frl = fr; asm volatile("" : "+v"(frl));
                const int row = u.pm * BM + ai * HALF + wr * 64 + m * 16 + frl;
                const int b = row >> 12, t = row & (SEQ - 1);
                const float rstd = ss[ai * HALF + wr * 64 + m * 16 + frl];
                float v[2][8];
#pragma unroll
                for (int bj = 0; bj < 2; ++bj)
#pragma unroll
                    for (int n = 0; n < 2; ++n)
#pragma unroll
                        for (int j = 0; j < 4; ++j) v[bj][n * 4 + j] = acc[ai][bj][m][n][j] * rstd;
                if (KIND == 0 && type < 2) {
                    float s2 = 0.f;
#pragma unroll
                    for (int bj = 0; bj < 2; ++bj)
#pragma unroll
                        for (int e = 0; e < 8; ++e) s2 += v[bj][e] * v[bj][e];
                    s2 += __shfl_xor(s2, 16); s2 += __shfl_xor(s2, 32);
                    const float r = __builtin_amdgcn_rsqf(s2 * (1.0f / 64.0f) + RMS_EPS);
#pragma unroll
                    for (int bj = 0; bj < 2; ++bj)
#pragma unroll
                        for (int e = 0; e < 8; ++e) v[bj][e] *= r * gn[bj][e];
#pragma unroll
                    for (int bj = 0; bj < 2; ++bj) {
                        const int pos = (bj == 0) ? (t >> 6) : (t & 63);
                        const f32x4 cs0 = rope[(pos * 16 + 4 * fq) >> 1], cs1 = rope[((pos * 16 + 4 * fq) >> 1) + 1];
                        const float cc[4] = {cs0[0], cs0[2], cs1[0], cs1[2]}, sn[4] = {cs0[1], cs0[3], cs1[1], cs1[3]};
#pragma unroll
                        for (int j = 0; j < 4; ++j) {
                            const float x1 = v[bj][j], x2 = v[bj][4 + j];
                            v[bj][j] = x1 * cc[j] - x2 * sn[j]; v[bj][4 + j] = x2 * cc[j] + x1 * sn[j];
                        }
                    }
                }
                if (type == 0) {
#pragma unroll
                    for (int bj = 0; bj < 2; ++bj)
#pragma unroll
                        for (int e = 0; e < 8; ++e) v[bj][e] *= QSCALE;
                }
                const int dmask = (1 << gsh) - 1;
                const int vb = (b << gsh) + (t & dmask), idx = t >> gsh, lsh = 12 - gsh;
                if (type < 2) {
                    const int nh = (type == 0) ? ((KIND == 1) ? 6 : 16) : ((KIND == 1) ? 2 : 4);
                    unsigned char* base = ws + ((type == 0) ? WS_Q : WS_K) + ((KIND == 1) ? (size_t)g * ((size_t)NBATCH * nh * SEQ * 128) : 0);
                    const unsigned off = ((unsigned)(((vb * nh + hin) << lsh) + idx) * 64u + 8u * fq) * 2u;
#pragma unroll
                    for (int bj = 0; bj < 2; ++bj) {
                        u32x4 w; w.x = cvt_pk_bf16(v[bj][0], v[bj][1]); w.y = cvt_pk_bf16(v[bj][2], v[bj][3]); w.z = cvt_pk_bf16(v[bj][4], v[bj][5]); w.w = cvt_pk_bf16(v[bj][6], v[bj][7]);
                        *(u32x4*)(base + off + 64 * bj) = w;
                    }
                } else {
                    const int nh = (KIND == 1) ? 2 : 4;
                    unsigned char* base = ws + WS_VT + ((KIND == 1) ? (size_t)g * ((size_t)NBATCH * nh * SEQ * 128) : 0);
                    unsigned off = ((unsigned)((((vb * nh + hin) * 64 + 8 * fq) << lsh) + perm_key(idx))) * 2u;
                    const unsigned dstep = 2u << lsh;
#pragma unroll
                    for (int bj = 0; bj < 2; ++bj) {
#pragma unroll
                        for (int e = 0; e < 8; ++e) {
                            const unsigned pk = cvt_pk_bf16(v[bj][e], 0.f);
                            *(bf16_t*)(base + off) = (bf16_t)(pk & 0xffffu);
                            off += dstep;
                        }
                        off += 24u * dstep;
                    }
                }
                __builtin_amdgcn_sched_barrier(0);
            }
    }
};

struct EpiRes {
    static constexpr bool PERM = true, AFTER_DRAIN = false;
    const float* hin; float* hout; bf16_t* hb; float* ssout;
    __device__ __forceinline__ void operator()(const f32x4 (&acc)[2][2][4][2], const Unit& u, int wr, int wc, int fr, int fq) const {
        asm volatile("" : "+v"(fr), "+v"(fq));
        const unsigned o0 = (unsigned)((u.pm * BM + wr * 64 + fr) * DM + u.pn * BM + wc * 32 + 8 * fq);
        f32x4 hv[2][4];
#pragma unroll
        for (int bj = 0; bj < 2; ++bj) { hv[0][2 * bj] = *(const f32x4*)((const char*)hin + (o0 + bj * HALF) * 4u); hv[0][2 * bj + 1] = *(const f32x4*)((const char*)hin + (o0 + bj * HALF) * 4u + 16); }
#pragma unroll
        for (int it = 0; it < 8; ++it) {
            const int ai = it >> 2, m = it & 3, cur = it & 1, nxt = cur ^ 1;
            if (it + 1 < 8) {
                const int ai2 = (it + 1) >> 2, m2 = (it + 1) & 3;
                const unsigned o2 = o0 + (unsigned)((ai2 * HALF + m2 * 16) * DM);
#pragma unroll
                for (int bj = 0; bj < 2; ++bj) { hv[nxt][2 * bj] = *(const f32x4*)((const char*)hin + (o2 + bj * HALF) * 4u); hv[nxt][2 * bj + 1] = *(const f32x4*)((const char*)hin + (o2 + bj * HALF) * 4u + 16); }
            }
            const unsigned o1 = o0 + (unsigned)((ai * HALF + m * 16) * DM);
            float q = 0.f;
#pragma unroll
            for (int bj = 0; bj < 2; ++bj) {
                const unsigned o = o1 + bj * HALF;
                const f32x4 v0 = acc[ai][bj][m][0] + hv[cur][2 * bj], v1 = acc[ai][bj][m][1] + hv[cur][2 * bj + 1];
                *(f32x4*)((char*)hout + o * 4u) = v0; *(f32x4*)((char*)hout + o * 4u + 16) = v1;
                u32x4 w; w.x = cvt_pk_bf16(v0[0], v0[1]); w.y = cvt_pk_bf16(v0[2], v0[3]); w.z = cvt_pk_bf16(v1[0], v1[1]); w.w = cvt_pk_bf16(v1[2], v1[3]);
                *(u32x4*)((char*)hb + o * 2u) = w;
                q += (v0[0] * v0[0] + v0[1] * v0[1]) + (v0[2] * v0[2] + v0[3] * v0[3]) + (v1[0] * v1[0] + v1[1] * v1[1]) + (v1[2] * v1[2] + v1[3] * v1[3]);
            }
            q += __shfl_xor(q, 16); q += __shfl_xor(q, 32);
            const int row = u.pm * BM + ai * HALF + wr * 64 + m * 16 + fr;
            if (fq == 0) ssout[(size_t)row * 16 + u.pn * 4 + wc] = q;
        }
    }
};

struct EpiMlp1 {
    static constexpr bool PERM = true, AFTER_DRAIN = false;
    PG8_LAS unsigned char* lds; bf16_t* U; mutable int cnt;
    __device__ __forceinline__ void operator()(const f32x4 (&acc)[2][2][4][2], const Unit& u, int wr, int wc, int fr, int fq) const {
        const PG8_LAS float* ss = (const PG8_LAS float*)(lds + LDS_RSTD) + 256 * cnt;
        ++cnt;
#pragma unroll
        for (int ai = 0; ai < 2; ++ai)
#pragma unroll
            for (int m = 0; m < 4; ++m) {
                const int row = u.pm * BM + ai * HALF + wr * 64 + m * 16 + fr;
                const float rstd = ss[ai * HALF + wr * 64 + m * 16 + fr];
#pragma unroll
                for (int bj = 0; bj < 2; ++bj) {
                    f32x4 v0 = acc[ai][bj][m][0] * rstd, v1 = acc[ai][bj][m][1] * rstd;
#pragma unroll
                    for (int j = 0; j < 4; ++j) { const float a = fmaxf(v0[j], 0.f), c = fmaxf(v1[j], 0.f); v0[j] = a * a; v1[j] = c * c; }
                    u32x4 w; w.x = cvt_pk_bf16(v0[0], v0[1]); w.y = cvt_pk_bf16(v0[2], v0[3]); w.z = cvt_pk_bf16(v1[0], v1[1]); w.w = cvt_pk_bf16(v1[2], v1[3]);
                    *(u32x4*)((char*)U + (unsigned)(row * DFF + u.pn * BM + bj * HALF + wc * 32 + 8 * fq) * 2u) = w;
                }
            }
    }
};
template <class Epi, class Sched, bool ALIGN_EPI = false, bool SP2 = false>
__device__ __forceinline__ void gemm_phase(PG8_LAS unsigned char* lds, const Gemm g, const Sched& S, const Epi& E) {
    int tid_ = threadIdx.x; asm volatile("" : "+v"(tid_));
    const int tid = tid_, wid = __builtin_amdgcn_readfirstlane(tid >> 6), lane = tid & 63, wr = wid >> 2, wc = wid & 3, fr = lane & 15, fq = lane >> 4;
    const int K = g.K, nt = K / BK;
    unsigned voffA[2], voffB[2];
#pragma unroll
    for (int i = 0; i < 2; ++i) { int R, C; stage_rc(tid * 16 + i * 8192, R, C); const int Rb = Epi::PERM ? ((R & ~31) + perm32(R & 31)) : R;
        voffA[i] = (unsigned)(R * K + C) * 2u; voffB[i] = (unsigned)(Rb * K + C) * 2u; }
    const size_t kstep = (size_t)(BK * 2);
    const size_t hstep = (size_t)HALF * K * 2;
    const size_t tstep = 2 * hstep;
    const unsigned ldsw = (unsigned)wid * 1024u;
    const int aoff = lds_byte(wr * 64 + fr, fq * 8), boff = lds_byte(wc * 32 + fr, fq * 8);
#define PG8_SA(b, h) (((b) * 2 + (h)) * HTB)
#define PG8_SB(b, h) ((4 + (b) * 2 + (h)) * HTB)
#define PG8_STAGE(bufoff, gbase, voff) do { _Pragma("unroll") for (int _i = 0; _i < 2; ++_i) \
        __builtin_amdgcn_global_load_lds((const unsigned*)((const char*)(gbase) + (voff)[_i]), (PG8_LAS unsigned*)(lds + (bufoff) + ldsw + _i * 8192), 16, 0, 0); } while (0)
#define PG8_LDA(dst, b, h) do { _Pragma("unroll") for (int m = 0; m < 4; ++m) _Pragma("unroll") for (int k = 0; k < 2; ++k) dst[m][k] = *(const PG8_LAS bf16x8*)(lds + PG8_SA(b, h) + aoff + m * 2048 + k * 1024); } while (0)
#define PG8_LDB(dst, b, h) do { _Pragma("unroll") for (int n = 0; n < 2; ++n) _Pragma("unroll") for (int k = 0; k < 2; ++k) dst[n][k] = *(const PG8_LAS bf16x8*)(lds + PG8_SB(b, h) + boff + n * 2048 + k * 1024); } while (0)
#define PG8_MMA(ai, bj, At, Bt) do { __builtin_amdgcn_s_setprio(1); _Pragma("unroll") for (int m = 0; m < 4; ++m) _Pragma("unroll") for (int n = 0; n < 2; ++n) _Pragma("unroll") for (int k = 0; k < 2; ++k) \
        acc[ai][bj][m][n] = __builtin_amdgcn_mfma_f32_16x16x32_bf16(Bt[n][k], At[m][k], acc[ai][bj][m][n], 0, 0, 0); __builtin_amdgcn_s_setprio(0); } while (0)
#define PG8_WAIT_V(n) asm volatile("s_waitcnt vmcnt(" #n ")" ::: "memory")
#define PG8_WAIT_L(n) asm volatile("s_waitcnt lgkmcnt(" #n ")" ::: "memory")
#define PG8_BAR __builtin_amdgcn_s_barrier()
#define PG8_SCHED __builtin_amdgcn_sched_barrier(0)
    Unit cur, nxt; int ui = 0;
    if (!S.next(0, cur)) return;
    f32x4 acc[2][2][4][2];
#pragma unroll
    for (int a = 0; a < 2; ++a)
#pragma unroll
        for (int b = 0; b < 2; ++b)
#pragma unroll
            for (int m = 0; m < 4; ++m)
#pragma unroll
                for (int n = 0; n < 2; ++n) acc[a][b][m][n] = (f32x4){0.f, 0.f, 0.f, 0.f};
    bf16x8 At[4][2], B0[2][2], B1[2][2];
    const char* cA = (const char*)g.A + (size_t)cur.pm * tstep; const char* cB = (const char*)g.Bt + (size_t)cur.pn * tstep;
    S.a_ready(cur);
    if constexpr (SP2) {
        PG8_STAGE(PG8_SB(0, 0), cB, voffB); PG8_STAGE(PG8_SB(0, 1), cB + hstep, voffB); PG8_STAGE(PG8_SA(0, 0), cA, voffA); PG8_STAGE(PG8_SA(0, 1), cA + hstep, voffA);
        if (wr == 1) PG8_BAR;
        PG8_WAIT_V(2); PG8_BAR;
        PG8_STAGE(PG8_SB(1, 0), cB + kstep, voffB); PG8_STAGE(PG8_SA(1, 0), cA + kstep, voffA); PG8_STAGE(PG8_SB(1, 1), cB + hstep + kstep, voffB);
        PG8_WAIT_V(6); PG8_BAR;
    } else {
        PG8_STAGE(PG8_SB(0, 0), cB, voffB); PG8_STAGE(PG8_SA(0, 0), cA, voffA); PG8_STAGE(PG8_SB(0, 1), cB + hstep, voffB); PG8_STAGE(PG8_SA(0, 1), cA + hstep, voffA);
        if (wr == 1) PG8_BAR;
        PG8_WAIT_V(4); PG8_BAR;
        PG8_STAGE(PG8_SB(1, 0), cB + kstep, voffB); PG8_STAGE(PG8_SA(1, 0), cA + kstep, voffA); PG8_STAGE(PG8_SB(1, 1), cB + hstep + kstep, voffB);
        PG8_WAIT_V(6); PG8_BAR;
    }
    for (;;) {
        const bool has_next = S.next(ui + 1, nxt);
        const char* nA = has_next ? (const char*)g.A + (size_t)nxt.pm * tstep : cA; const char* nB = has_next ? (const char*)g.Bt + (size_t)nxt.pn * tstep : cB;
        for (int t = 0; t < nt; t += 2) {
            const bool last = (t == nt - 2);
            const char* a1 = cA + (size_t)(t + 1) * kstep;
            const char* a2 = last ? nA : cA + (size_t)(t + 2) * kstep; const char* b2 = last ? nB : cB + (size_t)(t + 2) * kstep;
            const char* a3 = a2 + kstep; const char* b3 = b2 + kstep;
            if (last && has_next) S.a_ready(nxt);
            if constexpr (SP2) {
            PG8_LDB(B0, 0, 0); PG8_LDB(B1, 0, 1); PG8_SCHED; PG8_LDA(At, 0, 0); PG8_STAGE(PG8_SA(1, 1), a1 + hstep, voffA);
            PG8_WAIT_V(8); PG8_WAIT_L(0); PG8_BAR; PG8_MMA(0, 0, At, B0); PG8_MMA(0, 1, At, B1); PG8_BAR; PG8_SCHED;
            PG8_LDA(At, 0, 1); PG8_STAGE(PG8_SB(0, 0), b2, voffB); PG8_STAGE(PG8_SB(0, 1), b2 + hstep, voffB); PG8_STAGE(PG8_SA(0, 0), a2, voffA);
            PG8_WAIT_V(8); PG8_WAIT_L(0); PG8_BAR; PG8_MMA(1, 0, At, B0); PG8_MMA(1, 1, At, B1); PG8_BAR; PG8_SCHED;
            PG8_LDB(B0, 1, 0); PG8_LDB(B1, 1, 1); PG8_SCHED; PG8_LDA(At, 1, 0); PG8_STAGE(PG8_SA(0, 1), a2 + hstep, voffA);
            PG8_WAIT_V(8); PG8_WAIT_L(0); PG8_BAR; PG8_MMA(0, 0, At, B0); PG8_MMA(0, 1, At, B1); PG8_BAR; PG8_SCHED;
            PG8_LDA(At, 1, 1); PG8_STAGE(PG8_SB(1, 0), b3, voffB); PG8_STAGE(PG8_SB(1, 1), b3 + hstep, voffB); PG8_STAGE(PG8_SA(1, 0), a3, voffA);
            PG8_WAIT_V(8); PG8_WAIT_L(0); PG8_BAR; PG8_MMA(1, 0, At, B0); PG8_MMA(1, 1, At, B1); PG8_BAR; PG8_SCHED;
            } else {
            PG8_LDB(B0, 0, 0); PG8_SCHED; PG8_LDA(At, 0, 0); PG8_STAGE(PG8_SA(1, 1), a1 + hstep, voffA);
            PG8_WAIT_L(8); PG8_BAR; PG8_WAIT_L(0); PG8_MMA(0, 0, At, B0); PG8_BAR; PG8_SCHED;
            PG8_LDB(B1, 0, 1); PG8_STAGE(PG8_SB(0, 0), b2, voffB);
            PG8_BAR; PG8_WAIT_L(0); PG8_MMA(0, 1, At, B1); PG8_BAR;
            PG8_LDA(At, 0, 1); PG8_STAGE(PG8_SA(0, 0), a2, voffA);
            PG8_BAR; PG8_WAIT_L(0); PG8_MMA(1, 0, At, B0); PG8_BAR; PG8_SCHED;
            PG8_STAGE(PG8_SB(0, 1), b2 + hstep, voffB);
            PG8_WAIT_V(6); PG8_BAR; PG8_MMA(1, 1, At, B1); PG8_BAR;
            PG8_LDB(B0, 1, 0); PG8_SCHED; PG8_LDA(At, 1, 0); PG8_STAGE(PG8_SA(0, 1), a2 + hstep, voffA);
            PG8_WAIT_L(8); PG8_BAR; PG8_WAIT_L(0); PG8_MMA(0, 0, At, B0); PG8_BAR; PG8_SCHED;
            PG8_LDB(B1, 1, 1); PG8_STAGE(PG8_SB(1, 0), b3, voffB);
            PG8_BAR; PG8_WAIT_L(0); PG8_MMA(0, 1, At, B1); PG8_BAR;
            PG8_LDA(At, 1, 1); PG8_STAGE(PG8_SA(1, 0), a3, voffA);
            PG8_BAR; PG8_WAIT_L(0); PG8_MMA(1, 0, At, B0); PG8_BAR; PG8_SCHED;
            PG8_STAGE(PG8_SB(1, 1), b3 + hstep, voffB);
            PG8_WAIT_V(6); PG8_BAR; PG8_MMA(1, 1, At, B1); PG8_BAR;
            }
        }
        if constexpr (ALIGN_EPI) { if (wr == 0) PG8_BAR; }
        if constexpr (!Epi::AFTER_DRAIN) { E(acc, cur, wr, wc, fr, fq); S.done(cur); }
        if (!has_next) break;
#pragma unroll
        for (int a = 0; a < 2; ++a)
#pragma unroll
            for (int b = 0; b < 2; ++b)
#pragma unroll
                for (int m = 0; m < 4; ++m)
#pragma unroll
                    for (int n = 0; n < 2; ++n) acc[a][b][m][n] = (f32x4){0.f, 0.f, 0.f, 0.f};
        cur = nxt; cA = nA; cB = nB; ++ui;
        if constexpr (ALIGN_EPI) { if (wr == 1) PG8_BAR; }
    }
    PG8_WAIT_V(0);
    if constexpr (!ALIGN_EPI) { if (wr == 0) PG8_BAR; }
    PG8_BAR;
    if constexpr (Epi::AFTER_DRAIN) { E.fused(acc, cur, wr, wc, fr, fq, lds, wid, lane); S.done(cur); }
#undef PG8_SA
#undef PG8_SB
#undef PG8_STAGE
#undef PG8_LDA
#undef PG8_LDB
#undef PG8_MMA
#undef PG8_WAIT_V
#undef PG8_WAIT_L
#undef PG8_BAR
#undef PG8_SCHED
}
}
using namespace pg8;
using pg8::bf16_t; using pg8::bf16x8; using pg8::f32x4; using pg8::u32x4; using pg8::cvt_pk_bf16;
#define LAS __attribute__((address_space(3)))
typedef float f32x16 __attribute__((ext_vector_type(16)));
typedef unsigned u32x2 __attribute__((ext_vector_type(2)));
#define LDS_WAIT() asm volatile("s_waitcnt lgkmcnt(0)" ::: "memory")
typedef float f32x2_t __attribute__((ext_vector_type(2)));
typedef __bf16 bf16x2_t __attribute__((ext_vector_type(2)));
__device__ __forceinline__ unsigned cvtpk_s(float lo, float hi) { f32x2_t v = {lo, hi}; bf16x2_t b = __builtin_convertvector(v, bf16x2_t); return __builtin_bit_cast(unsigned, b); }

constexpr size_t WE_QKV0 = 0, WE_QKV1 = WE_QKV0 + 1536 * 1024, WE_QKV2 = WE_QKV1 + 2048 * 1024, WE_QKV3 = WE_QKV2 + 1536 * 1024;
constexpr size_t WE_WO0 = WE_QKV3 + 1536 * 1024, WE_WO1 = WE_WO0 + 1024 * 1024, WE_WO2 = WE_WO1 + 1024 * 1152, WE_WO3 = WE_WO2 + 1024 * 1024;
constexpr size_t WE_W1 = WE_WO3 + 1024 * 1024, WE_W2 = WE_W1 + 4 * (size_t)4096 * 1024, WE_END = WE_W2 + 4 * (size_t)4096 * 1024;
static_assert(WS_W + WE_END * 2 <= WS_HB, "weights fit");

struct Params { const float* in[15]; float* out; unsigned char* ws; };

__device__ __forceinline__ float wave_sum(float v) {
#pragma unroll
    for (int o = 1; o < 64; o <<= 1) v += __shfl_xor(v, o);
    return v;
}

__device__ __forceinline__ void tr_item(const float* __restrict__ W, int K, int N, int Npad, bf16_t* WT, const float* __restrict__ gain, int mode, int nheads, int nperm, LAS float* scr, int item, int lane) {
    const int nblk = Npad >> 5, kb = item / nblk, nb = item - kb * nblk, k0 = 64 * kb, R0 = 32 * nb;
    int src0 = R0; bool valid = true, perm = false;
    if (mode == 1) { const int pn = R0 >> 8, c = R0 & 255, bj = c >> 7, wc = (c >> 5) & 3, hcol = 4 * pn + wc; valid = hcol < nheads; perm = hcol < nperm; src0 = hcol * 64 + 32 * bj; }
#pragma unroll 8
    for (int i = 0; i < 32; ++i) {
        const int kk = 2 * i + (lane >> 5);
        float w = 0.f;
        if (valid) { w = W[(size_t)(k0 + kk) * N + src0 + (lane & 31)]; if (gain) w *= gain[k0 + kk]; }
        scr[kk * 33 + (lane & 31)] = w;
    }
    LDS_WAIT();
    const int c8 = lane & 7;
#pragma unroll
    for (int jj = 0; jj < 4; ++jj) {
        const int e = (lane >> 3) + 8 * jj;
        const int se = perm ? (16 * ((e >> 2) & 1) + 4 * (e >> 3) + (e & 3)) : e;
        const LAS float* s = scr + (8 * c8) * 33 + se;
        u32x4 o; o.x = cvt_pk_bf16(s[0 * 33], s[1 * 33]); o.y = cvt_pk_bf16(s[2 * 33], s[3 * 33]); o.z = cvt_pk_bf16(s[4 * 33], s[5 * 33]); o.w = cvt_pk_bf16(s[6 * 33], s[7 * 33]);
        *(u32x4*)(WT + (size_t)(R0 + e) * K + k0 + 8 * c8) = o;
    }
    LDS_WAIT();
}

__device__ __forceinline__ void prologue(const Params& p, LAS unsigned char* lds, int gw, int NGW, int wave, int lane) {
    float* ss = (float*)(p.ws + WS_SSP);
    bf16_t* WB = (bf16_t*)(p.ws + WS_W);
    LAS float* scr = (LAS float*)(lds + wave * 16384);
    const float* attn_norm = p.in[1]; const float* mlp_norm = p.in[2];
    constexpr int I_QA = 16 * (1536 / 32), I_QB = 16 * (2048 / 32), I_WO = 16 * 32, I_WOB = 18 * 32, I_W1 = 16 * 128, I_W2 = 64 * 32;
    constexpr int NITEMS = 3 * I_QA + I_QB + 3 * I_WO + I_WOB + 4 * I_W1 + 4 * I_W2;
    for (int it = gw; it < NITEMS; it += NGW) {
        int r = it;
        if (r < I_QA) { tr_item(p.in[3], 1024, 1536, 1536, WB + WE_QKV0, attn_norm + 0 * DM, 1, 24, 20, scr, r, lane); continue; } r -= I_QA;
        if (r < I_QB) { tr_item(p.in[7], 1024, 1920, 2048, WB + WE_QKV1, attn_norm + 1 * DM, 1, 30, 0, scr, r, lane); continue; } r -= I_QB;
        if (r < I_QA) { tr_item(p.in[9], 1024, 1536, 1536, WB + WE_QKV2, attn_norm + 2 * DM, 1, 24, 0, scr, r, lane); continue; } r -= I_QA;
        if (r < I_QA) { tr_item(p.in[3] + (size_t)1024 * 1536, 1024, 1536, 1536, WB + WE_QKV3, attn_norm + 3 * DM, 1, 24, 20, scr, r, lane); continue; } r -= I_QA;
        if (r < I_WO) { tr_item(p.in[6], 1024, 1024, 1024, WB + WE_WO0, nullptr, 0, 0, 0, scr, r, lane); continue; } r -= I_WO;
        if (r < I_WOB) { tr_item(p.in[8], 1152, 1024, 1024, WB + WE_WO1, nullptr, 0, 0, 0, scr, r, lane); continue; } r -= I_WOB;
        if (r < I_WO) { tr_item(p.in[11], 1024, 1024, 1024, WB + WE_WO2, nullptr, 0, 0, 0, scr, r, lane); continue; } r -= I_WO;
        if (r < I_WO) { tr_item(p.in[6] + (size_t)1024 * 1024, 1024, 1024, 1024, WB + WE_WO3, nullptr, 0, 0, 0, scr, r, lane); continue; } r -= I_WO;
        if (r < 4 * I_W1) { const int l = r / I_W1; tr_item(p.in[12] + (size_t)l * 1024 * 4096, 1024, 4096, 4096, WB + WE_W1 + (size_t)l * 4096 * 1024, mlp_norm + l * DM, 0, 0, 0, scr, r - l * I_W1, lane); continue; } r -= 4 * I_W1;
        { const int l = r / I_W2; tr_item(p.in[13] + (size_t)l * 4096 * 1024, 4096, 1024, 1024, WB + WE_W2 + (size_t)l * 4096 * 1024, nullptr, 0, 0, 0, scr, r - l * I_W2, lane); }
    }
    const float* x = p.in[0]; bf16_t* hb = (bf16_t*)(p.ws + WS_HB);
    for (int m = gw; m < MTOK; m += NGW) {
        const f32x4* xr = (const f32x4*)(x + (size_t)m * DM) + lane;
        f32x4 v[4]; float s = 0.f;
#pragma unroll
        for (int j = 0; j < 4; ++j) { v[j] = xr[64 * j]; s += (v[j].x * v[j].x + v[j].y * v[j].y) + (v[j].z * v[j].z + v[j].w * v[j].w); }
        s = wave_sum(s);
        u32x2* o8 = (u32x2*)(hb + (size_t)m * DM) + lane;
#pragma unroll
        for (int j = 0; j < 4; ++j) { u32x2 w; w.x = cvt_pk_bf16(v[j].x, v[j].y); w.y = cvt_pk_bf16(v[j].z, v[j].w); o8[64 * j] = w; }
        if (lane < 16) ss[(size_t)m * 16 + lane] = (lane == 0) ? s : 0.f;
    }
}

constexpr int AT_ROWB = 144, AT_TILEB = 64 * AT_ROWB, AT_BUFB = 2 * AT_TILEB;
template <int MODE> __device__ __forceinline__ void attn_phase(LAS unsigned char* lds, const bf16_t* __restrict__ Qg, const bf16_t* __restrict__ Kg, const bf16_t* __restrict__ Vg, bf16_t* Og, float* LSE, const float* __restrict__ sinks) {
    int tid_ = threadIdx.x; asm volatile("" : "+v"(tid_));
    const int tid = tid_, lane = tid & 63, wave = __builtin_amdgcn_readfirstlane(tid >> 6), r32 = lane & 31, hi = lane >> 5;
    constexpr int NQ = (MODE == 0) ? 2 : 1;
    constexpr int QU = 256 * NQ;
    constexpr int NUNITS = (MODE == 1) ? 3 * 768 : 2048 / NQ;
    constexpr int HQ = (MODE == 1) ? 6 : 16, HKV = (MODE == 1) ? 2 : 4, WIN = (MODE == 1) ? 64 : 128, OPITCH = (MODE == 1) ? 1152 : 1024;
    const int srow = tid >> 3, schunk = tid & 7;
    const unsigned sdst = (unsigned)(srow * AT_ROWB + schunk * 16);
    for (int un = blockIdx.x; un < NUNITS; un += gridDim.x) {
        int g = 0, vb, hq, qb;
        if (MODE == 1) { g = un / 768; const int r = un - g * 768; const int nqbs = 4 - 2 * g;   qb = r & ((1 << nqbs) - 1); const int r2 = r >> nqbs; hq = r2 % 6; vb = r2 / 6; }
        else if (MODE == 0) { qb = un & 7; hq = (un >> 3) & 15; vb = un >> 7; }
        else { qb = un & 15; hq = (un >> 4) & 15; vb = un >> 8; }
        const int gsh = 2 * g, lsh = 12 - gsh, L = 1 << lsh;
        const int kvh = (MODE == 1) ? hq / 3 : hq >> 2;
        const int q0 = qb * QU, qw = q0 + 32 * NQ * wave;
        const size_t gq = (MODE == 1) ? (size_t)g * ((size_t)NBATCH * 6 * SEQ * 64) : 0, gk = (MODE == 1) ? (size_t)g * ((size_t)NBATCH * 2 * SEQ * 64) : 0;
        bf16x8 qf[NQ][4];
#pragma unroll
        for (int j = 0; j < NQ; ++j) {
            const bf16_t* qp = Qg + gq + ((((size_t)(vb * HQ + hq)) << lsh) + qw + 32 * j + r32) * 64 + 8 * hi;
#pragma unroll
            for (int s = 0; s < 4; ++s) qf[j][s] = *(const bf16x8*)(qp + 16 * s);
        }
        const bf16_t* kbase = Kg + gk + (((size_t)(vb * HKV + kvh)) << lsh) * 64;
        const bf16_t* vbase = Vg + gk + ((((size_t)(vb * HKV + kvh)) * 64) << lsh);
        int lo = 0, hiT = L >> 6;
        if (MODE != 0) { lo = (q0 - WIN) >> 6; if (lo < 0) lo = 0; int h2 = ((q0 + 255 + WIN) >> 6) + 1; if (h2 < hiT) hiT = h2; }
        float slope2 = 0.f;
        if (MODE == 1) slope2 = exp2f(-8.0f * (float)(g * 6 + hq + 1) / 18.0f) * (float)(1 << gsh) * LOG2E;
        if (MODE == 2) slope2 = exp2f(-8.0f * (float)(hq + 1) / 16.0f) * LOG2E;
        float mrun[NQ], lrun[NQ];
        f32x16 oacc[NQ][2];
#pragma unroll
        for (int j = 0; j < NQ; ++j) {
            mrun[j] = NEG_BIG; lrun[j] = 0.f;
            if (MODE == 2) { mrun[j] = sinks[hq] * LOG2E; lrun[j] = (hi == 0) ? 1.f : 0.f; }
#pragma unroll
            for (int i = 0; i < 16; ++i) { oacc[j][0][i] = 0.f; oacc[j][1][i] = 0.f; }
        }
        u32x4 kreg, vreg;
        kreg = *(const u32x4*)(kbase + (size_t)lo * 4096 + tid * 8);
        vreg = *(const u32x4*)(vbase + ((size_t)srow << lsh) + lo * 64 + schunk * 8);
        *(LAS u32x4*)(lds + sdst) = kreg; *(LAS u32x4*)(lds + AT_TILEB + sdst) = vreg;
        __syncthreads();
        for (int kt = lo; kt < hiT; ++kt) {
            const int buf = (kt - lo) & 1;
            const bool more = (kt + 1 < hiT);
            if (more) {
                kreg = *(const u32x4*)(kbase + (size_t)(kt + 1) * 4096 + tid * 8);
                vreg = *(const u32x4*)(vbase + ((size_t)srow << lsh) + (kt + 1) * 64 + schunk * 8);
            }
            bool active = true;
            if (MODE != 0) active = !((64 * kt + 63 < qw - WIN) || (64 * kt > qw + 31 + WIN));
            if (active) {
                const LAS unsigned char* kl = lds + buf * AT_BUFB;
                const LAS unsigned char* vl = kl + AT_TILEB;
                f32x16 sacc[NQ][2];
#pragma unroll
                for (int kb = 0; kb < 2; ++kb) {
#pragma unroll
                    for (int j = 0; j < NQ; ++j)
#pragma unroll
                        for (int i = 0; i < 16; ++i) sacc[j][kb][i] = 0.f;
#pragma unroll
                    for (int s = 0; s < 4; ++s) {
                        const bf16x8 kf = *(const LAS bf16x8*)(kl + (32 * kb + r32) * AT_ROWB + (2 * s + hi) * 16);
#pragma unroll
                        for (int j = 0; j < NQ; ++j) sacc[j][kb] = __builtin_amdgcn_mfma_f32_32x32x16_bf16(kf, qf[j][s], sacc[j][kb], 0, 0, 0);
                    }
                }
                bf16x8 pf[NQ][2][2];
#pragma unroll
                for (int j = 0; j < NQ; ++j) {
                    if (MODE != 0) {
                        const float fd0 = (float)(64 * kt + 4 * hi - (qw + r32));
#pragma unroll
                        for (int kb = 0; kb < 2; ++kb)
#pragma unroll
                            for (int i = 0; i < 16; ++i) {
                                const float dist = fabsf(fd0 + (float)(32 * kb + 8 * (i >> 2) + (i & 3)));
                                sacc[j][kb][i] = (dist <= (float)WIN) ? (sacc[j][kb][i] - slope2 * dist) : NEG_BIG;
                            }
                    }
                    float mx = sacc[j][0][0];
#pragma unroll
                    for (int i = 1; i < 16; ++i) mx = fmaxf(mx, sacc[j][0][i]);
#pragma unroll
                    for (int i = 0; i < 16; ++i) mx = fmaxf(mx, sacc[j][1][i]);
                    mx = fmaxf(mx, __shfl_xor(mx, 32));
                    if (__builtin_amdgcn_ballot_w64(mx > mrun[j]) != 0ull) {
                        const float mnew = fmaxf(mrun[j], mx);
                        const float alpha = __builtin_amdgcn_exp2f(mrun[j] - mnew);
                        mrun[j] = mnew;
                        lrun[j] *= alpha;
#pragma unroll
                        for (int i = 0; i < 16; ++i) { oacc[j][0][i] *= alpha; oacc[j][1][i] *= alpha; }
                    }
                    const float mcur = mrun[j];
                    float ps = 0.f;
#pragma unroll
                    for (int kb = 0; kb < 2; ++kb)
#pragma unroll
                        for (int i = 0; i < 16; ++i) { const float pv = __builtin_amdgcn_exp2f(sacc[j][kb][i] - mcur); sacc[j][kb][i] = pv; ps += pv; }
                    lrun[j] += ps;
#pragma unroll
                    for (int kb = 0; kb < 2; ++kb)
#pragma unroll
                        for (int hh = 0; hh < 2; ++hh) {
                            u32x4 w; w.x = cvtpk_s(sacc[j][kb][8 * hh + 0], sacc[j][kb][8 * hh + 1]); w.y = cvtpk_s(sacc[j][kb][8 * hh + 2], sacc[j][kb][8 * hh + 3]);
                            w.z = cvtpk_s(sacc[j][kb][8 * hh + 4], sacc[j][kb][8 * hh + 5]); w.w = cvtpk_s(sacc[j][kb][8 * hh + 6], sacc[j][kb][8 * hh + 7]);
                            pf[j][kb][hh] = __builtin_bit_cast(bf16x8, w);
                        }
                }
#pragma unroll
                for (int db = 0; db < 2; ++db)
#pragma unroll
                    for (int kb = 0; kb < 2; ++kb)
#pragma unroll
                        for (int hh = 0; hh < 2; ++hh) {
                            const bf16x8 vf = *(const LAS bf16x8*)(vl + (32 * db + r32) * AT_ROWB + (2 * (2 * kb + hh) + hi) * 16);
#pragma unroll
                            for (int j = 0; j < NQ; ++j) oacc[j][db] = __builtin_amdgcn_mfma_f32_32x32x16_bf16(vf, pf[j][kb][hh], oacc[j][db], 0, 0, 0);
                        }
            }
            if (more) {
                LAS unsigned char* nb = lds + (buf ^ 1) * AT_BUFB;
                *(LAS u32x4*)(nb + sdst) = kreg; *(LAS u32x4*)(nb + AT_TILEB + sdst) = vreg;
            }
            __syncthreads();
        }
#pragma unroll
        for (int j = 0; j < NQ; ++j) {
            const float ltot = lrun[j] + __shfl_xor(lrun[j], 32);
            const float inv = 1.0f / ltot;
            int row, hglob;
            if (MODE == 1) { const int dmask = (1 << gsh) - 1; const int b = vb >> gsh, rr = vb & dmask; row = b * SEQ + rr + ((qw + r32) << gsh); hglob = g * 6 + hq; }
            else { row = vb * SEQ + qw + 32 * j + r32; hglob = hq; }
            bf16_t* op = Og + (size_t)row * OPITCH + hglob * 64 + 4 * hi;
#pragma unroll
            for (int db = 0; db < 2; ++db)
#pragma unroll
                for (int q4 = 0; q4 < 4; ++q4) {
                    u32x2 w; w.x = cvtpk_s(oacc[j][db][4 * q4 + 0] * inv, oacc[j][db][4 * q4 + 1] * inv); w.y = cvtpk_s(oacc[j][db][4 * q4 + 2] * inv, oacc[j][db][4 * q4 + 3] * inv);
                    *(u32x2*)(op + 32 * db + 8 * q4) = w;
                }
            if (MODE == 1) { if (hi == 0) LSE[(size_t)row * 18 + hglob] = mrun[j] + __builtin_amdgcn_logf(ltot); }
        }
    }
}

__device__ __forceinline__ void attn_dense_fast(LAS unsigned char* lds, const bf16_t* __restrict__ Qg, const bf16_t* __restrict__ Kg, const bf16_t* __restrict__ Vg, bf16_t* Og) {
    int tid_ = threadIdx.x; asm volatile("" : "+v"(tid_));
    const int tid = tid_, lane = tid & 63, wave = __builtin_amdgcn_readfirstlane(tid >> 6), r32 = lane & 31, hi = lane >> 5;
    constexpr int NQ = 2, NUNITS = 1024, NT = SEQ / 64;
    constexpr int VRING = 2 * AT_TILEB;
    const int srow = tid >> 3, schunk = tid & 7;
    const unsigned sdst = (unsigned)(srow * AT_ROWB + schunk * 16);
    { unsigned z = 0u; asm volatile("" : "+v"(z));
      for (int i = tid; i < 3 * AT_TILEB / 16; i += 512) *(LAS u32x4*)(lds + VRING + i * 16) = (u32x4){z, z, z, z}; }
    __syncthreads();
    for (int un = blockIdx.x; un < NUNITS; un += gridDim.x) {
        const int qb = un & 7, hq = (un >> 3) & 15, vb = un >> 7, kvh = hq >> 2;
        const int qw = qb * 512 + 64 * wave;
        bf16x8 qf[NQ][4];
#pragma unroll
        for (int j = 0; j < NQ; ++j) {
            const bf16_t* qp = Qg + ((size_t)(vb * 16 + hq) * SEQ + qw + 32 * j + r32) * 64 + 8 * hi;
#pragma unroll
            for (int s = 0; s < 4; ++s) qf[j][s] = *(const bf16x8*)(qp + 16 * s);
        }
        const char* kbu = (const char*)(Kg + (size_t)(vb * 4 + kvh) * SEQ * 64);
        const char* vbu = (const char*)(Vg + (size_t)(vb * 4 + kvh) * 64 * SEQ);
        const unsigned kof = (unsigned)tid * 16u, vof = (unsigned)(srow * SEQ + schunk * 8) * 2u;
        float lsum[NQ]; f32x16 oacc[NQ][2]; bf16x8 pfp[NQ][2][2];
#pragma unroll
        for (int j = 0; j < NQ; ++j) {
            lsum[j] = 0.f;
#pragma unroll
            for (int i = 0; i < 16; ++i) { oacc[j][0][i] = 0.f; oacc[j][1][i] = 0.f; }
#pragma unroll
            for (int kb = 0; kb < 2; ++kb)
#pragma unroll
                for (int hh = 0; hh < 2; ++hh) pfp[j][kb][hh] = (bf16x8){0, 0, 0, 0, 0, 0, 0, 0};
        }
        u32x4 kreg = *(const u32x4*)(kbu + kof), vreg = *(const u32x4*)(vbu + vof);
        *(LAS u32x4*)(lds + sdst) = kreg; *(LAS u32x4*)(lds + VRING + sdst) = vreg;
        __syncthreads();
        int vprev = VRING + 2 * AT_TILEB, vcur = VRING, vnext = VRING + AT_TILEB;
#pragma unroll 1
        for (int kt = 0; kt < NT; ++kt) {
            const int tn = (kt + 1 < NT) ? kt + 1 : kt;
            kreg = *(const u32x4*)(kbu + (size_t)tn * 8192 + kof);
            vreg = *(const u32x4*)(vbu + (size_t)tn * 128 + vof);
            const LAS unsigned char* kl = lds + (kt & 1) * AT_TILEB;
            const LAS unsigned char* vl = lds + vprev;
#pragma unroll
            for (int kb = 0; kb < 2; ++kb) {
                f32x16 sacc[NQ];
#pragma unroll
                for (int j = 0; j < NQ; ++j)
#pragma unroll
                    for (int i = 0; i < 16; ++i) sacc[j][i] = 0.f;
#pragma unroll
                for (int s = 0; s < 4; ++s) {
                    const bf16x8 kf = *(const LAS bf16x8*)(kl + (32 * kb + r32) * AT_ROWB + (2 * s + hi) * 16);
#pragma unroll
                    for (int j = 0; j < NQ; ++j) sacc[j] = __builtin_amdgcn_mfma_f32_32x32x16_bf16(kf, qf[j][s], sacc[j], 0, 0, 0);
                }
#pragma unroll
                for (int hh = 0; hh < 2; ++hh)
#pragma unroll
                    for (int db = 0; db < 2; ++db) {
                        const bf16x8 vf = *(const LAS bf16x8*)(vl + (32 * db + r32) * AT_ROWB + (2 * (2 * kb + hh) + hi) * 16);
#pragma unroll
                        for (int j = 0; j < NQ; ++j) oacc[j][db] = __builtin_amdgcn_mfma_f32_32x32x16_bf16(vf, pfp[j][kb][hh], oacc[j][db], 0, 0, 0);
                    }
#pragma unroll
                for (int j = 0; j < NQ; ++j) {
                    float ps = 0.f;
#pragma unroll
                    for (int i = 0; i < 16; ++i) { const float pv = __builtin_amdgcn_exp2f(sacc[j][i]); sacc[j][i] = pv; ps += pv; }
                    lsum[j] += ps;
#pragma unroll
                    for (int hh = 0; hh < 2; ++hh) {
                        u32x4 w; w.x = cvtpk_s(sacc[j][8 * hh + 0], sacc[j][8 * hh + 1]); w.y = cvtpk_s(sacc[j][8 * hh + 2], sacc[j][8 * hh + 3]);
                        w.z = cvtpk_s(sacc[j][8 * hh + 4], sacc[j][8 * hh + 5]); w.w = cvtpk_s(sacc[j][8 * hh + 6], sacc[j][8 * hh + 7]);
                        pfp[j][kb][hh] = __builtin_bit_cast(bf16x8, w);
                    }
                }
            }
            *(LAS u32x4*)(lds + ((kt + 1) & 1) * AT_TILEB + sdst) = kreg; *(LAS u32x4*)(lds + vnext + sdst) = vreg;
            { const int tmp = vprev; vprev = vcur; vcur = vnext; vnext = tmp; }
            __syncthreads();
        }
        {
            const LAS unsigned char* vl = lds + vprev;
#pragma unroll
            for (int db = 0; db < 2; ++db)
#pragma unroll
                for (int kb = 0; kb < 2; ++kb)
#pragma unroll
                    for (int hh = 0; hh < 2; ++hh) {
                        const bf16x8 vf = *(const LAS bf16x8*)(vl + (32 * db + r32) * AT_ROWB + (2 * (2 * kb + hh) + hi) * 16);
#pragma unroll
                        for (int j = 0; j < NQ; ++j) oacc[j][db] = __builtin_amdgcn_mfma_f32_32x32x16_bf16(vf, pfp[j][kb][hh], oacc[j][db], 0, 0, 0);
                    }
        }
        __syncthreads();
#pragma unroll
        for (int j = 0; j < NQ; ++j) {
            const float ltot = lsum[j] + __shfl_xor(lsum[j], 32);
            const float inv = 1.0f / ltot;
            const int row = vb * SEQ + qw + 32 * j + r32;
            bf16_t* op = Og + (size_t)row * 1024 + hq * 64 + 4 * hi;
#pragma unroll
            for (int db = 0; db < 2; ++db)
#pragma unroll
                for (int q4 = 0; q4 < 4; ++q4) {
                    u32x2 w; w.x = cvtpk_s(oacc[j][db][4 * q4 + 0] * inv, oacc[j][db][4 * q4 + 1] * inv); w.y = cvtpk_s(oacc[j][db][4 * q4 + 2] * inv, oacc[j][db][4 * q4 + 3] * inv);
                    *(u32x2*)(op + 32 * db + 8 * q4) = w;
                }
        }
    }
}

__device__ __forceinline__ void mixb_fix(bf16_t* Og, const float* LSE, int gw, int NGW, int lane) {
    asm volatile("" : "+v"(lane));
    for (int m = gw; m < MTOK; m += NGW) {
        const float* ls = LSE + (size_t)m * 18;
#pragma unroll
        for (int c3 = 0; c3 < 3; ++c3) {
            const int c = lane + 64 * c3;
            if (c < 144) {
                const int head = c >> 3, g = head / 6, kr = head - 6 * g;
                const float l0 = ls[kr], l1 = ls[6 + kr], l2 = ls[12 + kr];
                const float mx = fmaxf(l0, fmaxf(l1, l2));
                const float e0 = exp2f(l0 - mx), e1 = exp2f(l1 - mx), e2 = exp2f(l2 - mx);
                const float a = ((g == 0) ? e0 : (g == 1) ? e1 : e2) / (e0 + e1 + e2);
                u32x4* pp = (u32x4*)(Og + (size_t)m * 1152) + c;
                u32x4 w = *pp;
                unsigned ww[4] = {w.x, w.y, w.z, w.w};
#pragma unroll
                for (int k = 0; k < 4; ++k) { const float f0 = __builtin_bit_cast(float, ww[k] << 16) * a, f1 = __builtin_bit_cast(float, ww[k] & 0xffff0000u) * a; ww[k] = cvt_pk_bf16(f0, f1); }
                w.x = ww[0]; w.y = ww[1]; w.z = ww[2]; w.w = ww[3];
                *pp = w;
            }
        }
    }
}

#define XB_TMO      128
#define XB_XCNT(j)  (256  + 64 * (j))
#define XB_XSUB(j)  (1280 + 64 * (j))
#define XB_XGEN(j)  (2304 + 64 * (j))
#define XB_TOP      3328
#define XB_TOPGEN   3392
#define XCD_BAR_WORDS 3456
#define XB_SPIN_CAP (1u << 18)

__device__ __forceinline__ unsigned xb_ld(unsigned* p)              { return __hip_atomic_load(p, __ATOMIC_RELAXED, __HIP_MEMORY_SCOPE_AGENT); }
__device__ __forceinline__ unsigned xb_add(unsigned* p, unsigned v) { return __hip_atomic_fetch_add(p, v, __ATOMIC_RELAXED, __HIP_MEMORY_SCOPE_AGENT); }
__device__ __forceinline__ unsigned xb_xcc_id() { return (unsigned)__builtin_amdgcn_s_getreg((3 << 11) | 20) & 0xFu; }
#define XB_SPIN(cond, bar) do { unsigned _sp = 0; while (cond) { __builtin_amdgcn_s_sleep(1); \
    if ((++_sp & 255u) == 0u) { if (xb_ld(&(bar)[XB_TMO])) break; if (_sp > XB_SPIN_CAP) { atomicAdd(&(bar)[XB_TMO], 1u); break; } } } } while (0)

struct XcdBarrier {
    unsigned* bar; unsigned x;
    volatile LAS unsigned* st;
};

__device__ __forceinline__ XcdBarrier xcd_barrier_post(unsigned* bar, volatile LAS unsigned* st) {
    XcdBarrier b; b.bar = bar; b.x = xb_xcc_id(); b.st = st;
    if (threadIdx.x == 0) (void)xb_add(&bar[XB_XCNT(b.x)], 1u);
    return b;
}
__device__ __forceinline__ void xcd_barrier_complete(unsigned* bar, unsigned x, unsigned& nloc, unsigned& nx) {
    const unsigned G = gridDim.x * gridDim.y * gridDim.z;
    unsigned sum, cnt, mine, sp = 0u;
    for (;;) {
        sum = 0u; cnt = 0u; mine = 0u;
#pragma unroll
        for (unsigned j = 0; j < 16; ++j) { const unsigned c = xb_ld(&bar[XB_XCNT(j)]); sum += c; cnt += (c > 0u) ? 1u : 0u; mine = (j == x) ? c : mine; }
        if (sum == G) break;
        __builtin_amdgcn_s_sleep(1);
        if ((++sp & 255u) == 0u) { if (xb_ld(&bar[XB_TMO])) break; if (sp > XB_SPIN_CAP) { atomicAdd(&bar[XB_TMO], 1u); break; } }
    }
    nloc = mine > 0u ? mine : 1u; nx = cnt > 0u ? cnt : 1u;
}

__device__ __forceinline__ void xcd_barrier(const XcdBarrier& b) {
    asm volatile("s_waitcnt vmcnt(0)" ::: "memory");
    __syncthreads();
    if (threadIdx.x == 0) {
        unsigned* bar = b.bar;
        __builtin_amdgcn_s_waitcnt(0);
        unsigned nloc = b.st[0], nx = b.st[1];
        if (nloc == 0u) { xcd_barrier_complete(bar, b.x, nloc, nx); b.st[0] = nloc; b.st[1] = nx; }
        const unsigned old = xb_add(&bar[XB_XSUB(b.x)], 1u);
        const unsigned gen = old / nloc;
        if (old + 1u == (gen + 1u) * nloc) {
            __builtin_amdgcn_fence(__ATOMIC_RELEASE, "agent");
            asm volatile("s_waitcnt vmcnt(0)" ::: "memory");
            const unsigned og = xb_add(&bar[XB_TOP], 1u);
            const unsigned tg = og / nx;
            if (og + 1u == (tg + 1u) * nx) xb_add(&bar[XB_TOPGEN], 1u);
            else XB_SPIN(xb_ld(&bar[XB_TOPGEN]) == tg, bar);
            __builtin_amdgcn_fence(__ATOMIC_ACQUIRE, "agent");
            xb_add(&bar[XB_XGEN(b.x)], 1u);
            asm volatile("s_waitcnt vmcnt(0)" ::: "memory");
        } else {
            XB_SPIN(xb_ld(&bar[XB_XGEN(b.x)]) == gen, bar);
            __builtin_amdgcn_fence(__ATOMIC_ACQUIRE, "agent");
            asm volatile("s_waitcnt vmcnt(0)" ::: "memory");
        }
    }
    __syncthreads();
}

__device__ __forceinline__ void fill_rstd(LAS unsigned char* lds, const pg8::StaticOrder& S, const float* ssp) {
    LAS float* rs = (LAS float*)(lds + LDS_RSTD);
    int tid = threadIdx.x; asm volatile("" : "+v"(tid));
    for (int i0 = 0; i0 < 8; i0 += 2) {
        pg8::Unit u; const int i = i0 + (tid >> 8);
        if (S.next(i, u)) rs[i * 256 + (tid & 255)] = __builtin_amdgcn_rsqf(row_ss(ssp, u.pm * 256 + (tid & 255)) * (1.0f / DM) + RMS_EPS);
    }
    __syncthreads();
}

__global__ void __launch_bounds__(512, 2) fwd_kernel(Params p) {
    extern __shared__ __attribute__((aligned(16))) unsigned char lds_raw[];
    LAS unsigned char* lds = (LAS unsigned char*)lds_raw;
    cg::grid_group grid = cg::this_grid();
    volatile LAS unsigned* xst = (volatile LAS unsigned*)(lds + LDS_BYTES - 64);
    if (threadIdx.x < 2) xst[threadIdx.x] = 0u;
    __syncthreads();
    XcdBarrier xbar = xcd_barrier_post((unsigned*)(p.ws + WS_BAR), xst);
    {
        LAS float* rope = (LAS float*)(lds + LDS_ROPE); LAS float* gl = (LAS float*)(lds + LDS_GAIN);
        for (int i = threadIdx.x; i < 1024; i += 512) { const int pos = i >> 4, f = i & 15; const float ang = (float)pos * exp2f(-(float)f * 0.83048202372184059f); rope[2 * i] = cosf(ang); rope[2 * i + 1] = sinf(ang); }
        if (threadIdx.x < 256) { const int i = threadIdx.x, ja = i >> 7, qk = (i >> 6) & 1, d = i & 63; gl[i] = (qk == 0 ? p.in[4] : p.in[5])[ja * 64 + d]; }
    }
#define GRID_SYNC() do { asm volatile("s_waitcnt vmcnt(0) lgkmcnt(0)" ::: "memory"); grid.sync(); asm volatile("buffer_inv sc1\n\ts_waitcnt vmcnt(0)" ::: "memory"); GRID_SYNC2(); } while (0)
#define XBAR_SYNC() do { xcd_barrier(xbar); asm volatile("buffer_inv sc1\n\ts_waitcnt vmcnt(0)" ::: "memory"); } while (0)
#ifdef PROBE_DUP_SYNC
#define GRID_SYNC2() do { grid.sync(); asm volatile("buffer_inv sc1\n\ts_waitcnt vmcnt(0)" ::: "memory"); } while (0)
#else
#define GRID_SYNC2() do { } while (0)
#endif
    const int wave = __builtin_amdgcn_readfirstlane((int)threadIdx.x >> 6);
#define LANE() ({ int l_ = (int)threadIdx.x & 63; asm volatile("" : "+v"(l_)); l_; })
    const int G = gridDim.x, gw = blockIdx.x * 8 + wave, NGW = G * 8;
    unsigned char* ws = p.ws;
#define WSP() ({ unsigned char* q_ = ws; asm volatile("" : "+s"(q_)); q_; })
#define SSP(i) ((float*)(WSP() + WS_SSP) + (size_t)(i) * MTOK * 16)
#define LSE_ ((float*)(WSP() + WS_LSE))
#define WB_ ((bf16_t*)(WSP() + WS_W))
#define HB_ ((bf16_t*)(WSP() + WS_HB))
#define U_ ((bf16_t*)(WSP() + WS_U))
#define Qb_ ((bf16_t*)(WSP() + WS_Q))
#define Kb_ ((bf16_t*)(WSP() + WS_K))
#define Vb_ ((bf16_t*)(WSP() + WS_VT))
#define Ob_ ((bf16_t*)(WSP() + WS_O))
    float* h = p.out;

#ifndef PHMASK
#define PHMASK 0xffff
#endif
    if (PHMASK & 1) prologue(p, lds, gw, NGW, wave, LANE());
#ifdef PROBE_DUP_PRO
    __syncthreads(); prologue(p, lds, gw, NGW, wave, LANE());
#endif
    GRID_SYNC();

#pragma unroll 1
    for (int layer = 0; layer < 4; ++layer) {
        const int kind = (layer == 3) ? 0 : layer;
        const int ja = (layer == 3) ? 1 : 0;
        const size_t weq = (layer == 0) ? WE_QKV0 : (layer == 1) ? WE_QKV1 : (layer == 2) ? WE_QKV2 : WE_QKV3;
        const size_t weo = (layer == 0) ? WE_WO0 : (layer == 1) ? WE_WO1 : (layer == 2) ? WE_WO2 : WE_WO3;
        if (kind == 0 && (PHMASK & 2)) {
            pg8::Gemm g{HB_, WB_ + weq, MTOK, 1536, DM}; pg8::StaticOrder S; S.init(MTOK, 1536, G, (int)blockIdx.x);
            fill_rstd(lds, S, SSP(2 * layer));
            pg8::EpiQKV<0> E{WSP(), lds, ja, 0};
            pg8::gemm_phase<pg8::EpiQKV<0>, pg8::StaticOrder, true, true>(lds, g, S, E);
        } else if (kind == 1 && (PHMASK & 4)) {
            pg8::Gemm g{HB_, WB_ + weq, MTOK, 2048, DM}; pg8::StaticOrder S; S.init(MTOK, 2048, G, (int)blockIdx.x);
            fill_rstd(lds, S, SSP(2 * layer));
            pg8::EpiQKV<1> E{WSP(), lds, 0, 0};
            pg8::gemm_phase<pg8::EpiQKV<1>, pg8::StaticOrder, true, true>(lds, g, S, E);
        } else if (kind == 2 && (PHMASK & 8)) {
            pg8::Gemm g{HB_, WB_ + weq, MTOK, 1536, DM}; pg8::StaticOrder S; S.init(MTOK, 1536, G, (int)blockIdx.x);
            fill_rstd(lds, S, SSP(2 * layer));
            pg8::EpiQKV<2> E{WSP(), lds, 0, 0};
            pg8::gemm_phase<pg8::EpiQKV<2>, pg8::StaticOrder, true, true>(lds, g, S, E);
        }
        XBAR_SYNC();
        if (kind == 0) {
            const LAS float* gl = (const LAS float*)(lds + LDS_GAIN) + ja * 128;
            int lane3 = threadIdx.x & 63; asm volatile("" : "+v"(lane3));
            float gq = fabsf(gl[lane3]), gk = fabsf(gl[64 + lane3]);
#pragma unroll
            for (int o = 1; o < 64; o <<= 1) { gq = fmaxf(gq, __shfl_xor(gq, o)); gk = fmaxf(gk, __shfl_xor(gk, o)); }
            const bool fastp = __builtin_amdgcn_readfirstlane((QSCALE * 64.0f * gq * gk <= 60.0f) ? 1 : 0) != 0;
            if (fastp) { if (PHMASK & 16) attn_dense_fast(lds, Qb_, Kb_, Vb_, Ob_); }
            else if (PHMASK & 16) attn_phase<0>(lds, Qb_, Kb_, Vb_, Ob_, LSE_, nullptr);
#ifdef PROBE_DUP_A
            __syncthreads(); attn_phase<0>(lds, Qb_, Kb_, Vb_, Ob_, LSE_, nullptr);
#endif
        }
        else if (kind == 1) { if (PHMASK & 32) attn_phase<1>(lds, Qb_, Kb_, Vb_, Ob_, LSE_, nullptr);
#ifdef PROBE_DUP_BC
            __syncthreads(); attn_phase<1>(lds, Qb_, Kb_, Vb_, Ob_, LSE_, nullptr);
#endif
            XBAR_SYNC(); mixb_fix(Ob_, LSE_, gw, NGW, LANE()); }
        else { if (PHMASK & 64) attn_phase<2>(lds, Qb_, Kb_, Vb_, Ob_, LSE_, p.in[10]);
#ifdef PROBE_DUP_BC
            __syncthreads(); attn_phase<2>(lds, Qb_, Kb_, Vb_, Ob_, LSE_, p.in[10]);
#endif
        }
        XBAR_SYNC();
        if (PHMASK & 128) {
            const int Ko = (kind == 1) ? 1152 : 1024;
            pg8::Gemm g{Ob_, WB_ + weo, MTOK, DM, Ko}; pg8::StaticOrder S; S.init(MTOK, DM, G, (int)blockIdx.x);
            pg8::EpiRes E{(layer == 0) ? p.in[0] : (const float*)h, h, HB_, SSP(2 * layer + 1)};
            pg8::gemm_phase<pg8::EpiRes, pg8::StaticOrder, true, true>(lds, g, S, E);
        }
        XBAR_SYNC();
        if (PHMASK & 256) {
            pg8::Gemm g{HB_, WB_ + WE_W1 + (size_t)layer * 4096 * 1024, MTOK, DFF, DM}; pg8::StaticOrder S; S.init(MTOK, DFF, G, (int)blockIdx.x);
            fill_rstd(lds, S, SSP(2 * layer + 1));
            pg8::EpiMlp1 E{lds, U_, 0};
            pg8::gemm_phase<pg8::EpiMlp1, pg8::StaticOrder, true, true>(lds, g, S, E);
#ifdef PROBE_DUP_MLP1
            __syncthreads(); pg8::gemm_phase<pg8::EpiMlp1, pg8::StaticOrder, true, true>(lds, g, S, E);
#endif
        }
        XBAR_SYNC();
        if (PHMASK & 512) {
            pg8::Gemm g{U_, WB_ + WE_W2 + (size_t)layer * 4096 * 1024, MTOK, DM, DFF}; pg8::StaticOrder S; S.init(MTOK, DM, G, (int)blockIdx.x);
            pg8::EpiRes E{h, h, HB_, SSP(2 * layer + 2)};
            pg8::gemm_phase<pg8::EpiRes, pg8::StaticOrder, true, true>(lds, g, S, E);
        }
        XBAR_SYNC();
    }
    {
        const float* fg = p.in[14]; const float* ss8 = SSP(8);
        const int lane2 = LANE();
        for (int m = gw; m < MTOK; m += NGW) {
            const float rstd = __builtin_amdgcn_rsqf(row_ss(ss8, m) * (1.0f / DM) + RMS_EPS);
            f32x4* hr = (f32x4*)(h + (size_t)m * DM) + lane2;
#pragma unroll
            for (int j = 0; j < 4; ++j) { const f32x4 gg = ((const f32x4*)fg)[64 * j + lane2]; f32x4 v = hr[64 * j]; v = v * rstd * gg; hr[64 * j] = v; }
        }
    }
}

extern "C" void kernel_launch(void* const* d_in, const int* in_sizes, int n_in, void* d_out, int out_size, void* d_ws, size_t ws_size, hipStream_t stream) {
    static int grid = 0;
    if (grid == 0) {
        if (n_in != 15 || out_size != MTOK * DM || ws_size < WS_END) { fprintf(stderr, "kernel_launch: unexpected shapes (n_in %d out %d ws %zu)\n", n_in, out_size, ws_size); grid = -1; return; }
        int dev = 0, cus = 0, per_cu = 0;
        hipGetDevice(&dev);
        hipDeviceGetAttribute(&cus, hipDeviceAttributeMultiprocessorCount, dev);
        if (hipFuncSetAttribute((const void*)fwd_kernel, hipFuncAttributeMaxDynamicSharedMemorySize, LDS_BYTES) != hipSuccess) { fprintf(stderr, "kernel_launch: hipFuncSetAttribute failed\n"); grid = -1; return; }
        if (hipOccupancyMaxActiveBlocksPerMultiprocessor(&per_cu, (const void*)fwd_kernel, 512, LDS_BYTES) != hipSuccess || per_cu < 1) { fprintf(stderr, "kernel_launch: occupancy query gave %d\n", per_cu); per_cu = 1; }
        (void)hipGetLastError();
        grid = cus * per_cu;
    }
    if (grid < 0) return;
    if (hipMemsetAsync((char*)d_ws + WS_BAR, 0, 16384, stream) != hipSuccess) { fprintf(stderr, "kernel_launch: hipMemsetAsync failed\n"); return; }
    Params p{};
    for (int i = 0; i < 15; ++i) p.in[i] = (const float*)d_in[i];
    p.out = (float*)d_out; p.ws = (unsigned char*)d_ws;
    void* args[] = {&p};
    hipError_t e = hipLaunchCooperativeKernel((const void*)fwd_kernel, dim3(grid), dim3(512), args, LDS_BYTES, stream);
    if (e != hipSuccess) fprintf(stderr, "cooperative launch failed: %s (grid %d)\n", hipGetErrorString(e), grid);
}
```

```cpp
#include <hip/hip_runtime.h>
#include <hip/hip_cooperative_groups.h>
#include <cstdio>
#include <cstdint>
namespace cg = cooperative_groups;

namespace pg8 {
#define PG8_LAS __attribute__((address_space(3)))
typedef unsigned short bf16_t;
typedef short bf16x8 __attribute__((ext_vector_type(8)));
typedef float f32x4 __attribute__((ext_vector_type(4)));
typedef unsigned u32x4 __attribute__((ext_vector_type(4)));
constexpr int BM = 256, BK = 64, HALF = 128, HTB = HALF * BK * 2  , STAGE_BYTES = 8 * HTB, NXCD = 8, WGM = 8;

__host__ __device__ __forceinline__ int lds_byte(int r, int c) { const int st = (r >> 4) * 2 + (c >> 5), rr = r & 15, cc = c & 31, ob = rr * 64 + cc * 2; return st * 1024 + (ob ^ (((ob >> 9) & 1) << 5)); }
__host__ __device__ __forceinline__ void stage_rc(int b, int& R, int& C) { const int st = b / 1024, sb = b % 1024, swz = sb ^ (((sb >> 9) & 1) << 5); R = (st >> 1) * 16 + swz / 64; C = (st & 1) * 32 + (swz % 64) / 2; }
__host__ __device__ __forceinline__ int perm32(int rho) { const int n = rho >> 4, i = rho & 15; return 8 * (i >> 2) + 4 * n + (i & 3); }

struct Unit { int pm, pn; };
struct Gemm { const bf16_t* A; const bf16_t* Bt; int M, N, K; };

struct StaticOrder {
    int nM, nN, nwg, G, c;
    __host__ __device__ void init(int M, int N, int G_, int c_) { nM = M / BM; nN = N / BM; nwg = nM * nN; G = G_; c = c_; }
    __host__ __device__ bool next(int i, Unit& u) const {
        const long L = (long)i * G + c; if (L >= nwg) return false;
        int wgid = (int)L; { const int q = nwg / NXCD, r = nwg % NXCD, xcd = wgid % NXCD, off = wgid / NXCD; wgid = (xcd < r ? xcd * (q + 1) : r * (q + 1) + (xcd - r) * q) + off; }
        const int nig = WGM * nN, gid = wgid / nig, fm = gid * WGM, gsz = (nM - fm) < WGM ? (nM - fm) : WGM;
        u.pm = fm + ((wgid % nig) % gsz); u.pn = (wgid % nig) / gsz; return true;
    }
    __device__ __forceinline__ void a_ready(const Unit&) const {}
    __device__ __forceinline__ void done(const Unit&) const {}
};

__device__ __forceinline__ unsigned cvt_pk_bf16(float lo, float hi) { unsigned r; asm volatile("v_cvt_pk_bf16_f32 %0, %1, %2" : "=v"(r) : "v"(lo), "v"(hi)); return r; }
constexpr int SEQ = 4096, NBATCH = 8, MTOK = NBATCH * SEQ, DM = 1024, DFF = 4096;
constexpr float RMS_EPS = 1e-6f;
constexpr float LOG2E = 1.4426950408889634f;
constexpr float QSCALE = 0.125f * LOG2E;
constexpr float NEG_BIG = -1.0e30f;

constexpr size_t MiB = 1u << 20;
constexpr size_t WS_SS = 0;
constexpr size_t WS_TAB = 6 * MiB;
constexpr size_t WS_BAR = 7 * MiB;
constexpr size_t WS_LSE = 2 * MiB;
constexpr size_t WS_W = 8 * MiB;
constexpr size_t WS_HB = 96 * MiB;
constexpr size_t WS_U = 160 * MiB;
constexpr size_t WS_Q = 160 * MiB, WS_K = 232 * MiB, WS_VT = 256 * MiB, WS_O = 280 * MiB;
constexpr size_t WS_SSP = 420 * MiB;
constexpr size_t WS_END = 440 * MiB;

constexpr int LDS_RSTD = 131072;
constexpr int LDS_ROPE = 139264;
constexpr int LDS_GAIN = 147456;
constexpr int LDS_BYTES = 163840;
__device__ __forceinline__ float row_ss(const float* ssp, int row) {
    const f32x4* q = (const f32x4*)(ssp + (size_t)row * 16);
    const f32x4 a = q[0], b = q[1], c = q[2], d = q[3];
    return ((a[0] + a[1]) + (a[2] + a[3])) + ((b[0] + b[1]) + (b[2] + b[3])) + (((c[0] + c[1]) + (c[2] + c[3])) + ((d[0] + d[1]) + (d[2] + d[3])));
}
__device__ __forceinline__ int perm_key(int i) { return (i & ~12) | ((i & 4) << 1) | ((i & 8) >> 1); }

template <int KIND> struct EpiQKV {
    static constexpr bool PERM = true, AFTER_DRAIN = false;
    unsigned char* ws; PG8_LAS unsigned char* lds; int ja; mutable int cnt;
    __device__ __forceinline__ void operator()(const f32x4 (&acc)[2][2][4][2], const Unit& u, int wr, int wc, int fr, int fq) const {
        asm volatile("" : "+v"(fr), "+v"(fq));
        asm volatile("" : "+s"(wr), "+s"(wc));
        constexpr int NQH = (KIND == 1) ? 18 : 16, NKH = (KIND == 1) ? 6 : 4;
        const int hcol = 4 * u.pn + wc;
        int type, hh;
        if (hcol < NQH) { type = 0; hh = hcol; } else if (hcol < NQH + NKH) { type = 1; hh = hcol - NQH; } else if (hcol < NQH + 2 * NKH) { type = 2; hh = hcol - NQH - NKH; } else { ++cnt; return; }
        const PG8_LAS float* ss = (const PG8_LAS float*)(lds + LDS_RSTD) + 256 * cnt;
        ++cnt;
        const PG8_LAS f32x4* rope = (const PG8_LAS f32x4*)(lds + LDS_ROPE);
        float gn[2][8];
        if (KIND == 0) {
            const PG8_LAS float* gsrc = (const PG8_LAS float*)(lds + LDS_GAIN) + ja * 128 + ((type == 0) ? 0 : 64);
            if (type < 2) {
#pragma unroll
                for (int bj = 0; bj < 2; ++bj)
#pragma unroll
                    for (int n = 0; n < 2; ++n)
#pragma unroll
                        for (int j = 0; j < 4; ++j) gn[bj][n * 4 + j] = gsrc[32 * bj + 16 * n + 4 * fq + j];
            }
        }
        int hin = hh, g = 0;
        if (KIND == 1) { if (type == 0) { g = hh / 6; hin = hh - 6 * g; } else { g = hh >> 1; hin = hh & 1; } }
        if (KIND == 1 && g == 1) body<2>(acc, u, wr, wc, fr, fq, type, hin, g, ss, rope, gn);
        else if (KIND == 1 && g == 2) body<4>(acc, u, wr, wc, fr, fq, type, hin, g, ss, rope, gn);
        else body<0>(acc, u, wr, wc, fr, fq, type, hin, g, ss, rope, gn);
    }
    template <int gsh> __device__ __forceinline__ void body(const f32x4 (&acc)[2][2][4][2], const Unit& u, int wr, int wc, int fr, int fq, int type, int hin, int g, const PG8_LAS float* ss, const PG8_LAS f32x4* rope, const float (&gn)[2][8]) const {
#pragma unroll
        for (int ai = 0; ai < 2; ++ai)
#pragma unroll
            for (int m = 0; m < 4; ++m) {
                int frl = fr; asm volatile("" : "+v"(frl));
                const int row = u.pm * BM + ai * HALF + wr * 64 + m * 16 + frl;
                const int b = row >> 12, t = row & (SEQ - 1);
                const float rstd = ss[ai * HALF + wr * 64 + m * 16 + frl];
                float v[2][8];
#pragma unroll
                for (int bj = 0; bj < 2; ++bj)
#pragma unroll
                    for (int n = 0; n < 2; ++n)
#pragma unroll
                        for (int j = 0; j < 4; ++j) v[bj][n * 4 + j] = acc[ai][bj][m][n][j] * rstd;
                if (KIND == 0 && type < 2) {
                    float s2 = 0.f;
#pragma unroll
                    for (int bj = 0; bj < 2; ++bj)
#pragma unroll
                        for (int e = 0; e < 8; ++e) s2 += v[bj][e] * v[bj][e];
                    s2 += __shfl_xor(s2, 16); s2 += __shfl_xor(s2, 32);
                    const float r = __builtin_amdgcn_rsqf(s2 * (1.0f / 64.0f) + RMS_EPS);
#pragma unroll
                    for (int bj = 0; bj < 2; ++bj)
#pragma unroll
                        for (int e = 0; e < 8; ++e) v[bj][e] *= r * gn[bj][e];
#pragma unroll
                    for (int bj = 0; bj < 2; ++bj) {
                        const int pos = (bj == 0) ? (t >> 6) : (t & 63);
                        const f32x4 cs0 = rope[(pos * 16 + 4 * fq) >> 1], cs1 = rope[((pos * 16 + 4 * fq) >> 1) + 1];
                        const float cc[4] = {cs0[0], cs0[2], cs1[0], cs1[2]}, sn[4] = {cs0[1], cs0[3], cs1[1], cs1[3]};
#pragma unroll
                        for (int j = 0; j < 4; ++j) {
                            const float x1 = v[bj][j], x2 = v[bj][4 + j];
                            v[bj][j] = x1 * cc[j] - x2 * sn[j]; v[bj][4 + j] = x2 * cc[j] + x1 * sn[j];
                        }
                    }
                }
                if (type == 0) {
#pragma unroll
                    for (int bj = 0; bj < 2; ++bj)
#pragma unroll
                        for (int e = 0; e < 8; ++e) v[bj][e] *= QSCALE;
                }
                const int dmask = (1 << gsh) - 1;
                const int vb = (b << gsh) + (t & dmask), idx = t >> gsh, lsh = 12 - gsh;
                if (type < 2) {
                    const int nh = (type == 0) ? ((KIND == 1) ? 6 : 16) : ((KIND == 1) ? 2 : 4);
                    unsigned char* base = ws + ((type == 0) ? WS_Q : WS_K) + ((KIND == 1) ? (size_t)g * ((size_t)NBATCH * nh * SEQ * 128) : 0);
                    const unsigned off = ((unsigned)(((vb * nh + hin) << lsh) + idx) * 64u + 8u * fq) * 2u;
#pragma unroll
                    for (int bj = 0; bj < 2; ++bj) {
                        u32x4 w; w.x = cvt_pk_bf16(v[bj][0], v[bj][1]); w.y = cvt_pk_bf16(v[bj][2], v[bj][3]); w.z = cvt_pk_bf16(v[bj][4], v[bj][5]); w.w = cvt_pk_bf16(v[bj][6], v[bj][7]);
                        *(u32x4*)(base + off + 64 * bj) = w;
                    }
                } else {
                    const int nh = (KIND == 1) ? 2 : 4;
                    unsigned char* base = ws + WS_VT + ((KIND == 1) ? (size_t)g * ((size_t)NBATCH * nh * SEQ * 128) : 0);
                    unsigned off = ((unsigned)((((vb * nh + hin) * 64 + 8 * fq) << lsh) + perm_key(idx))) * 2u;
                    const unsigned dstep = 2u << lsh;
#pragma unroll
                    for (int bj = 0; bj < 2; ++bj) {
#pragma unroll
                        for (int e = 0; e < 8; ++e) {
                            const unsigned pk = cvt_pk_bf16(v[bj][e], 0.f);
                            *(bf16_t*)(base + off) = (bf16_t)(pk & 0xffffu);
                            off += dstep;
                        }
                        off += 24u * dstep;
                    }
                }
                __builtin_amdgcn_sched_barrier(0);
            }
    }
};

struct EpiRes {
    static constexpr bool PERM = true, AFTER_DRAIN = false;
    const float* hin; float* hout; bf16_t* hb; float* ssout;
    __device__ __forceinline__ void operator()(const f32x4 (&acc)[2][2][4][2], const Unit& u, int wr, int wc, int fr, int fq) const {
        asm volatile("" : "+v"(fr), "+v"(fq));
        const unsigned o0 = (unsigned)((u.pm * BM + wr * 64 + fr) * DM + u.pn * BM + wc * 32 + 8 * fq);
        f32x4 hv[2][4];
#pragma unroll
        for (int bj = 0; bj < 2; ++bj) { hv[0][2 * bj] = *(const f32x4*)((const char*)hin + (o0 + bj * HALF) * 4u); hv[0][2 * bj + 1] = *(const f32x4*)((const char*)hin + (o0 + bj * HALF) * 4u + 16); }
#pragma unroll
        for (int it = 0; it < 8; ++it) {
            const int ai = it >> 2, m = it & 3, cur = it & 1, nxt = cur ^ 1;
            if (it + 1 < 8) {
                const int ai2 = (it + 1) >> 2, m2 = (it + 1) & 3;
                const unsigned o2 = o0 + (unsigned)((ai2 * HALF + m2 * 16) * DM);
#pragma unroll
                for (int bj = 0; bj < 2; ++bj) { hv[nxt][2 * bj] = *(const f32x4*)((const char*)hin + (o2 + bj * HALF) * 4u); hv[nxt][2 * bj + 1] = *(const f32x4*)((const char*)hin + (o2 + bj * HALF) * 4u + 16); }
            }
            const unsigned o1 = o0 + (unsigned)((ai * HALF + m * 16) * DM);
            float q = 0.f;
#pragma unroll
            for (int bj = 0; bj < 2; ++bj) {
                const unsigned o = o1 + bj * HALF;
                const f32x4 v0 = acc[ai][bj][m][0] + hv[cur][2 * bj], v1 = acc[ai][bj][m][1] + hv[cur][2 * bj + 1];
                *(f32x4*)((char*)hout + o * 4u) = v0; *(f32x4*)((char*)hout + o * 4u + 16) = v1;
                u32x4 w; w.x = cvt_pk_bf16(v0[0], v0[1]); w.y = cvt_pk_bf16(v0[2], v0[3]); w.z = cvt_pk_bf16(v1[0], v1[1]); w.w = cvt_pk_bf16(v1[2], v1[3]);
                *(u32x4*)((char*)hb + o * 2u) = w;
                q += (v0[0] * v0[0] + v0[1] * v0[1]) + (v0[2] * v0[2] + v0[3] * v0[3]) + (v1[0] * v1[0] + v1[1] * v1[1]) + (v1[2] * v1[2] + v1[3] * v1[3]);
            }
            q += __shfl_xor(q, 16); q += __shfl_xor(q, 32);
            const int row = u.pm * BM + ai * HALF + wr * 64 + m * 16 + fr;
            if (fq == 0) ssout[(size_t)row * 16 + u.pn * 4 + wc] = q;
        }
    }
};

struct EpiMlp1 {
    static constexpr bool PERM = true, AFTER_DRAIN = false;
    PG8_LAS unsigned char* lds; bf16_t* U; mutable int cnt;
    __device__ __forceinline__ void operator()(const f32x4 (&acc)[2][2][4][2], const Unit& u, int wr, int wc, int fr, int fq) const {
        const PG8_LAS float* ss = (const PG8_LAS float*)(lds + LDS_RSTD) + 256 * cnt;
        ++cnt;
#pragma unroll
        for (int ai = 0; ai < 2; ++ai)
#pragma unroll
            for (int m = 0; m < 4; ++m) {
                const int row = u.pm * BM + ai * HALF + wr * 64 + m * 16 + fr;
                const float rstd = ss[ai * HALF + wr * 64 + m * 16 + fr];
#pragma unroll
                for (int bj = 0; bj < 2; ++bj) {
                    f32x4 v0 = acc[ai][bj][m][0] * rstd, v1 = acc[ai][bj][m][1] * rstd;
#pragma unroll
                    for (int j = 0; j < 4; ++j) { const float a = fmaxf(v0[j], 0.f), c = fmaxf(v1[j], 0.f); v0[j] = a * a; v1[j] = c * c; }
                    u32x4 w; w.x = cvt_pk_bf16(v0[0], v0[1]); w.y = cvt_pk_bf16(v0[2], v0[3]); w.z = cvt_pk_bf16(v1[0], v1[1]); w.w = cvt_pk_bf16(v1[2], v1[3]);
                    *(u32x4*)((char*)U + (unsigned)(row * DFF + u.pn * BM + bj * HALF + wc * 32 + 8 * fq) * 2u) = w;
                }
            }
    }
};
template <class Epi, class Sched, bool ALIGN_EPI = false, bool SP2 = false>
__device__ __forceinline__ void gemm_phase(PG8_LAS unsigned char* lds, const Gemm g, const Sched& S, const Epi& E) {
    int tid_ = threadIdx.x; asm volatile("" : "+v"(tid_));
    const int tid = tid_, wid = __builtin_amdgcn_readfirstlane(tid >> 6), lane = tid & 63, wr = wid >> 2, wc = wid & 3, fr = lane & 15, fq = lane >> 4;
    const int K = g.K, nt = K / BK;
    unsigned voffA[2], voffB[2];
#pragma unroll
    for (int i = 0; i < 2; ++i) { int R, C; stage_rc(tid * 16 + i * 8192, R, C); const int Rb = Epi::PERM ? ((R & ~31) + perm32(R & 31)) : R;
        voffA[i] = (unsigned)(R * K + C) * 2u; voffB[i] = (unsigned)(Rb * K + C) * 2u; }
    const size_t kstep = (size_t)(BK * 2);
    const size_t hstep = (size_t)HALF * K * 2;
    const size_t tstep = 2 * hstep;
    const unsigned ldsw = (unsigned)wid * 1024u;
    const int aoff = lds_byte(wr * 64 + fr, fq * 8), boff = lds_byte(wc * 32 + fr, fq * 8);
#define PG8_SA(b, h) (((b) * 2 + (h)) * HTB)
#define PG8_SB(b, h) ((4 + (b) * 2 + (h)) * HTB)
#define PG8_STAGE(bufoff, gbase, voff) do { _Pragma("unroll") for (int _i = 0; _i < 2; ++_i) \
        __builtin_amdgcn_global_load_lds((const unsigned*)((const char*)(gbase) + (voff)[_i]), (PG8_LAS unsigned*)(lds + (bufoff) + ldsw + _i * 8192), 16, 0, 0); } while (0)
#define PG8_LDA(dst, b, h) do { _Pragma("unroll") for (int m = 0; m < 4; ++m) _Pragma("unroll") for (int k = 0; k < 2; ++k) dst[m][k] = *(const PG8_LAS bf16x8*)(lds + PG8_SA(b, h) + aoff + m * 2048 + k * 1024); } while (0)
#define PG8_LDB(dst, b, h) do { _Pragma("unroll") for (int n = 0; n < 2; ++n) _Pragma("unroll") for (int k = 0; k < 2; ++k) dst[n][k] = *(const PG8_LAS bf16x8*)(lds + PG8_SB(b, h) + boff + n * 2048 + k * 1024); } while (0)
#define PG8_MMA(ai, bj, At, Bt) do { __builtin_amdgcn_s_setprio(1); _Pragma("unroll") for (int m = 0; m < 4; ++m) _Pragma("unroll") for (int n = 0; n < 2; ++n) _Pragma("unroll") for (int k = 0; k < 2; ++k) \
        acc[ai][bj][m][n] = __builtin_amdgcn_mfma_f32_16x16x32_bf16(Bt[n][k], At[m][k], acc[ai][bj][m][n], 0, 0, 0); __builtin_amdgcn_s_setprio(0); } while (0)
#define PG8_WAIT_V(n) asm volatile("s_waitcnt vmcnt(" #n ")" ::: "memory")
#define PG8_WAIT_L(n) asm volatile("s_waitcnt lgkmcnt(" #n ")" ::: "memory")
#define PG8_BAR __builtin_amdgcn_s_barrier()
#define PG8_SCHED __builtin_amdgcn_sched_barrier(0)
    Unit cur, nxt; int ui = 0;
    if (!S.next(0, cur)) return;
    f32x4 acc[2][2][4][2];
#pragma unroll
    for (int a = 0; a < 2; ++a)
#pragma unroll
        for (int b = 0; b < 2; ++b)
#pragma unroll
            for (int m = 0; m < 4; ++m)
#pragma unroll
                for (int n = 0; n < 2; ++n) acc[a][b][m][n] = (f32x4){0.f, 0.f, 0.f, 0.f};
    bf16x8 At[4][2], B0[2][2], B1[2][2];
    const char* cA = (const char*)g.A + (size_t)cur.pm * tstep; const char* cB = (const char*)g.Bt + (size_t)cur.pn * tstep;
    S.a_ready(cur);
    if constexpr (SP2) {
        PG8_STAGE(PG8_SB(0, 0), cB, voffB); PG8_STAGE(PG8_SB(0, 1), cB + hstep, voffB); PG8_STAGE(PG8_SA(0, 0), cA, voffA); PG8_STAGE(PG8_SA(0, 1), cA + hstep, voffA);
        if (wr == 1) PG8_BAR;
        PG8_WAIT_V(2); PG8_BAR;
        PG8_STAGE(PG8_SB(1, 0), cB + kstep, voffB); PG8_STAGE(PG8_SA(1, 0), cA + kstep, voffA); PG8_STAGE(PG8_SB(1, 1), cB + hstep + kstep, voffB);
        PG8_WAIT_V(6); PG8_BAR;
    } else {
        PG8_STAGE(PG8_SB(0, 0), cB, voffB); PG8_STAGE(PG8_SA(0, 0), cA, voffA); PG8_STAGE(PG8_SB(0, 1), cB + hstep, voffB); PG8_STAGE(PG8_SA(0, 1), cA + hstep, voffA);
        if (wr == 1) PG8_BAR;
        PG8_WAIT_V(4); PG8_BAR;
        PG8_STAGE(PG8_SB(1, 0), cB + kstep, voffB); PG8_STAGE(PG8_SA(1, 0), cA + kstep, voffA); PG8_STAGE(PG8_SB(1, 1), cB + hstep + kstep, voffB);
        PG8_WAIT_V(6); PG8_BAR;
    }
    for (;;) {
        const bool has_next = S.next(ui + 1, nxt);
        const char* nA = has_next ? (const char*)g.A + (size_t)nxt.pm * tstep : cA; const char* nB = has_next ? (const char*)g.Bt + (size_t)nxt.pn * tstep : cB;
        for (int t = 0; t < nt; t += 2) {
            const bool last = (t == nt - 2);
            const char* a1 = cA + (size_t)(t + 1) * kstep;
            const char* a2 = last ? nA : cA + (size_t)(t + 2) * kstep; const char* b2 = last ? nB : cB + (size_t)(t + 2) * kstep;
            const char* a3 = a2 + kstep; const char* b3 = b2 + kstep;
            if (last && has_next) S.a_ready(nxt);
            if constexpr (SP2) {
            PG8_LDB(B0, 0, 0); PG8_LDB(B1, 0, 1); PG8_SCHED; PG8_LDA(At, 0, 0); PG8_STAGE(PG8_SA(1, 1), a1 + hstep, voffA);
            PG8_WAIT_V(8); PG8_WAIT_L(0); PG8_BAR; PG8_MMA(0, 0, At, B0); PG8_MMA(0, 1, At, B1); PG8_BAR; PG8_SCHED;
            PG8_LDA(At, 0, 1); PG8_STAGE(PG8_SB(0, 0), b2, voffB); PG8_STAGE(PG8_SB(0, 1), b2 + hstep, voffB); PG8_STAGE(PG8_SA(0, 0), a2, voffA);
            PG8_WAIT_V(8); PG8_WAIT_L(0); PG8_BAR; PG8_MMA(1, 0, At, B0); PG8_MMA(1, 1, At, B1); PG8_BAR; PG8_SCHED;
            PG8_LDB(B0, 1, 0); PG8_LDB(B1, 1, 1); PG8_SCHED; PG8_LDA(At, 1, 0); PG8_STAGE(PG8_SA(0, 1), a2 + hstep, voffA);
            PG8_WAIT_V(8); PG8_WAIT_L(0); PG8_BAR; PG8_MMA(0, 0, At, B0); PG8_MMA(0, 1, At, B1); PG8_BAR; PG8_SCHED;
            PG8_LDA(At, 1, 1); PG8_STAGE(PG8_SB(1, 0), b3, voffB); PG8_STAGE(PG8_SB(1, 1), b3 + hstep, voffB); PG8_STAGE(PG8_SA(1, 0), a3, voffA);
            PG8_WAIT_V(8); PG8_WAIT_L(0); PG8_BAR; PG8_MMA(1, 0, At, B0); PG8_MMA(1, 1, At, B1); PG8_BAR; PG8_SCHED;
            } else {
            PG8_LDB(B0, 0, 0); PG8_SCHED; PG8_LDA(At, 0, 0); PG8_STAGE(PG8_SA(1, 1), a1 + hstep, voffA);
            PG8_WAIT_L(8); PG8_BAR; PG8_WAIT_L(0); PG8_MMA(0, 0, At, B0); PG8_BAR; PG8_SCHED;
            PG8_LDB(B1, 0, 1); PG8_STAGE(PG8_SB(0, 0), b2, voffB);
            PG8_BAR; PG8_WAIT_L(0); PG8_MMA(0, 1, At, B1); PG8_BAR;
            PG8_LDA(At, 0, 1); PG8_STAGE(PG8_SA(0, 0), a2, voffA);
            PG8_BAR; PG8_WAIT_L(0); PG8_MMA(1, 0, At, B0); PG8_BAR; PG8_SCHED;
            PG8_STAGE(PG8_SB(0, 1), b2 + hstep, voffB);
            PG8_WAIT_V(6); PG8_BAR; PG8_MMA(1, 1, At, B1); PG8_BAR;
            PG8_LDB(B0, 1, 0); PG8_SCHED; PG8_LDA(At, 1, 0); PG8_STAGE(PG8_SA(0, 1), a2 + hstep, voffA);
            PG8_WAIT_L(8); PG8_BAR; PG8_WAIT_L(0); PG8_MMA(0, 0, At, B0); PG8_BAR; PG8_SCHED;
            PG8_LDB(B1, 1, 1); PG8_STAGE(PG8_SB(1, 0), b3, voffB);
            PG8_BAR; PG8_WAIT_L(0); PG8_MMA(0, 1, At, B1); PG8_BAR;
            PG8_LDA(At, 1, 1); PG8_STAGE(PG8_SA(1, 0), a3, voffA);
            PG8_BAR; PG8_WAIT_L(0); PG8_MMA(1, 0, At, B0); PG8_BAR; PG8_SCHED;
            PG8_STAGE(PG8_SB(1, 1), b3 + hstep, voffB);
            PG8_WAIT_V(6); PG8_BAR; PG8_MMA(1, 1, At, B1); PG8_BAR;
            }
        }
        if constexpr (ALIGN_EPI) { if (wr == 0) PG8_BAR; }
        if constexpr (!Epi::AFTER_DRAIN) { E(acc, cur, wr, wc, fr, fq); S.done(cur); }
        if (!has_next) break;
#pragma unroll
        for (int a = 0; a < 2; ++a)
#pragma unroll
            for (int b = 0; b < 2; ++b)
#pragma unroll
                for (int m = 0; m < 4; ++m)
#pragma unroll
                    for (int n = 0; n < 2; ++n) acc[a][b][m][n] = (f32x4){0.f, 0.f, 0.f, 0.f};
        cur = nxt; cA = nA; cB = nB; ++ui;
        if constexpr (ALIGN_EPI) { if (wr == 1) PG8_BAR; }
    }
    PG8_WAIT_V(0);
    if constexpr (!ALIGN_EPI) { if (wr == 0) PG8_BAR; }
    PG8_BAR;
    if constexpr (Epi::AFTER_DRAIN) { E.fused(acc, cur, wr, wc, fr, fq, lds, wid, lane); S.done(cur); }
#undef PG8_SA
#undef PG8_SB
#undef PG8_STAGE
#undef PG8_LDA
#undef PG8_LDB
#undef PG8_MMA
#undef PG8_WAIT_V
#undef PG8_WAIT_L
#undef PG8_BAR
#undef PG8_SCHED
}
}
using namespace pg8;
using pg8::bf16_t; using pg8::bf16x8; using pg8::f32x4; using pg8::u32x4; using pg8::cvt_pk_bf16;
#define LAS __attribute__((address_space(3)))
typedef float f32x16 __attribute__((ext_vector_type(16)));
typedef unsigned u32x2 __attribute__((ext_vector_type(2)));
#define LDS_WAIT() asm volatile("s_waitcnt lgkmcnt(0)" ::: "memory")
typedef float f32x2_t __attribute__((ext_vector_type(2)));
typedef __bf16 bf16x2_t __attribute__((ext_vector_type(2)));
__device__ __forceinline__ unsigned cvtpk_s(float lo, float hi) { f32x2_t v = {lo, hi}; bf16x2_t b = __builtin_convertvector(v, bf16x2_t); return __builtin_bit_cast(unsigned, b); }

constexpr size_t WE_QKV0 = 0, WE_QKV1 = WE_QKV0 + 1536 * 1024, WE_QKV2 = WE_QKV1 + 2048 * 1024, WE_QKV3 = WE_QKV2 + 1536 * 1024;
constexpr size_t WE_WO0 = WE_QKV3 + 1536 * 1024, WE_WO1 = WE_WO0 + 1024 * 1024, WE_WO2 = WE_WO1 + 1024 * 1152, WE_WO3 = WE_WO2 + 1024 * 1024;
constexpr size_t WE_W1 = WE_WO3 + 1024 * 1024, WE_W2 = WE_W1 + 4 * (size_t)4096 * 1024, WE_END = WE_W2 + 4 * (size_t)4096 * 1024;
static_assert(WS_W + WE_END * 2 <= WS_HB, "weights fit");

struct Params { const float* in[15]; float* out; unsigned char* ws; };

__device__ __forceinline__ float wave_sum(float v) {
#pragma unroll
    for (int o = 1; o < 64; o <<= 1) v += __shfl_xor(v, o);
    return v;
}

__device__ __forceinline__ void tr_item(const float* __restrict__ W, int K, int N, int Npad, bf16_t* WT, const float* __restrict__ gain, int mode, int nheads, int nperm, LAS float* scr, int item, int lane) {
    const int nblk = Npad >> 5, kb = item / nblk, nb = item - kb * nblk, k0 = 64 * kb, R0 = 32 * nb;
    int src0 = R0; bool valid = true, perm = false;
    if (mode == 1) { const int pn = R0 >> 8, c = R0 & 255, bj = c >> 7, wc = (c >> 5) & 3, hcol = 4 * pn + wc; valid = hcol < nheads; perm = hcol < nperm; src0 = hcol * 64 + 32 * bj; }
#pragma unroll 8
    for (int i = 0; i < 32; ++i) {
        const int kk = 2 * i + (lane >> 5);
        float w = 0.f;
        if (valid) { w = W[(size_t)(k0 + kk) * N + src0 + (lane & 31)]; if (gain) w *= gain[k0 + kk]; }
        scr[kk * 33 + (lane & 31)] = w;
    }
    LDS_WAIT();
    const int c8 = lane & 7;
#pragma unroll
    for (int jj = 0; jj < 4; ++jj) {
        const int e = (lane >> 3) + 8 * jj;
        const int se = perm ? (16 * ((e >> 2) & 1) + 4 * (e >> 3) + (e & 3)) : e;
        const LAS float* s = scr + (8 * c8) * 33 + se;
        u32x4 o; o.x = cvt_pk_bf16(s[0 * 33], s[1 * 33]); o.y = cvt_pk_bf16(s[2 * 33], s[3 * 33]); o.z = cvt_pk_bf16(s[4 * 33], s[5 * 33]); o.w = cvt_pk_bf16(s[6 * 33], s[7 * 33]);
        *(u32x4*)(WT + (size_t)(R0 + e) * K + k0 + 8 * c8) = o;
    }
    LDS_WAIT();
}

__device__ __forceinline__ void prologue(const Params& p, LAS unsigned char* lds, int gw, int NGW, int wave, int lane) {
    float* ss = (float*)(p.ws + WS_SSP);
    bf16_t* WB = (bf16_t*)(p.ws + WS_W);
    LAS float* scr = (LAS float*)(lds + wave * 16384);
    const float* attn_norm = p.in[1]; const float* mlp_norm = p.in[2];
    constexpr int I_QA = 16 * (1536 / 32), I_QB = 16 * (2048 / 32), I_WO = 16 * 32, I_WOB = 18 * 32, I_W1 = 16 * 128, I_W2 = 64 * 32;
    constexpr int NITEMS = 3 * I_QA + I_QB + 3 * I_WO + I_WOB + 4 * I_W1 + 4 * I_W2;
    for (int it = gw; it < NITEMS; it += NGW) {
        int r = it;
        if (r < I_QA) { tr_item(p.in[3], 1024, 1536, 1536, WB + WE_QKV0, attn_norm + 0 * DM, 1, 24, 20, scr, r, lane); continue; } r -= I_QA;
        if (r < I_QB) { tr_item(p.in[7], 1024, 1920, 2048, WB + WE_QKV1, attn_norm + 1 * DM, 1, 30, 0, scr, r, lane); continue; } r -= I_QB;
        if (r < I_QA) { tr_item(p.in[9], 1024, 1536, 1536, WB + WE_QKV2, attn_norm + 2 * DM, 1, 24, 0, scr, r, lane); continue; } r -= I_QA;
        if (r < I_QA) { tr_item(p.in[3] + (size_t)1024 * 1536, 1024, 1536, 1536, WB + WE_QKV3, attn_norm + 3 * DM, 1, 24, 20, scr, r, lane); continue; } r -= I_QA;
        if (r < I_WO) { tr_item(p.in[6], 1024, 1024, 1024, WB + WE_WO0, nullptr, 0, 0, 0, scr, r, lane); continue; } r -= I_WO;
        if (r < I_WOB) { tr_item(p.in[8], 1152, 1024, 1024, WB + WE_WO1, nullptr, 0, 0, 0, scr, r, lane); continue; } r -= I_WOB;
        if (r < I_WO) { tr_item(p.in[11], 1024, 1024, 1024, WB + WE_WO2, nullptr, 0, 0, 0, scr, r, lane); continue; } r -= I_WO;
        if (r < I_WO) { tr_item(p.in[6] + (size_t)1024 * 1024, 1024, 1024, 1024, WB + WE_WO3, nullptr, 0, 0, 0, scr, r, lane); continue; } r -= I_WO;
        if (r < 4 * I_W1) { const int l = r / I_W1; tr_item(p.in[12] + (size_t)l * 1024 * 4096, 1024, 4096, 4096, WB + WE_W1 + (size_t)l * 4096 * 1024, mlp_norm + l * DM, 0, 0, 0, scr, r - l * I_W1, lane); continue; } r -= 4 * I_W1;
        { const int l = r / I_W2; tr_item(p.in[13] + (size_t)l * 4096 * 1024, 4096, 1024, 1024, WB + WE_W2 + (size_t)l * 4096 * 1024, nullptr, 0, 0, 0, scr, r - l * I_W2, lane); }
    }
    const float* x = p.in[0]; bf16_t* hb = (bf16_t*)(p.ws + WS_HB);
    for (int m = gw; m < MTOK; m += NGW) {
        const f32x4* xr = (const f32x4*)(x + (size_t)m * DM) + lane;
        f32x4 v[4]; float s = 0.f;
#pragma unroll
        for (int j = 0; j < 4; ++j) { v[j] = xr[64 * j]; s += (v[j].x * v[j].x + v[j].y * v[j].y) + (v[j].z * v[j].z + v[j].w * v[j].w); }
        s = wave_sum(s);
        u32x2* o8 = (u32x2*)(hb + (size_t)m * DM) + lane;
#pragma unroll
        for (int j = 0; j < 4; ++j) { u32x2 w; w.x = cvt_pk_bf16(v[j].x, v[j].y); w.y = cvt_pk_bf16(v[j].z, v[j].w); o8[64 * j] = w; }
        if (lane < 16) ss[(size_t)m * 16 + lane] = (lane == 0) ? s : 0.f;
    }
}

constexpr int AT_ROWB = 144, AT_TILEB = 64 * AT_ROWB, AT_BUFB = 2 * AT_TILEB;
template <int MODE> __device__ __forceinline__ void attn_phase(LAS unsigned char* lds, const bf16_t* __restrict__ Qg, const bf16_t* __restrict__ Kg, const bf16_t* __restrict__ Vg, bf16_t* Og, float* LSE, const float* __restrict__ sinks) {
    int tid_ = threadIdx.x; asm volatile("" : "+v"(tid_));
    const int tid = tid_, lane = tid & 63, wave = __builtin_amdgcn_readfirstlane(tid >> 6), r32 = lane & 31, hi = lane >> 5;
    constexpr int NQ = (MODE == 0) ? 2 : 1;
    constexpr int QU = 256 * NQ;
    constexpr int NUNITS = (MODE == 1) ? 3 * 768 : 2048 / NQ;
    constexpr int HQ = (MODE == 1) ? 6 : 16, HKV = (MODE == 1) ? 2 : 4, WIN = (MODE == 1) ? 64 : 128, OPITCH = (MODE == 1) ? 1152 : 1024;
    const int srow = tid >> 3, schunk = tid & 7;
    const unsigned sdst = (unsigned)(srow * AT_ROWB + schunk * 16);
    for (int un = blockIdx.x; un < NUNITS; un += gridDim.x) {
        int g = 0, vb, hq, qb;
        if (MODE == 1) { g = un / 768; const int r = un - g * 768; const int nqbs = 4 - 2 * g;   qb = r & ((1 << nqbs) - 1); const int r2 = r >> nqbs; hq = r2 % 6; vb = r2 / 6; }
        else if (MODE == 0) { qb = un & 7; hq = (un >> 3) & 15; vb = un >> 7; }
        else { qb = un & 15; hq = (un >> 4) & 15; vb = un >> 8; }
        const int gsh = 2 * g, lsh = 12 - gsh, L = 1 << lsh;
        const int kvh = (MODE == 1) ? hq / 3 : hq >> 2;
        const int q0 = qb * QU, qw = q0 + 32 * NQ * wave;
        const size_t gq = (MODE == 1) ? (size_t)g * ((size_t)NBATCH * 6 * SEQ * 64) : 0, gk = (MODE == 1) ? (size_t)g * ((size_t)NBATCH * 2 * SEQ * 64) : 0;
        bf16x8 qf[NQ][4];
#pragma unroll
        for (int j = 0; j < NQ; ++j) {
            const bf16_t* qp = Qg + gq + ((((size_t)(vb * HQ + hq)) << lsh) + qw + 32 * j + r32) * 64 + 8 * hi;
#pragma unroll
            for (int s = 0; s < 4; ++s) qf[j][s] = *(const bf16x8*)(qp + 16 * s);
        }
        const bf16_t* kbase = Kg + gk + (((size_t)(vb * HKV + kvh)) << lsh) * 64;
        const bf16_t* vbase = Vg + gk + ((((size_t)(vb * HKV + kvh)) * 64) << lsh);
        int lo = 0, hiT = L >> 6;
        if (MODE != 0) { lo = (q0 - WIN) >> 6; if (lo < 0) lo = 0; int h2 = ((q0 + 255 + WIN) >> 6) + 1; if (h2 < hiT) hiT = h2; }
        float slope2 = 0.f;
        if (MODE == 1) slope2 = exp2f(-8.0f * (float)(g * 6 + hq + 1) / 18.0f) * (float)(1 << gsh) * LOG2E;
        if (MODE == 2) slope2 = exp2f(-8.0f * (float)(hq + 1) / 16.0f) * LOG2E;
        float mrun[NQ], lrun[NQ];
        f32x16 oacc[NQ][2];
#pragma unroll
        for (int j = 0; j < NQ; ++j) {
            mrun[j] = NEG_BIG; lrun[j] = 0.f;
            if (MODE == 2) { mrun[j] = sinks[hq] * LOG2E; lrun[j] = (hi == 0) ? 1.f : 0.f; }
#pragma unroll
            for (int i = 0; i < 16; ++i) { oacc[j][0][i] = 0.f; oacc[j][1][i] = 0.f; }
        }
        u32x4 kreg, vreg;
        kreg = *(const u32x4*)(kbase + (size_t)lo * 4096 + tid * 8);
        vreg = *(const u32x4*)(vbase + ((size_t)srow << lsh) + lo * 64 + schunk * 8);
        *(LAS u32x4*)(lds + sdst) = kreg; *(LAS u32x4*)(lds + AT_TILEB + sdst) = vreg;
        __syncthreads();
        for (int kt = lo; kt < hiT; ++kt) {
            const int buf = (kt - lo) & 1;
            const bool more = (kt + 1 < hiT);
            if (more) {
                kreg = *(const u32x4*)(kbase + (size_t)(kt + 1) * 4096 + tid * 8);
                vreg = *(const u32x4*)(vbase + ((size_t)srow << lsh) + (kt + 1) * 64 + schunk * 8);
            }
            bool active = true;
            if (MODE != 0) active = !((64 * kt + 63 < qw - WIN) || (64 * kt > qw + 31 + WIN));
            if (active) {
                const LAS unsigned char* kl = lds + buf * AT_BUFB;
                const LAS unsigned char* vl = kl + AT_TILEB;
                f32x16 sacc[NQ][2];
#pragma unroll
                for (int kb = 0; kb < 2; ++kb) {
#pragma unroll
                    for (int j = 0; j < NQ; ++j)
#pragma unroll
                        for (int i = 0; i < 16; ++i) sacc[j][kb][i] = 0.f;
#pragma unroll
                    for (int s = 0; s < 4; ++s) {
                        const bf16x8 kf = *(const LAS bf16x8*)(kl + (32 * kb + r32) * AT_ROWB + (2 * s + hi) * 16);
#pragma unroll
                        for (int j = 0; j < NQ; ++j) sacc[j][kb] = __builtin_amdgcn_mfma_f32_32x32x16_bf16(kf, qf[j][s], sacc[j][kb], 0, 0, 0);
                    }
                }
                bf16x8 pf[NQ][2][2];
#pragma unroll
                for (int j = 0; j < NQ; ++j) {
                    if (MODE != 0) {
                        const float fd0 = (float)(64 * kt + 4 * hi - (qw + r32));
#pragma unroll
                        for (int kb = 0; kb < 2; ++kb)
#pragma unroll
                            for (int i = 0; i < 16; ++i) {
                                const float dist = fabsf(fd0 + (float)(32 * kb + 8 * (i >> 2) + (i & 3)));
                                sacc[j][kb][i] = (dist <= (float)WIN) ? (sacc[j][kb][i] - slope2 * dist) : NEG_BIG;
                            }
                    }
                    float mx = sacc[j][0][0];
#pragma unroll
                    for (int i = 1; i < 16; ++i) mx = fmaxf(mx, sacc[j][0][i]);
#pragma unroll
                    for (int i = 0; i < 16; ++i) mx = fmaxf(mx, sacc[j][1][i]);
                    mx = fmaxf(mx, __shfl_xor(mx, 32));
                    if (__builtin_amdgcn_ballot_w64(mx > mrun[j]) != 0ull) {
                        const float mnew = fmaxf(mrun[j], mx);
                        const float alpha = __builtin_amdgcn_exp2f(mrun[j] - mnew);
                        mrun[j] = mnew;
                        lrun[j] *= alpha;
#pragma unroll
                        for (int i = 0; i < 16; ++i) { oacc[j][0][i] *= alpha; oacc[j][1][i] *= alpha; }
                    }
                    const float mcur = mrun[j];
                    float ps = 0.f;
#pragma unroll
                    for (int kb = 0; kb < 2; ++kb)
#pragma unroll
                        for (int i = 0; i < 16; ++i) { const float pv = __builtin_amdgcn_exp2f(sacc[j][kb][i] - mcur); sacc[j][kb][i] = pv; ps += pv; }
                    lrun[j] += ps;
#pragma unroll
                    for (int kb = 0; kb < 2; ++kb)
#pragma unroll
                        for (int hh = 0; hh < 2; ++hh) {
                            u32x4 w; w.x = cvtpk_s(sacc[j][kb][8 * hh + 0], sacc[j][kb][8 * hh + 1]); w.y = cvtpk_s(sacc[j][kb][8 * hh + 2], sacc[j][kb][8 * hh + 3]);
                            w.z = cvtpk_s(sacc[j][kb][8 * hh + 4], sacc[j][kb][8 * hh + 5]); w.w = cvtpk_s(sacc[j][kb][8 * hh + 6], sacc[j][kb][8 * hh + 7]);
                            pf[j][kb][hh] = __builtin_bit_cast(bf16x8, w);
                        }
                }
#pragma unroll
                for (int db = 0; db < 2; ++db)
#pragma unroll
                    for (int kb = 0; kb < 2; ++kb)
#pragma unroll
                        for (int hh = 0; hh < 2; ++hh) {
                            const bf16x8 vf = *(const LAS bf16x8*)(vl + (32 * db + r32) * AT_ROWB + (2 * (2 * kb + hh) + hi) * 16);
#pragma unroll
                            for (int j = 0; j < NQ; ++j) oacc[j][db] = __builtin_amdgcn_mfma_f32_32x32x16_bf16(vf, pf[j][kb][hh], oacc[j][db], 0, 0, 0);
                        }
            }
            if (more) {
                LAS unsigned char* nb = lds + (buf ^ 1) * AT_BUFB;
                *(LAS u32x4*)(nb + sdst) = kreg; *(LAS u32x4*)(nb + AT_TILEB + sdst) = vreg;
            }
            __syncthreads();
        }
#pragma unroll
        for (int j = 0; j < NQ; ++j) {
            const float ltot = lrun[j] + __shfl_xor(lrun[j], 32);
            const float inv = 1.0f / ltot;
            int row, hglob;
            if (MODE == 1) { const int dmask = (1 << gsh) - 1; const int b = vb >> gsh, rr = vb & dmask; row = b * SEQ + rr + ((qw + r32) << gsh); hglob = g * 6 + hq; }
            else { row = vb * SEQ + qw + 32 * j + r32; hglob = hq; }
            bf16_t* op = Og + (size_t)row * OPITCH + hglob * 64 + 4 * hi;
#pragma unroll
            for (int db = 0; db < 2; ++db)
#pragma unroll
                for (int q4 = 0; q4 < 4; ++q4) {
                    u32x2 w; w.x = cvtpk_s(oacc[j][db][4 * q4 + 0] * inv, oacc[j][db][4 * q4 + 1] * inv); w.y = cvtpk_s(oacc[j][db][4 * q4 + 2] * inv, oacc[j][db][4 * q4 + 3] * inv);
                    *(u32x2*)(op + 32 * db + 8 * q4) = w;
                }
            if (MODE == 1) { if (hi == 0) LSE[(size_t)row * 18 + hglob] = mrun[j] + __builtin_amdgcn_logf(ltot); }
        }
    }
}

__device__ __forceinline__ void attn_dense_fast(LAS unsigned char* lds, const bf16_t* __restrict__ Qg, const bf16_t* __restrict__ Kg, const bf16_t* __restrict__ Vg, bf16_t* Og) {
    int tid_ = threadIdx.x; asm volatile("" : "+v"(tid_));
    const int tid = tid_, lane = tid & 63, wave = __builtin_amdgcn_readfirstlane(tid >> 6), r32 = lane & 31, hi = lane >> 5;
    constexpr int NQ = 2, NUNITS = 1024, NT = SEQ / 64;
    constexpr int VRING = 2 * AT_TILEB;
    const int srow = tid >> 3, schunk = tid & 7;
    const unsigned sdst = (unsigned)(srow * AT_ROWB + schunk * 16);
    { unsigned z = 0u; asm volatile("" : "+v"(z));
      for (int i = tid; i < 3 * AT_TILEB / 16; i += 512) *(LAS u32x4*)(lds + VRING + i * 16) = (u32x4){z, z, z, z}; }
    __syncthreads();
    for (int un = blockIdx.x; un < NUNITS; un += gridDim.x) {
        const int qb = un & 7, hq = (un >> 3) & 15, vb = un >> 7, kvh = hq >> 2;
        const int qw = qb * 512 + 64 * wave;
        bf16x8 qf[NQ][4];
#pragma unroll
        for (int j = 0; j < NQ; ++j) {
            const bf16_t* qp = Qg + ((size_t)(vb * 16 + hq) * SEQ + qw + 32 * j + r32) * 64 + 8 * hi;
#pragma unroll
            for (int s = 0; s < 4; ++s) qf[j][s] = *(const bf16x8*)(qp + 16 * s);
        }
        const char* kbu = (const char*)(Kg + (size_t)(vb * 4 + kvh) * SEQ * 64);
        const char* vbu = (const char*)(Vg + (size_t)(vb * 4 + kvh) * 64 * SEQ);
        const unsigned kof = (unsigned)tid * 16u, vof = (unsigned)(srow * SEQ + schunk * 8) * 2u;
        float lsum[NQ]; f32x16 oacc[NQ][2]; bf16x8 pfp[NQ][2][2];
#pragma unroll
        for (int j = 0; j < NQ; ++j) {
            lsum[j] = 0.f;
#pragma unroll
            for (int i = 0; i < 16; ++i) { oacc[j][0][i] = 0.f; oacc[j][1][i] = 0.f; }
#pragma unroll
            for (int kb = 0; kb < 2; ++kb)
#pragma unroll
                for (int hh = 0; hh < 2; ++hh) pfp[j][kb][hh] = (bf16x8){0, 0, 0, 0, 0, 0, 0, 0};
        }
        u32x4 kreg = *(const u32x4*)(kbu + kof), vreg = *(const u32x4*)(vbu + vof);
        *(LAS u32x4*)(lds + sdst) = kreg; *(LAS u32x4*)(lds + VRING + sdst) = vreg;
        __syncthreads();
        int vprev = VRING + 2 * AT_TILEB, vcur = VRING, vnext = VRING + AT_TILEB;
        f32x16 sB[NQ];
#pragma unroll
        for (int j = 0; j < NQ; ++j)
#pragma unroll
            for (int i = 0; i < 16; ++i) sB[j][i] = NEG_BIG;
#pragma unroll 1
        for (int kt = 0; kt < NT; ++kt) {
            const int tn = (kt + 1 < NT) ? kt + 1 : kt;
            kreg = *(const u32x4*)(kbu + (size_t)tn * 8192 + kof);
            vreg = *(const u32x4*)(vbu + (size_t)tn * 128 + vof);
            const LAS unsigned char* kl = lds + (kt & 1) * AT_TILEB;
            const LAS unsigned char* vl = lds + vprev;
#define AF_QK(dst, kb) do { _Pragma("unroll") for (int j = 0; j < NQ; ++j) _Pragma("unroll") for (int i = 0; i < 16; ++i) dst[j][i] = 0.f; \
            _Pragma("unroll") for (int s = 0; s < 4; ++s) { const bf16x8 kf = *(const LAS bf16x8*)(kl + (32 * (kb) + r32) * AT_ROWB + (2 * s + hi) * 16); \
                _Pragma("unroll") for (int j = 0; j < NQ; ++j) dst[j] = __builtin_amdgcn_mfma_f32_32x32x16_bf16(kf, qf[j][s], dst[j], 0, 0, 0); } } while (0)
#define AF_PV(kb) do { _Pragma("unroll") for (int hh = 0; hh < 2; ++hh) _Pragma("unroll") for (int db = 0; db < 2; ++db) { \
            const bf16x8 vf = *(const LAS bf16x8*)(vl + (32 * db + r32) * AT_ROWB + (2 * (2 * (kb) + hh) + hi) * 16); \
            _Pragma("unroll") for (int j = 0; j < NQ; ++j) oacc[j][db] = __builtin_amdgcn_mfma_f32_32x32x16_bf16(vf, pfp[j][kb][hh], oacc[j][db], 0, 0, 0); } } while (0)
#define AF_EXP(src, kb) do { _Pragma("unroll") for (int j = 0; j < NQ; ++j) { float ps = 0.f; \
            _Pragma("unroll") for (int i = 0; i < 16; ++i) { const float pv = __builtin_amdgcn_exp2f(src[j][i]); src[j][i] = pv; ps += pv; } \
            lsum[j] += ps; \
            _Pragma("unroll") for (int hh = 0; hh < 2; ++hh) { u32x4 w; w.x = cvtpk_s(src[j][8 * hh + 0], src[j][8 * hh + 1]); w.y = cvtpk_s(src[j][8 * hh + 2], src[j][8 * hh + 3]); \
                w.z = cvtpk_s(src[j][8 * hh + 4], src[j][8 * hh + 5]); w.w = cvtpk_s(src[j][8 * hh + 6], src[j][8 * hh + 7]); pfp[j][kb][hh] = __builtin_bit_cast(bf16x8, w); } } } while (0)
#define AF_SCHED() do { _Pragma("unroll") for (int q_ = 0; q_ < 16; ++q_) { __builtin_amdgcn_sched_group_barrier(0x008, 1, 0); __builtin_amdgcn_sched_group_barrier(0x400, 2, 0); \
            __builtin_amdgcn_sched_group_barrier(0x002, 3, 0); __builtin_amdgcn_sched_group_barrier(0x100, 1, 0); } } while (0)
            f32x16 sA[NQ];
            AF_QK(sA, 0); AF_PV(0); AF_EXP(sB, 1);
            AF_SCHED();
            AF_QK(sB, 1); AF_PV(1); AF_EXP(sA, 0);
            AF_SCHED();
            *(LAS u32x4*)(lds + ((kt + 1) & 1) * AT_TILEB + sdst) = kreg; *(LAS u32x4*)(lds + vnext + sdst) = vreg;
            { const int tmp = vprev; vprev = vcur; vcur = vnext; vnext = tmp; }
            __syncthreads();
        }
        {
            const LAS unsigned char* vl = lds + vprev;
            AF_EXP(sB, 1);
            AF_PV(0); AF_PV(1);
        }
        __syncthreads();
#pragma unroll
        for (int j = 0; j < NQ; ++j) {
            const float ltot = lsum[j] + __shfl_xor(lsum[j], 32);
            const float inv = 1.0f / ltot;
            const int row = vb * SEQ + qw + 32 * j + r32;
            bf16_t* op = Og + (size_t)row * 1024 + hq * 64 + 4 * hi;
#pragma unroll
            for (int db = 0; db < 2; ++db)
#pragma unroll
                for (int q4 = 0; q4 < 4; ++q4) {
                    u32x2 w; w.x = cvtpk_s(oacc[j][db][4 * q4 + 0] * inv, oacc[j][db][4 * q4 + 1] * inv); w.y = cvtpk_s(oacc[j][db][4 * q4 + 2] * inv, oacc[j][db][4 * q4 + 3] * inv);
                    *(u32x2*)(op + 32 * db + 8 * q4) = w;
                }
        }
    }
}

__device__ __forceinline__ void mixb_fix(bf16_t* Og, const float* LSE, int gw, int NGW, int lane) {
    asm volatile("" : "+v"(lane));
    for (int m = gw; m < MTOK; m += NGW) {
        const float* ls = LSE + (size_t)m * 18;
#pragma unroll
        for (int c3 = 0; c3 < 3; ++c3) {
            const int c = lane + 64 * c3;
            if (c < 144) {
                const int head = c >> 3, g = head / 6, kr = head - 6 * g;
                const float l0 = ls[kr], l1 = ls[6 + kr], l2 = ls[12 + kr];
                const float mx = fmaxf(l0, fmaxf(l1, l2));
                const float e0 = exp2f(l0 - mx), e1 = exp2f(l1 - mx), e2 = exp2f(l2 - mx);
                const float a = ((g == 0) ? e0 : (g == 1) ? e1 : e2) / (e0 + e1 + e2);
                u32x4* pp = (u32x4*)(Og + (size_t)m * 1152) + c;
                u32x4 w = *pp;
                unsigned ww[4] = {w.x, w.y, w.z, w.w};
#pragma unroll
                for (int k = 0; k < 4; ++k) { const float f0 = __builtin_bit_cast(float, ww[k] << 16) * a, f1 = __builtin_bit_cast(float, ww[k] & 0xffff0000u) * a; ww[k] = cvt_pk_bf16(f0, f1); }
                w.x = ww[0]; w.y = ww[1]; w.z = ww[2]; w.w = ww[3];
                *pp = w;
            }
        }
    }
}

#define XB_TMO      128
#define XB_XCNT(j)  (256  + 64 * (j))
#define XB_XSUB(j)  (1280 + 64 * (j))
#define XB_XGEN(j)  (2304 + 64 * (j))
#define XB_TOP      3328
#define XB_TOPGEN   3392
#define XCD_BAR_WORDS 3456
#define XB_SPIN_CAP (1u << 18)

__device__ __forceinline__ unsigned xb_ld(unsigned* p)              { return __hip_atomic_load(p, __ATOMIC_RELAXED, __HIP_MEMORY_SCOPE_AGENT); }
__device__ __forceinline__ unsigned xb_add(unsigned* p, unsigned v) { return __hip_atomic_fetch_add(p, v, __ATOMIC_RELAXED, __HIP_MEMORY_SCOPE_AGENT); }
__device__ __forceinline__ unsigned xb_xcc_id() { return (unsigned)__builtin_amdgcn_s_getreg((3 << 11) | 20) & 0xFu; }
#define XB_SPIN(cond, bar) do { unsigned _sp = 0; while (cond) { __builtin_amdgcn_s_sleep(1); \
    if ((++_sp & 255u) == 0u) { if (xb_ld(&(bar)[XB_TMO])) break; if (_sp > XB_SPIN_CAP) { atomicAdd(&(bar)[XB_TMO], 1u); break; } } } } while (0)

struct XcdBarrier {
    unsigned* bar; unsigned x;
    volatile LAS unsigned* st;
};

__device__ __forceinline__ XcdBarrier xcd_barrier_post(unsigned* bar, volatile LAS unsigned* st) {
    XcdBarrier b; b.bar = bar; b.x = xb_xcc_id(); b.st = st;
    if (threadIdx.x == 0) (void)xb_add(&bar[XB_XCNT(b.x)], 1u);
    return b;
}
__device__ __forceinline__ void xcd_barrier_complete(unsigned* bar, unsigned x, unsigned& nloc, unsigned& nx) {
    const unsigned G = gridDim.x * gridDim.y * gridDim.z;
    unsigned sum, cnt, mine, sp = 0u;
    for (;;) {
        sum = 0u; cnt = 0u; mine = 0u;
#pragma unroll
        for (unsigned j = 0; j < 16; ++j) { const unsigned c = xb_ld(&bar[XB_XCNT(j)]); sum += c; cnt += (c > 0u) ? 1u : 0u; mine = (j == x) ? c : mine; }
        if (sum == G) break;
        __builtin_amdgcn_s_sleep(1);
        if ((++sp & 255u) == 0u) { if (xb_ld(&bar[XB_TMO])) break; if (sp > XB_SPIN_CAP) { atomicAdd(&bar[XB_TMO], 1u); break; } }
    }
    nloc = mine > 0u ? mine : 1u; nx = cnt > 0u ? cnt : 1u;
}

__device__ __forceinline__ void xcd_barrier(const XcdBarrier& b) {
    asm volatile("s_waitcnt vmcnt(0)" ::: "memory");
    __syncthreads();
    if (threadIdx.x == 0) {
        unsigned* bar = b.bar;
        __builtin_amdgcn_s_waitcnt(0);
        unsigned nloc = b.st[0], nx = b.st[1];
        if (nloc == 0u) { xcd_barrier_complete(bar, b.x, nloc, nx); b.st[0] = nloc; b.st[1] = nx; }
        const unsigned old = xb_add(&bar[XB_XSUB(b.x)], 1u);
        const unsigned gen = old / nloc;
        if (old + 1u == (gen + 1u) * nloc) {
            __builtin_amdgcn_fence(__ATOMIC_RELEASE, "agent");
            asm volatile("s_waitcnt vmcnt(0)" ::: "memory");
            const unsigned og = xb_add(&bar[XB_TOP], 1u);
            const unsigned tg = og / nx;
            if (og + 1u == (tg + 1u) * nx) xb_add(&bar[XB_TOPGEN], 1u);
            else XB_SPIN(xb_ld(&bar[XB_TOPGEN]) == tg, bar);
            __builtin_amdgcn_fence(__ATOMIC_ACQUIRE, "agent");
            xb_add(&bar[XB_XGEN(b.x)], 1u);
            asm volatile("s_waitcnt vmcnt(0)" ::: "memory");
        } else {
            XB_SPIN(xb_ld(&bar[XB_XGEN(b.x)]) == gen, bar);
            __builtin_amdgcn_fence(__ATOMIC_ACQUIRE, "agent");
            asm volatile("s_waitcnt vmcnt(0)" ::: "memory");
        }
    }
    __syncthreads();
}

__device__ __forceinline__ void fill_rstd(LAS unsigned char* lds, const pg8::StaticOrder& S, const float* ssp) {
    LAS float* rs = (LAS float*)(lds + LDS_RSTD);
    int tid = threadIdx.x; asm volatile("" : "+v"(tid));
    for (int i0 = 0; i0 < 8; i0 += 2) {
        pg8::Unit u; const int i = i0 + (tid >> 8);
        if (S.next(i, u)) rs[i * 256 + (tid & 255)] = __builtin_amdgcn_rsqf(row_ss(ssp, u.pm * 256 + (tid & 255)) * (1.0f / DM) + RMS_EPS);
    }
    __syncthreads();
}

__global__ void __launch_bounds__(512, 2) fwd_kernel(Params p) {
    extern __shared__ __attribute__((aligned(16))) unsigned char lds_raw[];
    LAS unsigned char* lds = (LAS unsigned char*)lds_raw;
    cg::grid_group grid = cg::this_grid();
    volatile LAS unsigned* xst = (volatile LAS unsigned*)(lds + LDS_BYTES - 64);
    if (threadIdx.x < 2) xst[threadIdx.x] = 0u;
    __syncthreads();
    XcdBarrier xbar = xcd_barrier_post((unsigned*)(p.ws + WS_BAR), xst);
    {
        LAS float* rope = (LAS float*)(lds + LDS_ROPE); LAS float* gl = (LAS float*)(lds + LDS_GAIN);
        for (int i = threadIdx.x; i < 1024; i += 512) { const int pos = i >> 4, f = i & 15; const float ang = (float)pos * exp2f(-(float)f * 0.83048202372184059f); rope[2 * i] = cosf(ang); rope[2 * i + 1] = sinf(ang); }
        if (threadIdx.x < 256) { const int i = threadIdx.x, ja = i >> 7, qk = (i >> 6) & 1, d = i & 63; gl[i] = (qk == 0 ? p.in[4] : p.in[5])[ja * 64 + d]; }
    }
#define GRID_SYNC() do { asm volatile("s_waitcnt vmcnt(0) lgkmcnt(0)" ::: "memory"); grid.sync(); asm volatile("buffer_inv sc1\n\ts_waitcnt vmcnt(0)" ::: "memory"); GRID_SYNC2(); } while (0)
#define XBAR_SYNC() do { xcd_barrier(xbar); asm volatile("buffer_inv sc1\n\ts_waitcnt vmcnt(0)" ::: "memory"); } while (0)
#ifdef PROBE_DUP_SYNC
#define GRID_SYNC2() do { grid.sync(); asm volatile("buffer_inv sc1\n\ts_waitcnt vmcnt(0)" ::: "memory"); } while (0)
#else
#define GRID_SYNC2() do { } while (0)
#endif
    const int wave = __builtin_amdgcn_readfirstlane((int)threadIdx.x >> 6);
#define LANE() ({ int l_ = (int)threadIdx.x & 63; asm volatile("" : "+v"(l_)); l_; })
    const int G = gridDim.x, gw = blockIdx.x * 8 + wave, NGW = G * 8;
    unsigned char* ws = p.ws;
#define GAS __attribute__((address_space(1)))
#define WSP() ({ GAS unsigned char* q_ = (GAS unsigned char*)ws; asm volatile("" : "+s"(q_)); (unsigned char*)q_; })
#define SSP(i) ((float*)(WSP() + WS_SSP) + (size_t)(i) * MTOK * 16)
#define LSE_ ((float*)(WSP() + WS_LSE))
#define WB_ ((bf16_t*)(WSP() + WS_W))
#define HB_ ((bf16_t*)(WSP() + WS_HB))
#define U_ ((bf16_t*)(WSP() + WS_U))
#define Qb_ ((bf16_t*)(WSP() + WS_Q))
#define Kb_ ((bf16_t*)(WSP() + WS_K))
#define Vb_ ((bf16_t*)(WSP() + WS_VT))
#define Ob_ ((bf16_t*)(WSP() + WS_O))
    float* h = p.out;

#ifndef PHMASK
#define PHMASK 0xffff
#endif
    if (PHMASK & 1) prologue(p, lds, gw, NGW, wave, LANE());
#ifdef PROBE_DUP_PRO
    __syncthreads(); prologue(p, lds, gw, NGW, wave, LANE());
#endif
    GRID_SYNC();

#pragma unroll 1
    for (int layer = 0; layer < 4; ++layer) {
        const int kind = (layer == 3) ? 0 : layer;
        const int ja = (layer == 3) ? 1 : 0;
        const size_t weq = (layer == 0) ? WE_QKV0 : (layer == 1) ? WE_QKV1 : (layer == 2) ? WE_QKV2 : WE_QKV3;
        const size_t weo = (layer == 0) ? WE_WO0 : (layer == 1) ? WE_WO1 : (layer == 2) ? WE_WO2 : WE_WO3;
        if (kind == 0 && (PHMASK & 2)) {
            pg8::Gemm g{HB_, WB_ + weq, MTOK, 1536, DM}; pg8::StaticOrder S; S.init(MTOK, 1536, G, (int)blockIdx.x);
            fill_rstd(lds, S, SSP(2 * layer));
            pg8::EpiQKV<0> E{WSP(), lds, ja, 0};
            pg8::gemm_phase<pg8::EpiQKV<0>, pg8::StaticOrder, true, true>(lds, g, S, E);
        } else if (kind == 1 && (PHMASK & 4)) {
            pg8::Gemm g{HB_, WB_ + weq, MTOK, 2048, DM}; pg8::StaticOrder S; S.init(MTOK, 2048, G, (int)blockIdx.x);
            fill_rstd(lds, S, SSP(2 * layer));
            pg8::EpiQKV<1> E{WSP(), lds, 0, 0};
            pg8::gemm_phase<pg8::EpiQKV<1>, pg8::StaticOrder, true, true>(lds, g, S, E);
        } else if (kind == 2 && (PHMASK & 8)) {
            pg8::Gemm g{HB_, WB_ + weq, MTOK, 1536, DM}; pg8::StaticOrder S; S.init(MTOK, 1536, G, (int)blockIdx.x);
            fill_rstd(lds, S, SSP(2 * layer));
            pg8::EpiQKV<2> E{WSP(), lds, 0, 0};
            pg8::gemm_phase<pg8::EpiQKV<2>, pg8::StaticOrder, true, true>(lds, g, S, E);
        }
        XBAR_SYNC();
        if (kind == 0) {
            const LAS float* gl = (const LAS float*)(lds + LDS_GAIN) + ja * 128;
            int lane3 = threadIdx.x & 63; asm volatile("" : "+v"(lane3));
            float gq = fabsf(gl[lane3]), gk = fabsf(gl[64 + lane3]);
#pragma unroll
            for (int o = 1; o < 64; o <<= 1) { gq = fmaxf(gq, __shfl_xor(gq, o)); gk = fmaxf(gk, __shfl_xor(gk, o)); }
            const bool fastp = __builtin_amdgcn_readfirstlane((QSCALE * 64.0f * gq * gk <= 60.0f) ? 1 : 0) != 0;
            if (fastp) { if (PHMASK & 16) attn_dense_fast(lds, Qb_, Kb_, Vb_, Ob_); }
            else if (PHMASK & 16) attn_phase<0>(lds, Qb_, Kb_, Vb_, Ob_, LSE_, nullptr);
#ifdef PROBE_DUP_A
            __syncthreads(); attn_phase<0>(lds, Qb_, Kb_, Vb_, Ob_, LSE_, nullptr);
#endif
        }
        else if (kind == 1) { if (PHMASK & 32) attn_phase<1>(lds, Qb_, Kb_, Vb_, Ob_, LSE_, nullptr);
#ifdef PROBE_DUP_BC
            __syncthreads(); attn_phase<1>(lds, Qb_, Kb_, Vb_, Ob_, LSE_, nullptr);
#endif
            XBAR_SYNC(); mixb_fix(Ob_, LSE_, gw, NGW, LANE()); }
        else { if (PHMASK & 64) attn_phase<2>(lds, Qb_, Kb_, Vb_, Ob_, LSE_, p.in[10]);
#ifdef PROBE_DUP_BC
            __syncthreads(); attn_phase<2>(lds, Qb_, Kb_, Vb_, Ob_, LSE_, p.in[10]);
#endif
        }
        XBAR_SYNC();
        if (PHMASK & 128) {
            const int Ko = (kind == 1) ? 1152 : 1024;
            pg8::Gemm g{Ob_, WB_ + weo, MTOK, DM, Ko}; pg8::StaticOrder S; S.init(MTOK, DM, G, (int)blockIdx.x);
            pg8::EpiRes E{(layer == 0) ? p.in[0] : (const float*)h, h, HB_, SSP(2 * layer + 1)};
            pg8::gemm_phase<pg8::EpiRes, pg8::StaticOrder, true, true>(lds, g, S, E);
        }
        XBAR_SYNC();
        if (PHMASK & 256) {
            pg8::Gemm g{HB_, WB_ + WE_W1 + (size_t)layer * 4096 * 1024, MTOK, DFF, DM}; pg8::StaticOrder S; S.init(MTOK, DFF, G, (int)blockIdx.x);
            fill_rstd(lds, S, SSP(2 * layer + 1));
            pg8::EpiMlp1 E{lds, U_, 0};
            pg8::gemm_phase<pg8::EpiMlp1, pg8::StaticOrder, true, true>(lds, g, S, E);
#ifdef PROBE_DUP_MLP1
            __syncthreads(); pg8::gemm_phase<pg8::EpiMlp1, pg8::StaticOrder, true, true>(lds, g, S, E);
#endif
        }
        XBAR_SYNC();
        if (PHMASK & 512) {
            pg8::Gemm g{U_, WB_ + WE_W2 + (size_t)layer * 4096 * 1024, MTOK, DM, DFF}; pg8::StaticOrder S; S.init(MTOK, DM, G, (int)blockIdx.x);
            pg8::EpiRes E{h, h, HB_, SSP(2 * layer + 2)};
            pg8::gemm_phase<pg8::EpiRes, pg8::StaticOrder, true, true>(lds, g, S, E);
        }
        XBAR_SYNC();
    }
    {
        const float* fg = p.in[14]; const float* ss8 = SSP(8);
        const int lane2 = LANE();
        for (int m = gw; m < MTOK; m += NGW) {
            const float rstd = __builtin_amdgcn_rsqf(row_ss(ss8, m) * (1.0f / DM) + RMS_EPS);
            f32x4* hr = (f32x4*)(h + (size_t)m * DM) + lane2;
#pragma unroll
            for (int j = 0; j < 4; ++j) { const f32x4 gg = ((const f32x4*)fg)[64 * j + lane2]; f32x4 v = hr[64 * j]; v = v * rstd * gg; hr[64 * j] = v; }
        }
    }
}

extern "C" void kernel_launch(void* const* d_in, const int* in_sizes, int n_in, void* d_out, int out_size, void* d_ws, size_t ws_size, hipStream_t stream) {
    static int grid = 0;
    if (grid == 0) {
        if (n_in != 15 || out_size != MTOK * DM || ws_size < WS_END) { fprintf(stderr, "kernel_launch: unexpected shapes (n_in %d out %d ws %zu)\n", n_in, out_size, ws_size); grid = -1; return; }
        int dev = 0, cus = 0, per_cu = 0;
        hipGetDevice(&dev);
        hipDeviceGetAttribute(&cus, hipDeviceAttributeMultiprocessorCount, dev);
        if (hipFuncSetAttribute((const void*)fwd_kernel, hipFuncAttributeMaxDynamicSharedMemorySize, LDS_BYTES) != hipSuccess) { fprintf(stderr, "kernel_launch: hipFuncSetAttribute failed\n"); grid = -1; return; }
        if (hipOccupancyMaxActiveBlocksPerMultiprocessor(&per_cu, (const void*)fwd_kernel, 512, LDS_BYTES) != hipSuccess || per_cu < 1) { fprintf(stderr, "kernel_launch: occupancy query gave %d\n", per_cu); per_cu = 1; }
        (void)hipGetLastError();
        grid = cus * per_cu;
    }
    if (grid < 0) return;
    if (hipMemsetAsync((char*)d_ws + WS_BAR, 0, 16384, stream) != hipSuccess) { fprintf(stderr, "kernel_launch: hipMemsetAsync failed\n"); return; }
    Params p{};
    for (int i = 0; i < 15; ++i) p.in[i] = (const float*)d_in[i];
    p.out = (float*)d_out; p.ws = (unsigned char*)d_ws;
    void* args[] = {&p};
    hipError_t e = hipLaunchCooperativeKernel((const void*)fwd_kernel, dim3(grid), dim3(512), args, LDS_BYTES, stream);
    if (e != hipSuccess) fprintf(stderr, "cooperative launch failed: %s (grid %d)\n", hipGetErrorString(e), grid);
}
```

```cpp
#include <hip/hip_runtime.h>
#include <hip/hip_cooperative_groups.h>
#include <cstdio>
#include <cstdint>
namespace cg = cooperative_groups;

namespace pg8 {
#define PG8_LAS __attribute__((address_space(3)))
typedef unsigned short bf16_t;
typedef short bf16x8 __attribute__((ext_vector_type(8)));
typedef float f32x4 __attribute__((ext_vector_type(4)));
typedef unsigned u32x4 __attribute__((ext_vector_type(4)));
constexpr int BM = 256, BK = 64, HALF = 128, HTB = HALF * BK * 2  , STAGE_BYTES = 8 * HTB, NXCD = 8, WGM = 8;

__host__ __device__ __forceinline__ int lds_byte(int r, int c) { const int st = (r >> 4) * 2 + (c >> 5), rr = r & 15, cc = c & 31, ob = rr * 64 + cc * 2; return st * 1024 + (ob ^ (((ob >> 9) & 1) << 5)); }
__host__ __device__ __forceinline__ void stage_rc(int b, int& R, int& C) { const int st = b / 1024, sb = b % 1024, swz = sb ^ (((sb >> 9) & 1) << 5); R = (st >> 1) * 16 + swz / 64; C = (st & 1) * 32 + (swz % 64) / 2; }
__host__ __device__ __forceinline__ int perm32(int rho) { const int n = rho >> 4, i = rho & 15; return 8 * (i >> 2) + 4 * n + (i & 3); }

struct Unit { int pm, pn; };
struct Gemm { const bf16_t* A; const bf16_t* Bt; int M, N, K; };

struct StaticOrder {
    int nM, nN, nwg, G, c;
    __host__ __device__ void init(int M, int N, int G_, int c_) { nM = M / BM; nN = N / BM; nwg = nM * nN; G = G_; c = c_; }
    __host__ __device__ bool next(int i, Unit& u) const {
        const long L = (long)i * G + c; if (L >= nwg) return false;
        int wgid = (int)L; { const int q = nwg / NXCD, r = nwg % NXCD, xcd = wgid % NXCD, off = wgid / NXCD; wgid = (xcd < r ? xcd * (q + 1) : r * (q + 1) + (xcd - r) * q) + off; }
        const int nig = WGM * nN, gid = wgid / nig, fm = gid * WGM, gsz = (nM - fm) < WGM ? (nM - fm) : WGM;
        u.pm = fm + ((wgid % nig) % gsz); u.pn = (wgid % nig) / gsz; return true;
    }
    __device__ __forceinline__ void a_ready(const Unit&) const {}
    __device__ __forceinline__ void done(const Unit&) const {}
};

__device__ __forceinline__ unsigned cvt_pk_bf16(float lo, float hi) { unsigned r; asm volatile("v_cvt_pk_bf16_f32 %0, %1, %2" : "=v"(r) : "v"(lo), "v"(hi)); return r; }
constexpr int SEQ = 4096, NBATCH = 8, MTOK = NBATCH * SEQ, DM = 1024, DFF = 4096;
constexpr float RMS_EPS = 1e-6f;
constexpr float LOG2E = 1.4426950408889634f;
constexpr float QSCALE = 0.125f * LOG2E;
constexpr float NEG_BIG = -1.0e30f;

constexpr size_t MiB = 1u << 20;
constexpr size_t WS_SS = 0;
constexpr size_t WS_TAB = 6 * MiB;
constexpr size_t WS_BAR = 7 * MiB;
constexpr size_t WS_LSE = 2 * MiB;
constexpr size_t WS_W = 8 * MiB;
constexpr size_t WS_HB = 96 * MiB;
constexpr size_t WS_U = 160 * MiB;
constexpr size_t WS_Q = 160 * MiB, WS_K = 232 * MiB, WS_VT = 256 * MiB, WS_O = 280 * MiB;
constexpr size_t WS_SSP = 420 * MiB;
constexpr size_t WS_END = 440 * MiB;

constexpr int LDS_RSTD = 131072;
constexpr int LDS_ROPE = 139264;
constexpr int LDS_GAIN = 147456;
constexpr int LDS_BYTES = 163840;
__device__ __forceinline__ float row_ss(const float* ssp, int row) {
    const f32x4* q = (const f32x4*)(ssp + (size_t)row * 16);
    const f32x4 a = q[0], b = q[1], c = q[2], d = q[3];
    return ((a[0] + a[1]) + (a[2] + a[3])) + ((b[0] + b[1]) + (b[2] + b[3])) + (((c[0] + c[1]) + (c[2] + c[3])) + ((d[0] + d[1]) + (d[2] + d[3])));
}
__device__ __forceinline__ int perm_key(int i) { return (i & ~12) | ((i & 4) << 1) | ((i & 8) >> 1); }

template <int KIND> struct EpiQKV {
    static constexpr bool PERM = true, AFTER_DRAIN = false;
    unsigned char* ws; PG8_LAS unsigned char* lds; int ja; mutable int cnt;
    __device__ __forceinline__ void operator()(const f32x4 (&acc)[2][2][4][2], const Unit& u, int wr, int wc, int fr, int fq) const {
        asm volatile("" : "+v"(fr), "+v"(fq));
        asm volatile("" : "+s"(wr), "+s"(wc));
        constexpr int NQH = (KIND == 1) ? 18 : 16, NKH = (KIND == 1) ? 6 : 4;
        const int hcol = 4 * u.pn + wc;
        int type, hh;
        if (hcol < NQH) { type = 0; hh = hcol; } else if (hcol < NQH + NKH) { type = 1; hh = hcol - NQH; } else if (hcol < NQH + 2 * NKH) { type = 2; hh = hcol - NQH - NKH; } else { ++cnt; return; }
        const PG8_LAS float* ss = (const PG8_LAS float*)(lds + LDS_RSTD) + 256 * cnt;
        ++cnt;
        const PG8_LAS f32x4* rope = (const PG8_LAS f32x4*)(lds + LDS_ROPE);
        float gn[2][8];
        if (KIND == 0) {
            const PG8_LAS float* gsrc = (const PG8_LAS float*)(lds + LDS_GAIN) + ja * 128 + ((type == 0) ? 0 : 64);
            if (type < 2) {
#pragma unroll
                for (int bj = 0; bj < 2; ++bj)
#pragma unroll
                    for (int n = 0; n < 2; ++n)
#pragma unroll
                        for (int j = 0; j < 4; ++j) gn[bj][n * 4 + j] = gsrc[32 * bj + 16 * n + 4 * fq + j];
            }
        }
        int hin = hh, g = 0;
        if (KIND == 1) { if (type == 0) { g = hh / 6; hin = hh - 6 * g; } else { g = hh >> 1; hin = hh & 1; } }
        if (KIND == 1 && g == 1) body<2>(acc, u, wr, wc, fr, fq, type, hin, g, ss, rope, gn);
        else if (KIND == 1 && g == 2) body<4>(acc, u, wr, wc, fr, fq, type, hin, g, ss, rope, gn);
        else body<0>(acc, u, wr, wc, fr, fq, type, hin, g, ss, rope, gn);
    }
    template <int gsh> __device__ __forceinline__ void body(const f32x4 (&acc)[2][2][4][2], const Unit& u, int wr, int wc, int fr, int fq, int type, int hin, int g, const PG8_LAS float* ss, const PG8_LAS f32x4* rope, const float (&gn)[2][8]) const {
#pragma unroll
        for (int ai = 0; ai < 2; ++ai)
#pragma unroll
            for (int m = 0; m < 4; ++m) {
                int frl = fr; asm volatile("" : "+v"(frl));
                const int row = u.pm * BM + ai * HALF + wr * 64 + m * 16 + frl;
                const int b = row >> 12, t = row & (SEQ - 1);
                const float rstd = ss[ai * HALF + wr * 64 + m * 16 + frl];
                float v[2][8];
#pragma unroll
                for (int bj = 0; bj < 2; ++bj)
#pragma unroll
                    for (int n = 0; n < 2; ++n)
#pragma unroll
                        for (int j = 0; j < 4; ++j) v[bj][n * 4 + j] = acc[ai][bj][m][n][j] * rstd;
                if (KIND == 0 && type < 2) {
                    float s2 = 0.f;
#pragma unroll
                    for (int bj = 0; bj < 2; ++bj)
#pragma unroll
                        for (int e = 0; e < 8; ++e) s2 += v[bj][e] * v[bj][e];
                    s2 += __shfl_xor(s2, 16); s2 += __shfl_xor(s2, 32);
                    const float r = __builtin_amdgcn_rsqf(s2 * (1.0f / 64.0f) + RMS_EPS);
#pragma unroll
                    for (int bj = 0; bj < 2; ++bj)
#pragma unroll
                        for (int e = 0; e < 8; ++e) v[bj][e] *= r * gn[bj][e];
#pragma unroll
                    for (int bj = 0; bj < 2; ++bj) {
                        const int pos = (bj == 0) ? (t >> 6) : (t & 63);
                        const f32x4 cs0 = rope[(pos * 16 + 4 * fq) >> 1], cs1 = rope[((pos * 16 + 4 * fq) >> 1) + 1];
                        const float cc[4] = {cs0[0], cs0[2], cs1[0], cs1[2]}, sn[4] = {cs0[1], cs0[3], cs1[1], cs1[3]};
#pragma unroll
                        for (int j = 0; j < 4; ++j) {
                            const float x1 = v[bj][j], x2 = v[bj][4 + j];
                            v[bj][j] = x1 * cc[j] - x2 * sn[j]; v[bj][4 + j] = x2 * cc[j] + x1 * sn[j];
                        }
                    }
                }
                if (type == 0) {
#pragma unroll
                    for (int bj = 0; bj < 2; ++bj)
#pragma unroll
                        for (int e = 0; e < 8; ++e) v[bj][e] *= QSCALE;
                }
                const int dmask = (1 << gsh) - 1;
                const int vb = (b << gsh) + (t & dmask), idx = t >> gsh, lsh = 12 - gsh;
                if (type < 2) {
                    const int nh = (type == 0) ? ((KIND == 1) ? 6 : 16) : ((KIND == 1) ? 2 : 4);
                    unsigned char* base = ws + ((type == 0) ? WS_Q : WS_K) + ((KIND == 1) ? (size_t)g * ((size_t)NBATCH * nh * SEQ * 128) : 0);
                    const unsigned off = ((unsigned)(((vb * nh + hin) << lsh) + idx) * 64u + 8u * fq) * 2u;
#pragma unroll
                    for (int bj = 0; bj < 2; ++bj) {
                        u32x4 w; w.x = cvt_pk_bf16(v[bj][0], v[bj][1]); w.y = cvt_pk_bf16(v[bj][2], v[bj][3]); w.z = cvt_pk_bf16(v[bj][4], v[bj][5]); w.w = cvt_pk_bf16(v[bj][6], v[bj][7]);
                        *(u32x4*)(base + off + 64 * bj) = w;
                    }
                } else {
                    const int nh = (KIND == 1) ? 2 : 4;
                    unsigned char* base = ws + WS_VT + ((KIND == 1) ? (size_t)g * ((size_t)NBATCH * nh * SEQ * 128) : 0);
                    unsigned off = ((unsigned)((((vb * nh + hin) * 64 + 8 * fq) << lsh) + perm_key(idx))) * 2u;
                    const unsigned dstep = 2u << lsh;
#pragma unroll
                    for (int bj = 0; bj < 2; ++bj) {
#pragma unroll
                        for (int e = 0; e < 8; ++e) {
                            const unsigned pk = cvt_pk_bf16(v[bj][e], 0.f);
                            *(bf16_t*)(base + off) = (bf16_t)(pk & 0xffffu);
                            off += dstep;
                        }
                        off += 24u * dstep;
                    }
                }
                __builtin_amdgcn_sched_barrier(0);
            }
    }
};

struct EpiRes {
    static constexpr bool PERM = true, AFTER_DRAIN = false;
    bf16_t* hb; float* ssout;
    __device__ __forceinline__ void operator()(const f32x4 (&acc)[2][2][4][2], const Unit& u, int wr, int wc, int fr, int fq) const {
        asm volatile("" : "+v"(fr), "+v"(fq));
        const unsigned o0 = (unsigned)((u.pm * BM + wr * 64 + fr) * DM + u.pn * BM + wc * 32 + 8 * fq);
        u32x4 hv[2][2];
#pragma unroll
        for (int bj = 0; bj < 2; ++bj) hv[0][bj] = *(const u32x4*)((const char*)hb + (o0 + bj * HALF) * 2u);
#pragma unroll
        for (int it = 0; it < 8; ++it) {
            const int ai = it >> 2, m = it & 3, cur = it & 1, nxt = cur ^ 1;
            if (it + 1 < 8) {
                const int ai2 = (it + 1) >> 2, m2 = (it + 1) & 3;
                const unsigned o2 = o0 + (unsigned)((ai2 * HALF + m2 * 16) * DM);
#pragma unroll
                for (int bj = 0; bj < 2; ++bj) hv[nxt][bj] = *(const u32x4*)((const char*)hb + (o2 + bj * HALF) * 2u);
            }
            const unsigned o1 = o0 + (unsigned)((ai * HALF + m * 16) * DM);
            float q = 0.f;
#pragma unroll
            for (int bj = 0; bj < 2; ++bj) {
                const unsigned o = o1 + bj * HALF;
                const u32x4 hw = hv[cur][bj];
                f32x4 v0, v1;
                v0[0] = __builtin_bit_cast(float, hw.x << 16); v0[1] = __builtin_bit_cast(float, hw.x & 0xffff0000u); v0[2] = __builtin_bit_cast(float, hw.y << 16); v0[3] = __builtin_bit_cast(float, hw.y & 0xffff0000u);
                v1[0] = __builtin_bit_cast(float, hw.z << 16); v1[1] = __builtin_bit_cast(float, hw.z & 0xffff0000u); v1[2] = __builtin_bit_cast(float, hw.w << 16); v1[3] = __builtin_bit_cast(float, hw.w & 0xffff0000u);
                v0 = v0 + acc[ai][bj][m][0]; v1 = v1 + acc[ai][bj][m][1];
                u32x4 w; w.x = cvt_pk_bf16(v0[0], v0[1]); w.y = cvt_pk_bf16(v0[2], v0[3]); w.z = cvt_pk_bf16(v1[0], v1[1]); w.w = cvt_pk_bf16(v1[2], v1[3]);
                *(u32x4*)((char*)hb + o * 2u) = w;
                q += (v0[0] * v0[0] + v0[1] * v0[1]) + (v0[2] * v0[2] + v0[3] * v0[3]) + (v1[0] * v1[0] + v1[1] * v1[1]) + (v1[2] * v1[2] + v1[3] * v1[3]);
            }
            q += __shfl_xor(q, 16); q += __shfl_xor(q, 32);
            const int row = u.pm * BM + ai * HALF + wr * 64 + m * 16 + fr;
            if (fq == 0) ssout[(size_t)row * 16 + u.pn * 4 + wc] = q;
        }
    }
};

struct EpiMlp1 {
    static constexpr bool PERM = true, AFTER_DRAIN = false;
    PG8_LAS unsigned char* lds; bf16_t* U; mutable int cnt;
    __device__ __forceinline__ void operator()(const f32x4 (&acc)[2][2][4][2], const Unit& u, int wr, int wc, int fr, int fq) const {
        const PG8_LAS float* ss = (const PG8_LAS float*)(lds + LDS_RSTD) + 256 * cnt;
        ++cnt;
#pragma unroll
        for (int ai = 0; ai < 2; ++ai)
#pragma unroll
            for (int m = 0; m < 4; ++m) {
                const int row = u.pm * BM + ai * HALF + wr * 64 + m * 16 + fr;
                const float rstd = ss[ai * HALF + wr * 64 + m * 16 + fr];
#pragma unroll
                for (int bj = 0; bj < 2; ++bj) {
                    f32x4 v0 = acc[ai][bj][m][0] * rstd, v1 = acc[ai][bj][m][1] * rstd;
#pragma unroll
                    for (int j = 0; j < 4; ++j) { const float a = fmaxf(v0[j], 0.f), c = fmaxf(v1[j], 0.f); v0[j] = a * a; v1[j] = c * c; }
                    u32x4 w; w.x = cvt_pk_bf16(v0[0], v0[1]); w.y = cvt_pk_bf16(v0[2], v0[3]); w.z = cvt_pk_bf16(v1[0], v1[1]); w.w = cvt_pk_bf16(v1[2], v1[3]);
                    *(u32x4*)((char*)U + (unsigned)(row * DFF + u.pn * BM + bj * HALF + wc * 32 + 8 * fq) * 2u) = w;
                }
            }
    }
};
template <class Epi, class Sched, bool ALIGN_EPI = false, bool SP2 = false>
__device__ __forceinline__ void gemm_phase(PG8_LAS unsigned char* lds, const Gemm g, const Sched& S, const Epi& E) {
    int tid_ = threadIdx.x; asm volatile("" : "+v"(tid_));
    const int tid = tid_, wid = __builtin_amdgcn_readfirstlane(tid >> 6), lane = tid & 63, wr = wid >> 2, wc = wid & 3, fr = lane & 15, fq = lane >> 4;
    const int K = g.K, nt = K / BK;
    unsigned voffA[2], voffB[2];
#pragma unroll
    for (int i = 0; i < 2; ++i) { int R, C; stage_rc(tid * 16 + i * 8192, R, C); const int Rb = Epi::PERM ? ((R & ~31) + perm32(R & 31)) : R;
        voffA[i] = (unsigned)(R * K + C) * 2u; voffB[i] = (unsigned)(Rb * K + C) * 2u; }
    const size_t kstep = (size_t)(BK * 2);
    const size_t hstep = (size_t)HALF * K * 2;
    const size_t tstep = 2 * hstep;
    const unsigned ldsw = (unsigned)wid * 1024u;
    const int aoff = lds_byte(wr * 64 + fr, fq * 8), boff = lds_byte(wc * 32 + fr, fq * 8);
#define PG8_SA(b, h) (((b) * 2 + (h)) * HTB)
#define PG8_SB(b, h) ((4 + (b) * 2 + (h)) * HTB)
#define PG8_STAGE(bufoff, gbase, voff) do { _Pragma("unroll") for (int _i = 0; _i < 2; ++_i) \
        __builtin_amdgcn_global_load_lds((const unsigned*)((const char*)(gbase) + (voff)[_i]), (PG8_LAS unsigned*)(lds + (bufoff) + ldsw + _i * 8192), 16, 0, 0); } while (0)
#define PG8_LDA(dst, b, h) do { _Pragma("unroll") for (int m = 0; m < 4; ++m) _Pragma("unroll") for (int k = 0; k < 2; ++k) dst[m][k] = *(const PG8_LAS bf16x8*)(lds + PG8_SA(b, h) + aoff + m * 2048 + k * 1024); } while (0)
#define PG8_LDB(dst, b, h) do { _Pragma("unroll") for (int n = 0; n < 2; ++n) _Pragma("unroll") for (int k = 0; k < 2; ++k) dst[n][k] = *(const PG8_LAS bf16x8*)(lds + PG8_SB(b, h) + boff + n * 2048 + k * 1024); } while (0)
#define PG8_MMA(ai, bj, At, Bt) do { __builtin_amdgcn_s_setprio(1); _Pragma("unroll") for (int m = 0; m < 4; ++m) _Pragma("unroll") for (int n = 0; n < 2; ++n) _Pragma("unroll") for (int k = 0; k < 2; ++k) \
        acc[ai][bj][m][n] = __builtin_amdgcn_mfma_f32_16x16x32_bf16(Bt[n][k], At[m][k], acc[ai][bj][m][n], 0, 0, 0); __builtin_amdgcn_s_setprio(0); } while (0)
#define PG8_WAIT_V(n) asm volatile("s_waitcnt vmcnt(" #n ")" ::: "memory")
#define PG8_WAIT_L(n) asm volatile("s_waitcnt lgkmcnt(" #n ")" ::: "memory")
#define PG8_BAR __builtin_amdgcn_s_barrier()
#define PG8_SCHED __builtin_amdgcn_sched_barrier(0)
    Unit cur, nxt; int ui = 0;
    if (!S.next(0, cur)) return;
    f32x4 acc[2][2][4][2];
#pragma unroll
    for (int a = 0; a < 2; ++a)
#pragma unroll
        for (int b = 0; b < 2; ++b)
#pragma unroll
            for (int m = 0; m < 4; ++m)
#pragma unroll
                for (int n = 0; n < 2; ++n) acc[a][b][m][n] = (f32x4){0.f, 0.f, 0.f, 0.f};
    bf16x8 At[4][2], B0[2][2], B1[2][2];
    const char* cA = (const char*)g.A + (size_t)cur.pm * tstep; const char* cB = (const char*)g.Bt + (size_t)cur.pn * tstep;
    S.a_ready(cur);
    if constexpr (SP2) {
        PG8_STAGE(PG8_SB(0, 0), cB, voffB); PG8_STAGE(PG8_SB(0, 1), cB + hstep, voffB); PG8_STAGE(PG8_SA(0, 0), cA, voffA); PG8_STAGE(PG8_SA(0, 1), cA + hstep, voffA);
        if (wr == 1) PG8_BAR;
        PG8_WAIT_V(2); PG8_BAR;
        PG8_STAGE(PG8_SB(1, 0), cB + kstep, voffB); PG8_STAGE(PG8_SA(1, 0), cA + kstep, voffA); PG8_STAGE(PG8_SB(1, 1), cB + hstep + kstep, voffB);
        PG8_WAIT_V(6); PG8_BAR;
    } else {
        PG8_STAGE(PG8_SB(0, 0), cB, voffB); PG8_STAGE(PG8_SA(0, 0), cA, voffA); PG8_STAGE(PG8_SB(0, 1), cB + hstep, voffB); PG8_STAGE(PG8_SA(0, 1), cA + hstep, voffA);
        if (wr == 1) PG8_BAR;
        PG8_WAIT_V(4); PG8_BAR;
        PG8_STAGE(PG8_SB(1, 0), cB + kstep, voffB); PG8_STAGE(PG8_SA(1, 0), cA + kstep, voffA); PG8_STAGE(PG8_SB(1, 1), cB + hstep + kstep, voffB);
        PG8_WAIT_V(6); PG8_BAR;
    }
    for (;;) {
        const bool has_next = S.next(ui + 1, nxt);
        const char* nA = has_next ? (const char*)g.A + (size_t)nxt.pm * tstep : cA; const char* nB = has_next ? (const char*)g.Bt + (size_t)nxt.pn * tstep : cB;
        for (int t = 0; t < nt; t += 2) {
            const bool last = (t == nt - 2);
            const char* a1 = cA + (size_t)(t + 1) * kstep;
            const char* a2 = last ? nA : cA + (size_t)(t + 2) * kstep; const char* b2 = last ? nB : cB + (size_t)(t + 2) * kstep;
            const char* a3 = a2 + kstep; const char* b3 = b2 + kstep;
            if (last && has_next) S.a_ready(nxt);
            if constexpr (SP2) {
            PG8_LDB(B0, 0, 0); PG8_LDB(B1, 0, 1); PG8_SCHED; PG8_LDA(At, 0, 0); PG8_STAGE(PG8_SA(1, 1), a1 + hstep, voffA);
            PG8_WAIT_V(8); PG8_WAIT_L(0); PG8_BAR; PG8_MMA(0, 0, At, B0); PG8_MMA(0, 1, At, B1); PG8_BAR; PG8_SCHED;
            PG8_LDA(At, 0, 1); PG8_STAGE(PG8_SB(0, 0), b2, voffB); PG8_STAGE(PG8_SB(0, 1), b2 + hstep, voffB); PG8_STAGE(PG8_SA(0, 0), a2, voffA);
            PG8_WAIT_V(8); PG8_WAIT_L(0); PG8_BAR; PG8_MMA(1, 0, At, B0); PG8_MMA(1, 1, At, B1); PG8_BAR; PG8_SCHED;
            PG8_LDB(B0, 1, 0); PG8_LDB(B1, 1, 1); PG8_SCHED; PG8_LDA(At, 1, 0); PG8_STAGE(PG8_SA(0, 1), a2 + hstep, voffA);
            PG8_WAIT_V(8); PG8_WAIT_L(0); PG8_BAR; PG8_MMA(0, 0, At, B0); PG8_MMA(0, 1, At, B1); PG8_BAR; PG8_SCHED;
            PG8_LDA(At, 1, 1); PG8_STAGE(PG8_SB(1, 0), b3, voffB); PG8_STAGE(PG8_SB(1, 1), b3 + hstep, voffB); PG8_STAGE(PG8_SA(1, 0), a3, voffA);
            PG8_WAIT_V(8); PG8_WAIT_L(0); PG8_BAR; PG8_MMA(1, 0, At, B0); PG8_MMA(1, 1, At, B1); PG8_BAR; PG8_SCHED;
            } else {
            PG8_LDB(B0, 0, 0); PG8_SCHED; PG8_LDA(At, 0, 0); PG8_STAGE(PG8_SA(1, 1), a1 + hstep, voffA);
            PG8_WAIT_L(8); PG8_BAR; PG8_WAIT_L(0); PG8_MMA(0, 0, At, B0); PG8_BAR; PG8_SCHED;
            PG8_LDB(B1, 0, 1); PG8_STAGE(PG8_SB(0, 0), b2, voffB);
            PG8_BAR; PG8_WAIT_L(0); PG8_MMA(0, 1, At, B1); PG8_BAR;
            PG8_LDA(At, 0, 1); PG8_STAGE(PG8_SA(0, 0), a2, voffA);
            PG8_BAR; PG8_WAIT_L(0); PG8_MMA(1, 0, At, B0); PG8_BAR; PG8_SCHED;
            PG8_STAGE(PG8_SB(0, 1), b2 + hstep, voffB);
            PG8_WAIT_V(6); PG8_BAR; PG8_MMA(1, 1, At, B1); PG8_BAR;
            PG8_LDB(B0, 1, 0); PG8_SCHED; PG8_LDA(At, 1, 0); PG8_STAGE(PG8_SA(0, 1), a2 + hstep, voffA);
            PG8_WAIT_L(8); PG8_BAR; PG8_WAIT_L(0); PG8_MMA(0, 0, At, B0); PG8_BAR; PG8_SCHED;
            PG8_LDB(B1, 1, 1); PG8_STAGE(PG8_SB(1, 0), b3, voffB);
            PG8_BAR; PG8_WAIT_L(0); PG8_MMA(0, 1, At, B1); PG8_BAR;
            PG8_LDA(At, 1, 1); PG8_STAGE(PG8_SA(1, 0), a3, voffA);
            PG8_BAR; PG8_WAIT_L(0); PG8_MMA(1, 0, At, B0); PG8_BAR; PG8_SCHED;
            PG8_STAGE(PG8_SB(1, 1), b3 + hstep, voffB);
            PG8_WAIT_V(6); PG8_BAR; PG8_MMA(1, 1, At, B1); PG8_BAR;
            }
        }
        if constexpr (ALIGN_EPI) { if (wr == 0) PG8_BAR; }
        if constexpr (!Epi::AFTER_DRAIN) { E(acc, cur, wr, wc, fr, fq); S.done(cur); }
        if (!has_next) break;
#pragma unroll
        for (int a = 0; a < 2; ++a)
#pragma unroll
            for (int b = 0; b < 2; ++b)
#pragma unroll
                for (int m = 0; m < 4; ++m)
#pragma unroll
                    for (int n = 0; n < 2; ++n) acc[a][b][m][n] = (f32x4){0.f, 0.f, 0.f, 0.f};
        cur = nxt; cA = nA; cB = nB; ++ui;
        if constexpr (ALIGN_EPI) { if (wr == 1) PG8_BAR; }
    }
    PG8_WAIT_V(0);
    if constexpr (!ALIGN_EPI) { if (wr == 0) PG8_BAR; }
    PG8_BAR;
    if constexpr (Epi::AFTER_DRAIN) { E.fused(acc, cur, wr, wc, fr, fq, lds, wid, lane); S.done(cur); }
#undef PG8_SA
#undef PG8_SB
#undef PG8_STAGE
#undef PG8_LDA
#undef PG8_LDB
#undef PG8_MMA
#undef PG8_WAIT_V
#undef PG8_WAIT_L
#undef PG8_BAR
#undef PG8_SCHED
}
}
using namespace pg8;
using pg8::bf16_t; using pg8::bf16x8; using pg8::f32x4; using pg8::u32x4; using pg8::cvt_pk_bf16;
#define LAS __attribute__((address_space(3)))
typedef float f32x16 __attribute__((ext_vector_type(16)));
typedef unsigned u32x2 __attribute__((ext_vector_type(2)));
#define LDS_WAIT() asm volatile("s_waitcnt lgkmcnt(0)" ::: "memory")
typedef float f32x2_t __attribute__((ext_vector_type(2)));
typedef __bf16 bf16x2_t __attribute__((ext_vector_type(2)));
__device__ __forceinline__ unsigned cvtpk_s(float lo, float hi) { f32x2_t v = {lo, hi}; bf16x2_t b = __builtin_convertvector(v, bf16x2_t); return __builtin_bit_cast(unsigned, b); }

constexpr size_t WE_QKV0 = 0, WE_QKV1 = WE_QKV0 + 1536 * 1024, WE_QKV2 = WE_QKV1 + 2048 * 1024, WE_QKV3 = WE_QKV2 + 1536 * 1024;
constexpr size_t WE_WO0 = WE_QKV3 + 1536 * 1024, WE_WO1 = WE_WO0 + 1024 * 1024, WE_WO2 = WE_WO1 + 1024 * 1152, WE_WO3 = WE_WO2 + 1024 * 1024;
constexpr size_t WE_W1 = WE_WO3 + 1024 * 1024, WE_W2 = WE_W1 + 4 * (size_t)4096 * 1024, WE_END = WE_W2 + 4 * (size_t)4096 * 1024;
static_assert(WS_W + WE_END * 2 <= WS_HB, "weights fit");

struct Params { const float* in[15]; float* out; unsigned char* ws; };

__device__ __forceinline__ float wave_sum(float v) {
#pragma unroll
    for (int o = 1; o < 64; o <<= 1) v += __shfl_xor(v, o);
    return v;
}

__device__ __forceinline__ void tr_item(const float* __restrict__ W, int K, int N, int Npad, bf16_t* WT, const float* __restrict__ gain, int mode, int nheads, int nperm, LAS float* scr, int item, int lane) {
    const int nblk = Npad >> 5, kb = item / nblk, nb = item - kb * nblk, k0 = 64 * kb, R0 = 32 * nb;
    int src0 = R0; bool valid = true, perm = false;
    if (mode == 1) { const int pn = R0 >> 8, c = R0 & 255, bj = c >> 7, wc = (c >> 5) & 3, hcol = 4 * pn + wc; valid = hcol < nheads; perm = hcol < nperm; src0 = hcol * 64 + 32 * bj; }
#pragma unroll 8
    for (int i = 0; i < 32; ++i) {
        const int kk = 2 * i + (lane >> 5);
        float w = 0.f;
        if (valid) { w = W[(size_t)(k0 + kk) * N + src0 + (lane & 31)]; if (gain) w *= gain[k0 + kk]; }
        scr[kk * 33 + (lane & 31)] = w;
    }
    LDS_WAIT();
    const int c8 = lane & 7;
#pragma unroll
    for (int jj = 0; jj < 4; ++jj) {
        const int e = (lane >> 3) + 8 * jj;
        const int se = perm ? (16 * ((e >> 2) & 1) + 4 * (e >> 3) + (e & 3)) : e;
        const LAS float* s = scr + (8 * c8) * 33 + se;
        u32x4 o; o.x = cvt_pk_bf16(s[0 * 33], s[1 * 33]); o.y = cvt_pk_bf16(s[2 * 33], s[3 * 33]); o.z = cvt_pk_bf16(s[4 * 33], s[5 * 33]); o.w = cvt_pk_bf16(s[6 * 33], s[7 * 33]);
        *(u32x4*)(WT + (size_t)(R0 + e) * K + k0 + 8 * c8) = o;
    }
    LDS_WAIT();
}

__device__ __forceinline__ void prologue(const Params& p, LAS unsigned char* lds, int gw, int NGW, int wave, int lane) {
    float* ss = (float*)(p.ws + WS_SSP);
    bf16_t* WB = (bf16_t*)(p.ws + WS_W);
    LAS float* scr = (LAS float*)(lds + wave * 16384);
    const float* attn_norm = p.in[1]; const float* mlp_norm = p.in[2];
    constexpr int I_QA = 16 * (1536 / 32), I_QB = 16 * (2048 / 32), I_WO = 16 * 32, I_WOB = 18 * 32, I_W1 = 16 * 128, I_W2 = 64 * 32;
    constexpr int NITEMS = 3 * I_QA + I_QB + 3 * I_WO + I_WOB + 4 * I_W1 + 4 * I_W2;
    for (int it = gw; it < NITEMS; it += NGW) {
        int r = it;
        if (r < I_QA) { tr_item(p.in[3], 1024, 1536, 1536, WB + WE_QKV0, attn_norm + 0 * DM, 1, 24, 20, scr, r, lane); continue; } r -= I_QA;
        if (r < I_QB) { tr_item(p.in[7], 1024, 1920, 2048, WB + WE_QKV1, attn_norm + 1 * DM, 1, 30, 0, scr, r, lane); continue; } r -= I_QB;
        if (r < I_QA) { tr_item(p.in[9], 1024, 1536, 1536, WB + WE_QKV2, attn_norm + 2 * DM, 1, 24, 0, scr, r, lane); continue; } r -= I_QA;
        if (r < I_QA) { tr_item(p.in[3] + (size_t)1024 * 1536, 1024, 1536, 1536, WB + WE_QKV3, attn_norm + 3 * DM, 1, 24, 20, scr, r, lane); continue; } r -= I_QA;
        if (r < I_WO) { tr_item(p.in[6], 1024, 1024, 1024, WB + WE_WO0, nullptr, 0, 0, 0, scr, r, lane); continue; } r -= I_WO;
        if (r < I_WOB) { tr_item(p.in[8], 1152, 1024, 1024, WB + WE_WO1, nullptr, 0, 0, 0, scr, r, lane); continue; } r -= I_WOB;
        if (r < I_WO) { tr_item(p.in[11], 1024, 1024, 1024, WB + WE_WO2, nullptr, 0, 0, 0, scr, r, lane); continue; } r -= I_WO;
        if (r < I_WO) { tr_item(p.in[6] + (size_t)1024 * 1024, 1024, 1024, 1024, WB + WE_WO3, nullptr, 0, 0, 0, scr, r, lane); continue; } r -= I_WO;
        if (r < 4 * I_W1) { const int l = r / I_W1; tr_item(p.in[12] + (size_t)l * 1024 * 4096, 1024, 4096, 4096, WB + WE_W1 + (size_t)l * 4096 * 1024, mlp_norm + l * DM, 0, 0, 0, scr, r - l * I_W1, lane); continue; } r -= 4 * I_W1;
        { const int l = r / I_W2; tr_item(p.in[13] + (size_t)l * 4096 * 1024, 4096, 1024, 1024, WB + WE_W2 + (size_t)l * 4096 * 1024, nullptr, 0, 0, 0, scr, r - l * I_W2, lane); }
    }
    const float* x = p.in[0]; bf16_t* hb = (bf16_t*)(p.ws + WS_HB);
    for (int m = gw; m < MTOK; m += NGW) {
        const f32x4* xr = (const f32x4*)(x + (size_t)m * DM) + lane;
        f32x4 v[4]; float s = 0.f;
#pragma unroll
        for (int j = 0; j < 4; ++j) { v[j] = xr[64 * j]; s += (v[j].x * v[j].x + v[j].y * v[j].y) + (v[j].z * v[j].z + v[j].w * v[j].w); }
        s = wave_sum(s);
        u32x2* o8 = (u32x2*)(hb + (size_t)m * DM) + lane;
#pragma unroll
        for (int j = 0; j < 4; ++j) { u32x2 w; w.x = cvt_pk_bf16(v[j].x, v[j].y); w.y = cvt_pk_bf16(v[j].z, v[j].w); o8[64 * j] = w; }
        if (lane < 16) ss[(size_t)m * 16 + lane] = (lane == 0) ? s : 0.f;
    }
}

constexpr int AT_ROWB = 144, AT_TILEB = 64 * AT_ROWB, AT_BUFB = 2 * AT_TILEB;
template <int MODE> __device__ __forceinline__ void attn_phase(LAS unsigned char* lds, const bf16_t* __restrict__ Qg, const bf16_t* __restrict__ Kg, const bf16_t* __restrict__ Vg, bf16_t* Og, float* LSE, const float* __restrict__ sinks) {
    int tid_ = threadIdx.x; asm volatile("" : "+v"(tid_));
    const int tid = tid_, lane = tid & 63, wave = __builtin_amdgcn_readfirstlane(tid >> 6), r32 = lane & 31, hi = lane >> 5;
    constexpr int NQ = (MODE == 0) ? 2 : 1;
    constexpr int QU = 256 * NQ;
    constexpr int NUNITS = (MODE == 1) ? 3 * 768 : 2048 / NQ;
    constexpr int HQ = (MODE == 1) ? 6 : 16, HKV = (MODE == 1) ? 2 : 4, WIN = (MODE == 1) ? 64 : 128, OPITCH = (MODE == 1) ? 1152 : 1024;
    const int srow = tid >> 3, schunk = tid & 7;
    const unsigned sdst = (unsigned)(srow * AT_ROWB + schunk * 16);
    for (int un = blockIdx.x; un < NUNITS; un += gridDim.x) {
        int g = 0, vb, hq, qb;
        if (MODE == 1) { g = un / 768; const int r = un - g * 768; const int nqbs = 4 - 2 * g;   qb = r & ((1 << nqbs) - 1); const int r2 = r >> nqbs; hq = r2 % 6; vb = r2 / 6; }
        else if (MODE == 0) { qb = un & 7; hq = (un >> 3) & 15; vb = un >> 7; }
        else { qb = un & 15; hq = (un >> 4) & 15; vb = un >> 8; }
        const int gsh = 2 * g, lsh = 12 - gsh, L = 1 << lsh;
        const int kvh = (MODE == 1) ? hq / 3 : hq >> 2;
        const int q0 = qb * QU, qw = q0 + 32 * NQ * wave;
        const size_t gq = (MODE == 1) ? (size_t)g * ((size_t)NBATCH * 6 * SEQ * 64) : 0, gk = (MODE == 1) ? (size_t)g * ((size_t)NBATCH * 2 * SEQ * 64) : 0;
        bf16x8 qf[NQ][4];
#pragma unroll
        for (int j = 0; j < NQ; ++j) {
            const bf16_t* qp = Qg + gq + ((((size_t)(vb * HQ + hq)) << lsh) + qw + 32 * j + r32) * 64 + 8 * hi;
#pragma unroll
            for (int s = 0; s < 4; ++s) qf[j][s] = *(const bf16x8*)(qp + 16 * s);
        }
        const bf16_t* kbase = Kg + gk + (((size_t)(vb * HKV + kvh)) << lsh) * 64;
        const bf16_t* vbase = Vg + gk + ((((size_t)(vb * HKV + kvh)) * 64) << lsh);
        int lo = 0, hiT = L >> 6;
        if (MODE != 0) { lo = (q0 - WIN) >> 6; if (lo < 0) lo = 0; int h2 = ((q0 + 255 + WIN) >> 6) + 1; if (h2 < hiT) hiT = h2; }
        float slope2 = 0.f;
        if (MODE == 1) slope2 = exp2f(-8.0f * (float)(g * 6 + hq + 1) / 18.0f) * (float)(1 << gsh) * LOG2E;
        if (MODE == 2) slope2 = exp2f(-8.0f * (float)(hq + 1) / 16.0f) * LOG2E;
        float mrun[NQ], lrun[NQ];
        f32x16 oacc[NQ][2];
#pragma unroll
        for (int j = 0; j < NQ; ++j) {
            mrun[j] = NEG_BIG; lrun[j] = 0.f;
            if (MODE == 2) { mrun[j] = sinks[hq] * LOG2E; lrun[j] = (hi == 0) ? 1.f : 0.f; }
#pragma unroll
            for (int i = 0; i < 16; ++i) { oacc[j][0][i] = 0.f; oacc[j][1][i] = 0.f; }
        }
        u32x4 kreg, vreg;
        kreg = *(const u32x4*)(kbase + (size_t)lo * 4096 + tid * 8);
        vreg = *(const u32x4*)(vbase + ((size_t)srow << lsh) + lo * 64 + schunk * 8);
        *(LAS u32x4*)(lds + sdst) = kreg; *(LAS u32x4*)(lds + AT_TILEB + sdst) = vreg;
        __syncthreads();
        for (int kt = lo; kt < hiT; ++kt) {
            const int buf = (kt - lo) & 1;
            const bool more = (kt + 1 < hiT);
            if (more) {
                kreg = *(const u32x4*)(kbase + (size_t)(kt + 1) * 4096 + tid * 8);
                vreg = *(const u32x4*)(vbase + ((size_t)srow << lsh) + (kt + 1) * 64 + schunk * 8);
            }
            bool active = true;
            if (MODE != 0) active = !((64 * kt + 63 < qw - WIN) || (64 * kt > qw + 31 + WIN));
            if (active) {
                const LAS unsigned char* kl = lds + buf * AT_BUFB;
                const LAS unsigned char* vl = kl + AT_TILEB;
                f32x16 sacc[NQ][2];
#pragma unroll
                for (int kb = 0; kb < 2; ++kb) {
#pragma unroll
                    for (int j = 0; j < NQ; ++j)
#pragma unroll
                        for (int i = 0; i < 16; ++i) sacc[j][kb][i] = 0.f;
#pragma unroll
                    for (int s = 0; s < 4; ++s) {
                        const bf16x8 kf = *(const LAS bf16x8*)(kl + (32 * kb + r32) * AT_ROWB + (2 * s + hi) * 16);
#pragma unroll
                        for (int j = 0; j < NQ; ++j) sacc[j][kb] = __builtin_amdgcn_mfma_f32_32x32x16_bf16(kf, qf[j][s], sacc[j][kb], 0, 0, 0);
                    }
                }
                bf16x8 pf[NQ][2][2];
#pragma unroll
                for (int j = 0; j < NQ; ++j) {
                    if (MODE != 0) {
                        const float fd0 = (float)(64 * kt + 4 * hi - (qw + r32));
#pragma unroll
                        for (int kb = 0; kb < 2; ++kb)
#pragma unroll
                            for (int i = 0; i < 16; ++i) {
                                const float dist = fabsf(fd0 + (float)(32 * kb + 8 * (i >> 2) + (i & 3)));
                                sacc[j][kb][i] = (dist <= (float)WIN) ? (sacc[j][kb][i] - slope2 * dist) : NEG_BIG;
                            }
                    }
                    float mx = sacc[j][0][0];
#pragma unroll
                    for (int i = 1; i < 16; ++i) mx = fmaxf(mx, sacc[j][0][i]);
#pragma unroll
                    for (int i = 0; i < 16; ++i) mx = fmaxf(mx, sacc[j][1][i]);
                    mx = fmaxf(mx, __shfl_xor(mx, 32));
                    if (__builtin_amdgcn_ballot_w64(mx > mrun[j]) != 0ull) {
                        const float mnew = fmaxf(mrun[j], mx);
                        const float alpha = __builtin_amdgcn_exp2f(mrun[j] - mnew);
                        mrun[j] = mnew;
                        lrun[j] *= alpha;
#pragma unroll
                        for (int i = 0; i < 16; ++i) { oacc[j][0][i] *= alpha; oacc[j][1][i] *= alpha; }
                    }
                    const float mcur = mrun[j];
                    float ps = 0.f;
#pragma unroll
                    for (int kb = 0; kb < 2; ++kb)
#pragma unroll
                        for (int i = 0; i < 16; ++i) { const float pv = __builtin_amdgcn_exp2f(sacc[j][kb][i] - mcur); sacc[j][kb][i] = pv; ps += pv; }
                    lrun[j] += ps;
#pragma unroll
                    for (int kb = 0; kb < 2; ++kb)
#pragma unroll
                        for (int hh = 0; hh < 2; ++hh) {
                            u32x4 w; w.x = cvtpk_s(sacc[j][kb][8 * hh + 0], sacc[j][kb][8 * hh + 1]); w.y = cvtpk_s(sacc[j][kb][8 * hh + 2], sacc[j][kb][8 * hh + 3]);
                            w.z = cvtpk_s(sacc[j][kb][8 * hh + 4], sacc[j][kb][8 * hh + 5]); w.w = cvtpk_s(sacc[j][kb][8 * hh + 6], sacc[j][kb][8 * hh + 7]);
                            pf[j][kb][hh] = __builtin_bit_cast(bf16x8, w);
                        }
                }
#pragma unroll
                for (int db = 0; db < 2; ++db)
#pragma unroll
                    for (int kb = 0; kb < 2; ++kb)
#pragma unroll
                        for (int hh = 0; hh < 2; ++hh) {
                            const bf16x8 vf = *(const LAS bf16x8*)(vl + (32 * db + r32) * AT_ROWB + (2 * (2 * kb + hh) + hi) * 16);
#pragma unroll
                            for (int j = 0; j < NQ; ++j) oacc[j][db] = __builtin_amdgcn_mfma_f32_32x32x16_bf16(vf, pf[j][kb][hh], oacc[j][db], 0, 0, 0);
                        }
            }
            if (more) {
                LAS unsigned char* nb = lds + (buf ^ 1) * AT_BUFB;
                *(LAS u32x4*)(nb + sdst) = kreg; *(LAS u32x4*)(nb + AT_TILEB + sdst) = vreg;
            }
            __syncthreads();
        }
#pragma unroll
        for (int j = 0; j < NQ; ++j) {
            const float ltot = lrun[j] + __shfl_xor(lrun[j], 32);
            const float inv = 1.0f / ltot;
            int row, hglob;
            if (MODE == 1) { const int dmask = (1 << gsh) - 1; const int b = vb >> gsh, rr = vb & dmask; row = b * SEQ + rr + ((qw + r32) << gsh); hglob = g * 6 + hq; }
            else { row = vb * SEQ + qw + 32 * j + r32; hglob = hq; }
            bf16_t* op = Og + (size_t)row * OPITCH + hglob * 64 + 4 * hi;
#pragma unroll
            for (int db = 0; db < 2; ++db)
#pragma unroll
                for (int q4 = 0; q4 < 4; ++q4) {
                    u32x2 w; w.x = cvtpk_s(oacc[j][db][4 * q4 + 0] * inv, oacc[j][db][4 * q4 + 1] * inv); w.y = cvtpk_s(oacc[j][db][4 * q4 + 2] * inv, oacc[j][db][4 * q4 + 3] * inv);
                    *(u32x2*)(op + 32 * db + 8 * q4) = w;
                }
            if (MODE == 1) { if (hi == 0) LSE[(size_t)row * 18 + hglob] = mrun[j] + __builtin_amdgcn_logf(ltot); }
        }
    }
}

__device__ __forceinline__ void attn_dense_fast(LAS unsigned char* lds, const bf16_t* __restrict__ Qg, const bf16_t* __restrict__ Kg, const bf16_t* __restrict__ Vg, bf16_t* Og) {
    int tid_ = threadIdx.x; asm volatile("" : "+v"(tid_));
    const int tid = tid_, lane = tid & 63, wave = __builtin_amdgcn_readfirstlane(tid >> 6), r32 = lane & 31, hi = lane >> 5;
    constexpr int NQ = 2, NUNITS = 1024, NT = SEQ / 64;
    constexpr int VRING = 2 * AT_TILEB;
    const int srow = tid >> 3, schunk = tid & 7;
    const unsigned sdst = (unsigned)(srow * AT_ROWB + schunk * 16);
    { unsigned z = 0u; asm volatile("" : "+v"(z));
      for (int i = tid; i < 3 * AT_TILEB / 16; i += 512) *(LAS u32x4*)(lds + VRING + i * 16) = (u32x4){z, z, z, z}; }
    __syncthreads();
    for (int un = blockIdx.x; un < NUNITS; un += gridDim.x) {
        const int qb = un & 7, hq = (un >> 3) & 15, vb = un >> 7, kvh = hq >> 2;
        const int qw = qb * 512 + 64 * wave;
        bf16x8 qf[NQ][4];
#pragma unroll
        for (int j = 0; j < NQ; ++j) {
            const bf16_t* qp = Qg + ((size_t)(vb * 16 + hq) * SEQ + qw + 32 * j + r32) * 64 + 8 * hi;
#pragma unroll
            for (int s = 0; s < 4; ++s) qf[j][s] = *(const bf16x8*)(qp + 16 * s);
        }
        const char* kbu = (const char*)(Kg + (size_t)(vb * 4 + kvh) * SEQ * 64);
        const char* vbu = (const char*)(Vg + (size_t)(vb * 4 + kvh) * 64 * SEQ);
        const unsigned kof = (unsigned)tid * 16u, vof = (unsigned)(srow * SEQ + schunk * 8) * 2u;
        float lsum[NQ]; f32x16 oacc[NQ][2]; bf16x8 pfp[NQ][2][2];
#pragma unroll
        for (int j = 0; j < NQ; ++j) {
            lsum[j] = 0.f;
#pragma unroll
            for (int i = 0; i < 16; ++i) { oacc[j][0][i] = 0.f; oacc[j][1][i] = 0.f; }
#pragma unroll
            for (int kb = 0; kb < 2; ++kb)
#pragma unroll
                for (int hh = 0; hh < 2; ++hh) pfp[j][kb][hh] = (bf16x8){0, 0, 0, 0, 0, 0, 0, 0};
        }
        u32x4 kreg = *(const u32x4*)(kbu + kof), vreg = *(const u32x4*)(vbu + vof);
        *(LAS u32x4*)(lds + sdst) = kreg; *(LAS u32x4*)(lds + VRING + sdst) = vreg;
        __syncthreads();
        int vprev = VRING + 2 * AT_TILEB, vcur = VRING, vnext = VRING + AT_TILEB;
        f32x16 sB[NQ];
#pragma unroll
        for (int j = 0; j < NQ; ++j)
#pragma unroll
            for (int i = 0; i < 16; ++i) sB[j][i] = NEG_BIG;
#pragma unroll 1
        for (int kt = 0; kt < NT; ++kt) {
            const int tn = (kt + 1 < NT) ? kt + 1 : kt;
            kreg = *(const u32x4*)(kbu + (size_t)tn * 8192 + kof);
            vreg = *(const u32x4*)(vbu + (size_t)tn * 128 + vof);
            const LAS unsigned char* kl = lds + (kt & 1) * AT_TILEB;
            const LAS unsigned char* vl = lds + vprev;
#define AF_QK(dst, kb) do { _Pragma("unroll") for (int j = 0; j < NQ; ++j) _Pragma("unroll") for (int i = 0; i < 16; ++i) dst[j][i] = 0.f; \
            _Pragma("unroll") for (int s = 0; s < 4; ++s) { const bf16x8 kf = *(const LAS bf16x8*)(kl + (32 * (kb) + r32) * AT_ROWB + (2 * s + hi) * 16); \
                _Pragma("unroll") for (int j = 0; j < NQ; ++j) dst[j] = __builtin_amdgcn_mfma_f32_32x32x16_bf16(kf, qf[j][s], dst[j], 0, 0, 0); } } while (0)
#define AF_PV(kb) do { _Pragma("unroll") for (int hh = 0; hh < 2; ++hh) _Pragma("unroll") for (int db = 0; db < 2; ++db) { \
            const bf16x8 vf = *(const LAS bf16x8*)(vl + (32 * db + r32) * AT_ROWB + (2 * (2 * (kb) + hh) + hi) * 16); \
            _Pragma("unroll") for (int j = 0; j < NQ; ++j) oacc[j][db] = __builtin_amdgcn_mfma_f32_32x32x16_bf16(vf, pfp[j][kb][hh], oacc[j][db], 0, 0, 0); } } while (0)
#define AF_EXP(src, kb) do { _Pragma("unroll") for (int j = 0; j < NQ; ++j) { float ps = 0.f; \
            _Pragma("unroll") for (int i = 0; i < 16; ++i) { const float pv = __builtin_amdgcn_exp2f(src[j][i]); src[j][i] = pv; ps += pv; } \
            lsum[j] += ps; \
            _Pragma("unroll") for (int hh = 0; hh < 2; ++hh) { u32x4 w; w.x = cvtpk_s(src[j][8 * hh + 0], src[j][8 * hh + 1]); w.y = cvtpk_s(src[j][8 * hh + 2], src[j][8 * hh + 3]); \
                w.z = cvtpk_s(src[j][8 * hh + 4], src[j][8 * hh + 5]); w.w = cvtpk_s(src[j][8 * hh + 6], src[j][8 * hh + 7]); pfp[j][kb][hh] = __builtin_bit_cast(bf16x8, w); } } } while (0)
#define AF_SCHED() do { _Pragma("unroll") for (int q_ = 0; q_ < 16; ++q_) { __builtin_amdgcn_sched_group_barrier(0x008, 1, 0); __builtin_amdgcn_sched_group_barrier(0x400, 2, 0); \
            __builtin_amdgcn_sched_group_barrier(0x002, 3, 0); __builtin_amdgcn_sched_group_barrier(0x100, 1, 0); } } while (0)
            f32x16 sA[NQ];
            AF_QK(sA, 0); AF_PV(0); AF_EXP(sB, 1);
            AF_SCHED();
            AF_QK(sB, 1); AF_PV(1); AF_EXP(sA, 0);
            AF_SCHED();
            *(LAS u32x4*)(lds + ((kt + 1) & 1) * AT_TILEB + sdst) = kreg; *(LAS u32x4*)(lds + vnext + sdst) = vreg;
            { const int tmp = vprev; vprev = vcur; vcur = vnext; vnext = tmp; }
            __syncthreads();
        }
        {
            const LAS unsigned char* vl = lds + vprev;
            AF_EXP(sB, 1);
            AF_PV(0); AF_PV(1);
        }
        __syncthreads();
#pragma unroll
        for (int j = 0; j < NQ; ++j) {
            const float ltot = lsum[j] + __shfl_xor(lsum[j], 32);
            const float inv = 1.0f / ltot;
            const int row = vb * SEQ + qw + 32 * j + r32;
            bf16_t* op = Og + (size_t)row * 1024 + hq * 64 + 4 * hi;
#pragma unroll
            for (int db = 0; db < 2; ++db)
#pragma unroll
                for (int q4 = 0; q4 < 4; ++q4) {
                    u32x2 w; w.x = cvtpk_s(oacc[j][db][4 * q4 + 0] * inv, oacc[j][db][4 * q4 + 1] * inv); w.y = cvtpk_s(oacc[j][db][4 * q4 + 2] * inv, oacc[j][db][4 * q4 + 3] * inv);
                    *(u32x2*)(op + 32 * db + 8 * q4) = w;
                }
        }
    }
}

__device__ __forceinline__ void mixb_fix(bf16_t* Og, const float* LSE, int gw, int NGW, int lane) {
    asm volatile("" : "+v"(lane));
    for (int m = gw; m < MTOK; m += NGW) {
        const float* ls = LSE + (size_t)m * 18;
#pragma unroll
        for (int c3 = 0; c3 < 3; ++c3) {
            const int c = lane + 64 * c3;
            if (c < 144) {
                const int head = c >> 3, g = head / 6, kr = head - 6 * g;
                const float l0 = ls[kr], l1 = ls[6 + kr], l2 = ls[12 + kr];
                const float mx = fmaxf(l0, fmaxf(l1, l2));
                const float e0 = exp2f(l0 - mx), e1 = exp2f(l1 - mx), e2 = exp2f(l2 - mx);
                const float a = ((g == 0) ? e0 : (g == 1) ? e1 : e2) / (e0 + e1 + e2);
                u32x4* pp = (u32x4*)(Og + (size_t)m * 1152) + c;
                u32x4 w = *pp;
                unsigned ww[4] = {w.x, w.y, w.z, w.w};
#pragma unroll
                for (int k = 0; k < 4; ++k) { const float f0 = __builtin_bit_cast(float, ww[k] << 16) * a, f1 = __builtin_bit_cast(float, ww[k] & 0xffff0000u) * a; ww[k] = cvt_pk_bf16(f0, f1); }
                w.x = ww[0]; w.y = ww[1]; w.z = ww[2]; w.w = ww[3];
                *pp = w;
            }
        }
    }
}

#define XB_TMO      128
#define XB_XCNT(j)  (256  + 64 * (j))
#define XB_XSUB(j)  (1280 + 64 * (j))
#define XB_XGEN(j)  (2304 + 64 * (j))
#define XB_TOP      3328
#define XB_TOPGEN   3392
#define XCD_BAR_WORDS 3456
#define XB_SPIN_CAP (1u << 18)

__device__ __forceinline__ unsigned xb_ld(unsigned* p)              { return __hip_atomic_load(p, __ATOMIC_RELAXED, __HIP_MEMORY_SCOPE_AGENT); }
__device__ __forceinline__ unsigned xb_add(unsigned* p, unsigned v) { return __hip_atomic_fetch_add(p, v, __ATOMIC_RELAXED, __HIP_MEMORY_SCOPE_AGENT); }
__device__ __forceinline__ unsigned xb_xcc_id() { return (unsigned)__builtin_amdgcn_s_getreg((3 << 11) | 20) & 0xFu; }
#define XB_SPIN(cond, bar) do { unsigned _sp = 0; while (cond) { __builtin_amdgcn_s_sleep(1); \
    if ((++_sp & 255u) == 0u) { if (xb_ld(&(bar)[XB_TMO])) break; if (_sp > XB_SPIN_CAP) { atomicAdd(&(bar)[XB_TMO], 1u); break; } } } } while (0)

struct XcdBarrier {
    unsigned* bar; unsigned x;
    volatile LAS unsigned* st;
};

__device__ __forceinline__ XcdBarrier xcd_barrier_post(unsigned* bar, volatile LAS unsigned* st) {
    XcdBarrier b; b.bar = bar; b.x = xb_xcc_id(); b.st = st;
    if (threadIdx.x == 0) (void)xb_add(&bar[XB_XCNT(b.x)], 1u);
    return b;
}
__device__ __forceinline__ void xcd_barrier_complete(unsigned* bar, unsigned x, unsigned& nloc, unsigned& nx) {
    const unsigned G = gridDim.x * gridDim.y * gridDim.z;
    unsigned sum, cnt, mine, sp = 0u;
    for (;;) {
        sum = 0u; cnt = 0u; mine = 0u;
#pragma unroll
        for (unsigned j = 0; j < 16; ++j) { const unsigned c = xb_ld(&bar[XB_XCNT(j)]); sum += c; cnt += (c > 0u) ? 1u : 0u; mine = (j == x) ? c : mine; }
        if (sum == G) break;
        __builtin_amdgcn_s_sleep(1);
        if ((++sp & 255u) == 0u) { if (xb_ld(&bar[XB_TMO])) break; if (sp > XB_SPIN_CAP) { atomicAdd(&bar[XB_TMO], 1u); break; } }
    }
    nloc = mine > 0u ? mine : 1u; nx = cnt > 0u ? cnt : 1u;
}

__device__ __forceinline__ void xcd_barrier(const XcdBarrier& b) {
    asm volatile("s_waitcnt vmcnt(0)" ::: "memory");
    __syncthreads();
    if (threadIdx.x == 0) {
        unsigned* bar = b.bar;
        __builtin_amdgcn_s_waitcnt(0);
        unsigned nloc = b.st[0], nx = b.st[1];
        if (nloc == 0u) { xcd_barrier_complete(bar, b.x, nloc, nx); b.st[0] = nloc; b.st[1] = nx; }
        const unsigned old = xb_add(&bar[XB_XSUB(b.x)], 1u);
        const unsigned gen = old / nloc;
        if (old + 1u == (gen + 1u) * nloc) {
            __builtin_amdgcn_fence(__ATOMIC_RELEASE, "agent");
            asm volatile("s_waitcnt vmcnt(0)" ::: "memory");
            const unsigned og = xb_add(&bar[XB_TOP], 1u);
            const unsigned tg = og / nx;
            if (og + 1u == (tg + 1u) * nx) xb_add(&bar[XB_TOPGEN], 1u);
            else XB_SPIN(xb_ld(&bar[XB_TOPGEN]) == tg, bar);
            __builtin_amdgcn_fence(__ATOMIC_ACQUIRE, "agent");
            xb_add(&bar[XB_XGEN(b.x)], 1u);
            asm volatile("s_waitcnt vmcnt(0)" ::: "memory");
        } else {
            XB_SPIN(xb_ld(&bar[XB_XGEN(b.x)]) == gen, bar);
            __builtin_amdgcn_fence(__ATOMIC_ACQUIRE, "agent");
            asm volatile("s_waitcnt vmcnt(0)" ::: "memory");
        }
    }
    __syncthreads();
}

__device__ __forceinline__ void fill_rstd(LAS unsigned char* lds, const pg8::StaticOrder& S, const float* ssp) {
    LAS float* rs = (LAS float*)(lds + LDS_RSTD);
    int tid = threadIdx.x; asm volatile("" : "+v"(tid));
    for (int i0 = 0; i0 < 8; i0 += 2) {
        pg8::Unit u; const int i = i0 + (tid >> 8);
        if (S.next(i, u)) rs[i * 256 + (tid & 255)] = __builtin_amdgcn_rsqf(row_ss(ssp, u.pm * 256 + (tid & 255)) * (1.0f / DM) + RMS_EPS);
    }
    __syncthreads();
}

__global__ void __launch_bounds__(512, 2) fwd_kernel(Params p) {
    extern __shared__ __attribute__((aligned(16))) unsigned char lds_raw[];
    LAS unsigned char* lds = (LAS unsigned char*)lds_raw;
    cg::grid_group grid = cg::this_grid();
    volatile LAS unsigned* xst = (volatile LAS unsigned*)(lds + LDS_BYTES - 64);
    if (threadIdx.x < 2) xst[threadIdx.x] = 0u;
    __syncthreads();
    XcdBarrier xbar = xcd_barrier_post((unsigned*)(p.ws + WS_BAR), xst);
    {
        LAS float* rope = (LAS float*)(lds + LDS_ROPE); LAS float* gl = (LAS float*)(lds + LDS_GAIN);
        for (int i = threadIdx.x; i < 1024; i += 512) { const int pos = i >> 4, f = i & 15; const float ang = (float)pos * exp2f(-(float)f * 0.83048202372184059f); rope[2 * i] = cosf(ang); rope[2 * i + 1] = sinf(ang); }
        if (threadIdx.x < 256) { const int i = threadIdx.x, ja = i >> 7, qk = (i >> 6) & 1, d = i & 63; gl[i] = (qk == 0 ? p.in[4] : p.in[5])[ja * 64 + d]; }
    }
#define GRID_SYNC() do { asm volatile("s_waitcnt vmcnt(0) lgkmcnt(0)" ::: "memory"); grid.sync(); asm volatile("buffer_inv sc1\n\ts_waitcnt vmcnt(0)" ::: "memory"); GRID_SYNC2(); } while (0)
#define XBAR_SYNC() do { xcd_barrier(xbar); asm volatile("buffer_inv sc1\n\ts_waitcnt vmcnt(0)" ::: "memory"); } while (0)
#ifdef PROBE_DUP_SYNC
#define GRID_SYNC2() do { grid.sync(); asm volatile("buffer_inv sc1\n\ts_waitcnt vmcnt(0)" ::: "memory"); } while (0)
#else
#define GRID_SYNC2() do { } while (0)
#endif
    const int wave = __builtin_amdgcn_readfirstlane((int)threadIdx.x >> 6);
#define LANE() ({ int l_ = (int)threadIdx.x & 63; asm volatile("" : "+v"(l_)); l_; })
    const int G = gridDim.x, gw = blockIdx.x * 8 + wave, NGW = G * 8;
    unsigned char* ws = p.ws;
#define GAS __attribute__((address_space(1)))
#define WSP() ({ GAS unsigned char* q_ = (GAS unsigned char*)ws; asm volatile("" : "+s"(q_)); (unsigned char*)q_; })
#define SSP(i) ((float*)(WSP() + WS_SSP) + (size_t)(i) * MTOK * 16)
#define LSE_ ((float*)(WSP() + WS_LSE))
#define WB_ ((bf16_t*)(WSP() + WS_W))
#define HB_ ((bf16_t*)(WSP() + WS_HB))
#define U_ ((bf16_t*)(WSP() + WS_U))
#define Qb_ ((bf16_t*)(WSP() + WS_Q))
#define Kb_ ((bf16_t*)(WSP() + WS_K))
#define Vb_ ((bf16_t*)(WSP() + WS_VT))
#define Ob_ ((bf16_t*)(WSP() + WS_O))
    float* h = p.out;

#ifndef PHMASK
#define PHMASK 0xffff
#endif
    if (PHMASK & 1) prologue(p, lds, gw, NGW, wave, LANE());
#ifdef PROBE_DUP_PRO
    __syncthreads(); prologue(p, lds, gw, NGW, wave, LANE());
#endif
    GRID_SYNC();

#pragma unroll 1
    for (int layer = 0; layer < 4; ++layer) {
        const int kind = (layer == 3) ? 0 : layer;
        const int ja = (layer == 3) ? 1 : 0;
        const size_t weq = (layer == 0) ? WE_QKV0 : (layer == 1) ? WE_QKV1 : (layer == 2) ? WE_QKV2 : WE_QKV3;
        const size_t weo = (layer == 0) ? WE_WO0 : (layer == 1) ? WE_WO1 : (layer == 2) ? WE_WO2 : WE_WO3;
        if (kind == 0 && (PHMASK & 2)) {
            pg8::Gemm g{HB_, WB_ + weq, MTOK, 1536, DM}; pg8::StaticOrder S; S.init(MTOK, 1536, G, (int)blockIdx.x);
            fill_rstd(lds, S, SSP(2 * layer));
            pg8::EpiQKV<0> E{WSP(), lds, ja, 0};
            pg8::gemm_phase<pg8::EpiQKV<0>, pg8::StaticOrder, true, true>(lds, g, S, E);
        } else if (kind == 1 && (PHMASK & 4)) {
            pg8::Gemm g{HB_, WB_ + weq, MTOK, 2048, DM}; pg8::StaticOrder S; S.init(MTOK, 2048, G, (int)blockIdx.x);
            fill_rstd(lds, S, SSP(2 * layer));
            pg8::EpiQKV<1> E{WSP(), lds, 0, 0};
            pg8::gemm_phase<pg8::EpiQKV<1>, pg8::StaticOrder, true, true>(lds, g, S, E);
        } else if (kind == 2 && (PHMASK & 8)) {
            pg8::Gemm g{HB_, WB_ + weq, MTOK, 1536, DM}; pg8::StaticOrder S; S.init(MTOK, 1536, G, (int)blockIdx.x);
            fill_rstd(lds, S, SSP(2 * layer));
            pg8::EpiQKV<2> E{WSP(), lds, 0, 0};
            pg8::gemm_phase<pg8::EpiQKV<2>, pg8::StaticOrder, true, true>(lds, g, S, E);
        }
        XBAR_SYNC();
        if (kind == 0) {
            const LAS float* gl = (const LAS float*)(lds + LDS_GAIN) + ja * 128;
            int lane3 = threadIdx.x & 63; asm volatile("" : "+v"(lane3));
            float gq = fabsf(gl[lane3]), gk = fabsf(gl[64 + lane3]);
#pragma unroll
            for (int o = 1; o < 64; o <<= 1) { gq = fmaxf(gq, __shfl_xor(gq, o)); gk = fmaxf(gk, __shfl_xor(gk, o)); }
            const bool fastp = __builtin_amdgcn_readfirstlane((QSCALE * 64.0f * gq * gk <= 60.0f) ? 1 : 0) != 0;
            if (fastp) { if (PHMASK & 16) attn_dense_fast(lds, Qb_, Kb_, Vb_, Ob_); }
            else if (PHMASK & 16) attn_phase<0>(lds, Qb_, Kb_, Vb_, Ob_, LSE_, nullptr);
#ifdef PROBE_DUP_A
            __syncthreads(); attn_phase<0>(lds, Qb_, Kb_, Vb_, Ob_, LSE_, nullptr);
#endif
        }
        else if (kind == 1) { if (PHMASK & 32) attn_phase<1>(lds, Qb_, Kb_, Vb_, Ob_, LSE_, nullptr);
#ifdef PROBE_DUP_BC
            __syncthreads(); attn_phase<1>(lds, Qb_, Kb_, Vb_, Ob_, LSE_, nullptr);
#endif
            XBAR_SYNC(); mixb_fix(Ob_, LSE_, gw, NGW, LANE()); }
        else { if (PHMASK & 64) attn_phase<2>(lds, Qb_, Kb_, Vb_, Ob_, LSE_, p.in[10]);
#ifdef PROBE_DUP_BC
            __syncthreads(); attn_phase<2>(lds, Qb_, Kb_, Vb_, Ob_, LSE_, p.in[10]);
#endif
        }
        XBAR_SYNC();
        if (PHMASK & 128) {
            const int Ko = (kind == 1) ? 1152 : 1024;
            pg8::Gemm g{Ob_, WB_ + weo, MTOK, DM, Ko}; pg8::StaticOrder S; S.init(MTOK, DM, G, (int)blockIdx.x);
            pg8::EpiRes E{HB_, SSP(2 * layer + 1)};
            pg8::gemm_phase<pg8::EpiRes, pg8::StaticOrder, true, true>(lds, g, S, E);
        }
        XBAR_SYNC();
        if (PHMASK & 256) {
            pg8::Gemm g{HB_, WB_ + WE_W1 + (size_t)layer * 4096 * 1024, MTOK, DFF, DM}; pg8::StaticOrder S; S.init(MTOK, DFF, G, (int)blockIdx.x);
            fill_rstd(lds, S, SSP(2 * layer + 1));
            pg8::EpiMlp1 E{lds, U_, 0};
            pg8::gemm_phase<pg8::EpiMlp1, pg8::StaticOrder, true, true>(lds, g, S, E);
#ifdef PROBE_DUP_MLP1
            __syncthreads(); pg8::gemm_phase<pg8::EpiMlp1, pg8::StaticOrder, true, true>(lds, g, S, E);
#endif
        }
        XBAR_SYNC();
        if (PHMASK & 512) {
            pg8::Gemm g{U_, WB_ + WE_W2 + (size_t)layer * 4096 * 1024, MTOK, DM, DFF}; pg8::StaticOrder S; S.init(MTOK, DM, G, (int)blockIdx.x);
            pg8::EpiRes E{HB_, SSP(2 * layer + 2)};
            pg8::gemm_phase<pg8::EpiRes, pg8::StaticOrder, true, true>(lds, g, S, E);
        }
        XBAR_SYNC();
    }
    {
        const float* fg = p.in[14]; const float* ss8 = SSP(8); const bf16_t* hbf = HB_;
        const int lane2 = LANE();
        f32x4 gg[4];
#pragma unroll
        for (int j = 0; j < 4; ++j) gg[j] = ((const f32x4*)fg)[4 * lane2 + j];
        for (int m = gw; m < MTOK; m += NGW) {
            const float rstd = __builtin_amdgcn_rsqf(row_ss(ss8, m) * (1.0f / DM) + RMS_EPS);
            const u32x4* hr = (const u32x4*)(hbf + (size_t)m * DM) + 2 * lane2;
            const u32x4 w0 = hr[0], w1 = hr[1];
            const unsigned ww[8] = {w0.x, w0.y, w0.z, w0.w, w1.x, w1.y, w1.z, w1.w};
            f32x4* orow = (f32x4*)(h + (size_t)m * DM) + 4 * lane2;
#pragma unroll
            for (int j = 0; j < 4; ++j) {
                f32x4 v;
                v[0] = __builtin_bit_cast(float, ww[2 * j] << 16); v[1] = __builtin_bit_cast(float, ww[2 * j] & 0xffff0000u);
                v[2] = __builtin_bit_cast(float, ww[2 * j + 1] << 16); v[3] = __builtin_bit_cast(float, ww[2 * j + 1] & 0xffff0000u);
                orow[j] = v * rstd * gg[j];
            }
        }
    }
}

extern "C" void kernel_launch(void* const* d_in, const int* in_sizes, int n_in, void* d_out, int out_size, void* d_ws, size_t ws_size, hipStream_t stream) {
    static int grid = 0;
    if (grid == 0) {
        if (n_in != 15 || out_size != MTOK * DM || ws_size < WS_END) { fprintf(stderr, "kernel_launch: unexpected shapes (n_in %d out %d ws %zu)\n", n_in, out_size, ws_size); grid = -1; return; }
        int dev = 0, cus = 0, per_cu = 0;
        hipGetDevice(&dev);
        hipDeviceGetAttribute(&cus, hipDeviceAttributeMultiprocessorCount, dev);
        if (hipFuncSetAttribute((const void*)fwd_kernel, hipFuncAttributeMaxDynamicSharedMemorySize, LDS_BYTES) != hipSuccess) { fprintf(stderr, "kernel_launch: hipFuncSetAttribute failed\n"); grid = -1; return; }
        if (hipOccupancyMaxActiveBlocksPerMultiprocessor(&per_cu, (const void*)fwd_kernel, 512, LDS_BYTES) != hipSuccess || per_cu < 1) { fprintf(stderr, "kernel_launch: occupancy query gave %d\n", per_cu); per_cu = 1; }
        (void)hipGetLastError();
        grid = cus * per_cu;
    }
    if (grid < 0) return;
    if (hipMemsetAsync((char*)d_ws + WS_BAR, 0, 16384, stream) != hipSuccess) { fprintf(stderr, "kernel_launch: hipMemsetAsync failed\n"); return; }
    Params p{};
    for (int i = 0; i < 15; ++i) p.in[i] = (const float*)d_in[i];
    p.out = (float*)d_out; p.ws = (unsigned char*)d_ws;
    void* args[] = {&p};
    hipError_t e = hipLaunchCooperativeKernel((const void*)fwd_kernel, dim3(grid), dim3(512), args, LDS_BYTES, stream);
    if (e != hipSuccess) fprintf(stderr, "cooperative launch failed: %s (grid %d)\n", hipGetErrorString(e), grid);
}
```

```cpp
#include <hip/hip_runtime.h>
#include <hip/hip_cooperative_groups.h>
#include <cstdio>
#include <cstdint>
namespace cg = cooperative_groups;

namespace pg8 {
#define PG8_LAS __attribute__((address_space(3)))
typedef unsigned short bf16_t;
typedef short bf16x8 __attribute__((ext_vector_type(8)));
typedef float f32x4 __attribute__((ext_vector_type(4)));
typedef unsigned u32x4 __attribute__((ext_vector_type(4)));
constexpr int BM = 256, BK = 64, HALF = 128, HTB = HALF * BK * 2  , STAGE_BYTES = 8 * HTB, NXCD = 8, WGM = 8;

__host__ __device__ __forceinline__ int lds_byte(int r, int c) { const int st = (r >> 4) * 2 + (c >> 5), rr = r & 15, cc = c & 31, ob = rr * 64 + cc * 2; return st * 1024 + (ob ^ (((ob >> 9) & 1) << 5)); }
__host__ __device__ __forceinline__ void stage_rc(int b, int& R, int& C) { const int st = b / 1024, sb = b % 1024, swz = sb ^ (((sb >> 9) & 1) << 5); R = (st >> 1) * 16 + swz / 64; C = (st & 1) * 32 + (swz % 64) / 2; }
__host__ __device__ __forceinline__ int perm32(int rho) { const int n = rho >> 4, i = rho & 15; return 8 * (i >> 2) + 4 * n + (i & 3); }

struct Unit { int pm, pn; };
struct Gemm { const bf16_t* A; const bf16_t* Bt; int M, N, K; };

struct StaticOrder {
    int nM, nN, nwg, G, c;
    __host__ __device__ void init(int M, int N, int G_, int c_) { nM = M / BM; nN = N / BM; nwg = nM * nN; G = G_; c = c_; }
    __host__ __device__ bool next(int i, Unit& u) const {
        const long L = (long)i * G + c; if (L >= nwg) return false;
        int wgid = (int)L; { const int q = nwg / NXCD, r = nwg % NXCD, xcd = wgid % NXCD, off = wgid / NXCD; wgid = (xcd < r ? xcd * (q + 1) : r * (q + 1) + (xcd - r) * q) + off; }
        const int nig = WGM * nN, gid = wgid / nig, fm = gid * WGM, gsz = (nM - fm) < WGM ? (nM - fm) : WGM;
        u.pm = fm + ((wgid % nig) % gsz); u.pn = (wgid % nig) / gsz; return true;
    }
    __device__ __forceinline__ void a_ready(const Unit&) const {}
    __device__ __forceinline__ void done(const Unit&) const {}
};

__device__ __forceinline__ unsigned cvt_pk_bf16(float lo, float hi) { unsigned r; asm volatile("v_cvt_pk_bf16_f32 %0, %1, %2" : "=v"(r) : "v"(lo), "v"(hi)); return r; }
constexpr int SEQ = 4096, NBATCH = 8, MTOK = NBATCH * SEQ, DM = 1024, DFF = 4096;
constexpr float RMS_EPS = 1e-6f;
constexpr float LOG2E = 1.4426950408889634f;
constexpr float QSCALE = 0.125f * LOG2E;
constexpr float NEG_BIG = -1.0e30f;

constexpr size_t MiB = 1u << 20;
constexpr size_t WS_SS = 0;
constexpr size_t WS_TAB = 6 * MiB;
constexpr size_t WS_BAR = 7 * MiB;
constexpr size_t WS_LSE = 2 * MiB;
constexpr size_t WS_W = 8 * MiB;
constexpr size_t WS_HB = 96 * MiB;
constexpr size_t WS_U = 160 * MiB;
constexpr size_t WS_Q = 160 * MiB, WS_K = 232 * MiB, WS_VT = 256 * MiB, WS_O = 280 * MiB;
constexpr size_t WS_SSP = 420 * MiB;
constexpr size_t WS_END = 440 * MiB;

constexpr int LDS_RSTD = 131072;
constexpr int LDS_ROPE = 139264;
constexpr int LDS_GAIN = 147456;
constexpr int LDS_BYTES = 163840;
__device__ __forceinline__ float row_ss(const float* ssp, int row) {
    const f32x4* q = (const f32x4*)(ssp + (size_t)row * 16);
    const f32x4 a = q[0], b = q[1], c = q[2], d = q[3];
    return ((a[0] + a[1]) + (a[2] + a[3])) + ((b[0] + b[1]) + (b[2] + b[3])) + (((c[0] + c[1]) + (c[2] + c[3])) + ((d[0] + d[1]) + (d[2] + d[3])));
}
__device__ __forceinline__ int perm_key(int i) { return (i & ~12) | ((i & 4) << 1) | ((i & 8) >> 1); }

template <int KIND> struct EpiQKV {
    static constexpr bool PERM = true, AFTER_DRAIN = false;
    unsigned char* ws; PG8_LAS unsigned char* lds; int ja; mutable int cnt;
    __device__ __forceinline__ void operator()(const f32x4 (&acc)[2][2][4][2], const Unit& u, int wr, int wc, int fr, int fq) const {
        asm volatile("" : "+v"(fr), "+v"(fq));
        asm volatile("" : "+s"(wr), "+s"(wc));
        constexpr int NQH = (KIND == 1) ? 18 : 16, NKH = (KIND == 1) ? 6 : 4;
        const int hcol = 4 * u.pn + wc;
        int type, hh;
        if (hcol < NQH) { type = 0; hh = hcol; } else if (hcol < NQH + NKH) { type = 1; hh = hcol - NQH; } else if (hcol < NQH + 2 * NKH) { type = 2; hh = hcol - NQH - NKH; } else { ++cnt; return; }
        const PG8_LAS float* ss = (const PG8_LAS float*)(lds + LDS_RSTD) + 256 * cnt;
        ++cnt;
        const PG8_LAS f32x4* rope = (const PG8_LAS f32x4*)(lds + LDS_ROPE);
        float gn[2][8];
        if (KIND == 0) {
            const PG8_LAS float* gsrc = (const PG8_LAS float*)(lds + LDS_GAIN) + ja * 128 + ((type == 0) ? 0 : 64);
            if (type < 2) {
#pragma unroll
                for (int bj = 0; bj < 2; ++bj)
#pragma unroll
                    for (int n = 0; n < 2; ++n)
#pragma unroll
                        for (int j = 0; j < 4; ++j) gn[bj][n * 4 + j] = gsrc[32 * bj + 16 * n + 4 * fq + j];
            }
        }
        int hin = hh, g = 0;
        if (KIND == 1) { if (type == 0) { g = hh / 6; hin = hh - 6 * g; } else { g = hh >> 1; hin = hh & 1; } }
        if (KIND == 1 && g == 1) body<2>(acc, u, wr, wc, fr, fq, type, hin, g, ss, rope, gn);
        else if (KIND == 1 && g == 2) body<4>(acc, u, wr, wc, fr, fq, type, hin, g, ss, rope, gn);
        else body<0>(acc, u, wr, wc, fr, fq, type, hin, g, ss, rope, gn);
    }
    template <int gsh> __device__ __forceinline__ void body(const f32x4 (&acc)[2][2][4][2], const Unit& u, int wr, int wc, int fr, int fq, int type, int hin, int g, const PG8_LAS float* ss, const PG8_LAS f32x4* rope, const float (&gn)[2][8]) const {
#pragma unroll
        for (int ai = 0; ai < 2; ++ai)
#pragma unroll
            for (int m = 0; m < 4; ++m) {
                int frl = fr; asm volatile("" : "+v"(frl));
                const int row = u.pm * BM + ai * HALF + wr * 64 + m * 16 + frl;
                const int b = row >> 12, t = row & (SEQ - 1);
                const float rstd = ss[ai * HALF + wr * 64 + m * 16 + frl];
                float v[2][8];
#pragma unroll
                for (int bj = 0; bj < 2; ++bj)
#pragma unroll
                    for (int n = 0; n < 2; ++n)
#pragma unroll
                        for (int j = 0; j < 4; ++j) v[bj][n * 4 + j] = acc[ai][bj][m][n][j] * rstd;
                if (KIND == 0 && type < 2) {
                    float s2 = 0.f;
#pragma unroll
                    for (int bj = 0; bj < 2; ++bj)
#pragma unroll
                        for (int e = 0; e < 8; ++e) s2 += v[bj][e] * v[bj][e];
                    s2 += __shfl_xor(s2, 16); s2 += __shfl_xor(s2, 32);
                    const float r = __builtin_amdgcn_rsqf(s2 * (1.0f / 64.0f) + RMS_EPS);
#pragma unroll
                    for (int bj = 0; bj < 2; ++bj)
#pragma unroll
                        for (int e = 0; e < 8; ++e) v[bj][e] *= r * gn[bj][e];
#pragma unroll
                    for (int bj = 0; bj < 2; ++bj) {
                        const int pos = (bj == 0) ? (t >> 6) : (t & 63);
                        const f32x4 cs0 = rope[(pos * 16 + 4 * fq) >> 1], cs1 = rope[((pos * 16 + 4 * fq) >> 1) + 1];
                        const float cc[4] = {cs0[0], cs0[2], cs1[0], cs1[2]}, sn[4] = {cs0[1], cs0[3], cs1[1], cs1[3]};
#pragma unroll
                        for (int j = 0; j < 4; ++j) {
                            const float x1 = v[bj][j], x2 = v[bj][4 + j];
                            v[bj][j] = x1 * cc[j] - x2 * sn[j]; v[bj][4 + j] = x2 * cc[j] + x1 * sn[j];
                        }
                    }
                }
                if (type == 0) {
#pragma unroll
                    for (int bj = 0; bj < 2; ++bj)
#pragma unroll
                        for (int e = 0; e < 8; ++e) v[bj][e] *= QSCALE;
                }
                const int dmask = (1 << gsh) - 1;
                const int vb = (b << gsh) + (t & dmask), idx = t >> gsh, lsh = 12 - gsh;
                if (type < 2) {
                    const int nh = (type == 0) ? ((KIND == 1) ? 6 : 16) : ((KIND == 1) ? 2 : 4);
                    unsigned char* base = ws + ((type == 0) ? WS_Q : WS_K) + ((KIND == 1) ? (size_t)g * ((size_t)NBATCH * nh * SEQ * 128) : 0);
                    unsigned off = ((unsigned)(((vb * nh + hin) << lsh) + idx) * 64u + 8u * fq) * 2u; unsigned bjstep = 64u;
                    if (KIND != 0 && type == 1) {
                        off = (unsigned)((vb * nh + hin) << lsh) * 128u + ((unsigned)(idx >> 5) * 4u + (fq >> 1)) * 1024u + ((fq & 1) * 32u + (idx & 31)) * 16u; bjstep = 2048u;
                    }
#pragma unroll
                    for (int bj = 0; bj < 2; ++bj) {
                        u32x4 w; w.x = cvt_pk_bf16(v[bj][0], v[bj][1]); w.y = cvt_pk_bf16(v[bj][2], v[bj][3]); w.z = cvt_pk_bf16(v[bj][4], v[bj][5]); w.w = cvt_pk_bf16(v[bj][6], v[bj][7]);
                        *(u32x4*)(base + off + bjstep * bj) = w;
                    }
                } else {
                    const int nh = (KIND == 1) ? 2 : 4;
                    unsigned char* base = ws + WS_VT + ((KIND == 1) ? (size_t)g * ((size_t)NBATCH * nh * SEQ * 128) : 0);
                    unsigned off = ((unsigned)((((vb * nh + hin) * 64 + 8 * fq) << lsh) + perm_key(idx))) * 2u;
                    unsigned dstep = 2u << lsh, bjskip = 24u * dstep;
                    if (KIND != 0) {
                        const unsigned pk_ = (unsigned)perm_key(idx), ks = pk_ & 63u, c8 = ks >> 3;
                        off = (unsigned)(((vb * nh + hin) * 64) << lsh) * 2u + (((pk_ >> 6) * 2u) * 4u + (c8 >> 1)) * 1024u + (c8 & 1u) * 512u + (8u * fq) * 16u + (ks & 7u) * 2u;
                        dstep = 16u; bjskip = 4096u - 8u * 16u;
                    }
#pragma unroll
                    for (int bj = 0; bj < 2; ++bj) {
#pragma unroll
                        for (int e = 0; e < 8; ++e) {
                            const unsigned pk = cvt_pk_bf16(v[bj][e], 0.f);
                            *(bf16_t*)(base + off) = (bf16_t)(pk & 0xffffu);
                            off += dstep;
                        }
                        off += bjskip;
                    }
                }
                __builtin_amdgcn_sched_barrier(0);
            }
    }
};

struct EpiRes {
    static constexpr bool PERM = true, AFTER_DRAIN = false;
    bf16_t* hb; float* ssout;
    __device__ __forceinline__ void operator()(const f32x4 (&acc)[2][2][4][2], const Unit& u, int wr, int wc, int fr, int fq) const {
        asm volatile("" : "+v"(fr), "+v"(fq));
        const unsigned o0 = (unsigned)((u.pm * BM + wr * 64 + fr) * DM + u.pn * BM + wc * 32 + 8 * fq);
        u32x4 hv[2][2];
#pragma unroll
        for (int bj = 0; bj < 2; ++bj) hv[0][bj] = *(const u32x4*)((const char*)hb + (o0 + bj * HALF) * 2u);
#pragma unroll
        for (int it = 0; it < 8; ++it) {
            const int ai = it >> 2, m = it & 3, cur = it & 1, nxt = cur ^ 1;
            if (it + 1 < 8) {
                const int ai2 = (it + 1) >> 2, m2 = (it + 1) & 3;
                const unsigned o2 = o0 + (unsigned)((ai2 * HALF + m2 * 16) * DM);
#pragma unroll
                for (int bj = 0; bj < 2; ++bj) hv[nxt][bj] = *(const u32x4*)((const char*)hb + (o2 + bj * HALF) * 2u);
            }
            const unsigned o1 = o0 + (unsigned)((ai * HALF + m * 16) * DM);
            float q = 0.f;
#pragma unroll
            for (int bj = 0; bj < 2; ++bj) {
                const unsigned o = o1 + bj * HALF;
                const u32x4 hw = hv[cur][bj];
                f32x4 v0, v1;
                v0[0] = __builtin_bit_cast(float, hw.x << 16); v0[1] = __builtin_bit_cast(float, hw.x & 0xffff0000u); v0[2] = __builtin_bit_cast(float, hw.y << 16); v0[3] = __builtin_bit_cast(float, hw.y & 0xffff0000u);
                v1[0] = __builtin_bit_cast(float, hw.z << 16); v1[1] = __builtin_bit_cast(float, hw.z & 0xffff0000u); v1[2] = __builtin_bit_cast(float, hw.w << 16); v1[3] = __builtin_bit_cast(float, hw.w & 0xffff0000u);
                v0 = v0 + acc[ai][bj][m][0]; v1 = v1 + acc[ai][bj][m][1];
                u32x4 w; w.x = cvt_pk_bf16(v0[0], v0[1]); w.y = cvt_pk_bf16(v0[2], v0[3]); w.z = cvt_pk_bf16(v1[0], v1[1]); w.w = cvt_pk_bf16(v1[2], v1[3]);
                *(u32x4*)((char*)hb + o * 2u) = w;
                q += (v0[0] * v0[0] + v0[1] * v0[1]) + (v0[2] * v0[2] + v0[3] * v0[3]) + (v1[0] * v1[0] + v1[1] * v1[1]) + (v1[2] * v1[2] + v1[3] * v1[3]);
            }
            q += __shfl_xor(q, 16); q += __shfl_xor(q, 32);
            const int row = u.pm * BM + ai * HALF + wr * 64 + m * 16 + fr;
            if (fq == 0) ssout[(size_t)row * 16 + u.pn * 4 + wc] = q;
        }
    }
};

struct EpiMlp1 {
    static constexpr bool PERM = true, AFTER_DRAIN = false;
    PG8_LAS unsigned char* lds; bf16_t* U; mutable int cnt;
    __device__ __forceinline__ void operator()(const f32x4 (&acc)[2][2][4][2], const Unit& u, int wr, int wc, int fr, int fq) const {
        const PG8_LAS float* ss = (const PG8_LAS float*)(lds + LDS_RSTD) + 256 * cnt;
        ++cnt;
#pragma unroll
        for (int ai = 0; ai < 2; ++ai)
#pragma unroll
            for (int m = 0; m < 4; ++m) {
                const int row = u.pm * BM + ai * HALF + wr * 64 + m * 16 + fr;
                const float rstd = ss[ai * HALF + wr * 64 + m * 16 + fr];
#pragma unroll
                for (int bj = 0; bj < 2; ++bj) {
                    f32x4 v0 = acc[ai][bj][m][0] * rstd, v1 = acc[ai][bj][m][1] * rstd;
#pragma unroll
                    for (int j = 0; j < 4; ++j) { const float a = fmaxf(v0[j], 0.f), c = fmaxf(v1[j], 0.f); v0[j] = a * a; v1[j] = c * c; }
                    u32x4 w; w.x = cvt_pk_bf16(v0[0], v0[1]); w.y = cvt_pk_bf16(v0[2], v0[3]); w.z = cvt_pk_bf16(v1[0], v1[1]); w.w = cvt_pk_bf16(v1[2], v1[3]);
                    *(u32x4*)((char*)U + (unsigned)(row * DFF + u.pn * BM + bj * HALF + wc * 32 + 8 * fq) * 2u) = w;
                }
            }
    }
};
template <class Epi, class Sched, bool ALIGN_EPI = false, bool SP2 = false>
__device__ __forceinline__ void gemm_phase(PG8_LAS unsigned char* lds, const Gemm g, const Sched& S, const Epi& E) {
    int tid_ = threadIdx.x; asm volatile("" : "+v"(tid_));
    const int tid = tid_, wid = __builtin_amdgcn_readfirstlane(tid >> 6), lane = tid & 63, wr = wid >> 2, wc = wid & 3, fr = lane & 15, fq = lane >> 4;
    const int K = g.K, nt = K / BK;
    unsigned voffA[2], voffB[2];
#pragma unroll
    for (int i = 0; i < 2; ++i) { int R, C; stage_rc(tid * 16 + i * 8192, R, C); const int Rb = Epi::PERM ? ((R & ~31) + perm32(R & 31)) : R;
        voffA[i] = (unsigned)(R * K + C) * 2u; voffB[i] = (unsigned)(Rb * K + C) * 2u; }
    const size_t kstep = (size_t)(BK * 2);
    const size_t hstep = (size_t)HALF * K * 2;
    const size_t tstep = 2 * hstep;
    const unsigned ldsw = (unsigned)wid * 1024u;
    const int aoff = lds_byte(wr * 64 + fr, fq * 8), boff = lds_byte(wc * 32 + fr, fq * 8);
#define PG8_SA(b, h) (((b) * 2 + (h)) * HTB)
#define PG8_SB(b, h) ((4 + (b) * 2 + (h)) * HTB)
#define PG8_STAGE(bufoff, gbase, voff) do { _Pragma("unroll") for (int _i = 0; _i < 2; ++_i) \
        __builtin_amdgcn_global_load_lds((const unsigned*)((const char*)(gbase) + (voff)[_i]), (PG8_LAS unsigned*)(lds + (bufoff) + ldsw + _i * 8192), 16, 0, 0); } while (0)
#define PG8_LDA(dst, b, h) do { _Pragma("unroll") for (int m = 0; m < 4; ++m) _Pragma("unroll") for (int k = 0; k < 2; ++k) dst[m][k] = *(const PG8_LAS bf16x8*)(lds + PG8_SA(b, h) + aoff + m * 2048 + k * 1024); } while (0)
#define PG8_LDB(dst, b, h) do { _Pragma("unroll") for (int n = 0; n < 2; ++n) _Pragma("unroll") for (int k = 0; k < 2; ++k) dst[n][k] = *(const PG8_LAS bf16x8*)(lds + PG8_SB(b, h) + boff + n * 2048 + k * 1024); } while (0)
#define PG8_MMA(ai, bj, At, Bt) do { __builtin_amdgcn_s_setprio(1); _Pragma("unroll") for (int m = 0; m < 4; ++m) _Pragma("unroll") for (int n = 0; n < 2; ++n) _Pragma("unroll") for (int k = 0; k < 2; ++k) \
        acc[ai][bj][m][n] = __builtin_amdgcn_mfma_f32_16x16x32_bf16(Bt[n][k], At[m][k], acc[ai][bj][m][n], 0, 0, 0); __builtin_amdgcn_s_setprio(0); } while (0)
#define PG8_WAIT_V(n) asm volatile("s_waitcnt vmcnt(" #n ")" ::: "memory")
#define PG8_WAIT_L(n) asm volatile("s_waitcnt lgkmcnt(" #n ")" ::: "memory")
#define PG8_BAR __builtin_amdgcn_s_barrier()
#define PG8_SCHED __builtin_amdgcn_sched_barrier(0)
    Unit cur, nxt; int ui = 0;
    if (!S.next(0, cur)) return;
    f32x4 acc[2][2][4][2];
#pragma unroll
    for (int a = 0; a < 2; ++a)
#pragma unroll
        for (int b = 0; b < 2; ++b)
#pragma unroll
            for (int m = 0; m < 4; ++m)
#pragma unroll
                for (int n = 0; n < 2; ++n) acc[a][b][m][n] = (f32x4){0.f, 0.f, 0.f, 0.f};
    bf16x8 At[4][2], B0[2][2], B1[2][2];
    const char* cA = (const char*)g.A + (size_t)cur.pm * tstep; const char* cB = (const char*)g.Bt + (size_t)cur.pn * tstep;
    S.a_ready(cur);
    if constexpr (SP2) {
        PG8_STAGE(PG8_SB(0, 0), cB, voffB); PG8_STAGE(PG8_SB(0, 1), cB + hstep, voffB); PG8_STAGE(PG8_SA(0, 0), cA, voffA); PG8_STAGE(PG8_SA(0, 1), cA + hstep, voffA);
        if (wr == 1) PG8_BAR;
        PG8_WAIT_V(2); PG8_BAR;
        PG8_STAGE(PG8_SB(1, 0), cB + kstep, voffB); PG8_STAGE(PG8_SA(1, 0), cA + kstep, voffA); PG8_STAGE(PG8_SB(1, 1), cB + hstep + kstep, voffB);
        PG8_WAIT_V(6); PG8_BAR;
    } else {
        PG8_STAGE(PG8_SB(0, 0), cB, voffB); PG8_STAGE(PG8_SA(0, 0), cA, voffA); PG8_STAGE(PG8_SB(0, 1), cB + hstep, voffB); PG8_STAGE(PG8_SA(0, 1), cA + hstep, voffA);
        if (wr == 1) PG8_BAR;
        PG8_WAIT_V(4); PG8_BAR;
        PG8_STAGE(PG8_SB(1, 0), cB + kstep, voffB); PG8_STAGE(PG8_SA(1, 0), cA + kstep, voffA); PG8_STAGE(PG8_SB(1, 1), cB + hstep + kstep, voffB);
        PG8_WAIT_V(6); PG8_BAR;
    }
    for (;;) {
        const bool has_next = S.next(ui + 1, nxt);
        const char* nA = has_next ? (const char*)g.A + (size_t)nxt.pm * tstep : cA; const char* nB = has_next ? (const char*)g.Bt + (size_t)nxt.pn * tstep : cB;
        for (int t = 0; t < nt; t += 2) {
            const bool last = (t == nt - 2);
            const char* a1 = cA + (size_t)(t + 1) * kstep;
            const char* a2 = last ? nA : cA + (size_t)(t + 2) * kstep; const char* b2 = last ? nB : cB + (size_t)(t + 2) * kstep;
            const char* a3 = a2 + kstep; const char* b3 = b2 + kstep;
            if (last && has_next) S.a_ready(nxt);
            if constexpr (SP2) {
            PG8_LDB(B0, 0, 0); PG8_LDB(B1, 0, 1); PG8_SCHED; PG8_LDA(At, 0, 0); PG8_STAGE(PG8_SA(1, 1), a1 + hstep, voffA);
            PG8_WAIT_V(8); PG8_WAIT_L(0); PG8_BAR; PG8_MMA(0, 0, At, B0); PG8_MMA(0, 1, At, B1); PG8_BAR; PG8_SCHED;
            PG8_LDA(At, 0, 1); PG8_STAGE(PG8_SB(0, 0), b2, voffB); PG8_STAGE(PG8_SB(0, 1), b2 + hstep, voffB); PG8_STAGE(PG8_SA(0, 0), a2, voffA);
            PG8_WAIT_V(8); PG8_WAIT_L(0); PG8_BAR; PG8_MMA(1, 0, At, B0); PG8_MMA(1, 1, At, B1); PG8_BAR; PG8_SCHED;
            PG8_LDB(B0, 1, 0); PG8_LDB(B1, 1, 1); PG8_SCHED; PG8_LDA(At, 1, 0); PG8_STAGE(PG8_SA(0, 1), a2 + hstep, voffA);
            PG8_WAIT_V(8); PG8_WAIT_L(0); PG8_BAR; PG8_MMA(0, 0, At, B0); PG8_MMA(0, 1, At, B1); PG8_BAR; PG8_SCHED;
            PG8_LDA(At, 1, 1); PG8_STAGE(PG8_SB(1, 0), b3, voffB); PG8_STAGE(PG8_SB(1, 1), b3 + hstep, voffB); PG8_STAGE(PG8_SA(1, 0), a3, voffA);
            PG8_WAIT_V(8); PG8_WAIT_L(0); PG8_BAR; PG8_MMA(1, 0, At, B0); PG8_MMA(1, 1, At, B1); PG8_BAR; PG8_SCHED;
            } else {
            PG8_LDB(B0, 0, 0); PG8_SCHED; PG8_LDA(At, 0, 0); PG8_STAGE(PG8_SA(1, 1), a1 + hstep, voffA);
            PG8_WAIT_L(8); PG8_BAR; PG8_WAIT_L(0); PG8_MMA(0, 0, At, B0); PG8_BAR; PG8_SCHED;
            PG8_LDB(B1, 0, 1); PG8_STAGE(PG8_SB(0, 0), b2, voffB);
            PG8_BAR; PG8_WAIT_L(0); PG8_MMA(0, 1, At, B1); PG8_BAR;
            PG8_LDA(At, 0, 1); PG8_STAGE(PG8_SA(0, 0), a2, voffA);
            PG8_BAR; PG8_WAIT_L(0); PG8_MMA(1, 0, At, B0); PG8_BAR; PG8_SCHED;
            PG8_STAGE(PG8_SB(0, 1), b2 + hstep, voffB);
            PG8_WAIT_V(6); PG8_BAR; PG8_MMA(1, 1, At, B1); PG8_BAR;
            PG8_LDB(B0, 1, 0); PG8_SCHED; PG8_LDA(At, 1, 0); PG8_STAGE(PG8_SA(0, 1), a2 + hstep, voffA);
            PG8_WAIT_L(8); PG8_BAR; PG8_WAIT_L(0); PG8_MMA(0, 0, At, B0); PG8_BAR; PG8_SCHED;
            PG8_LDB(B1, 1, 1); PG8_STAGE(PG8_SB(1, 0), b3, voffB);
            PG8_BAR; PG8_WAIT_L(0); PG8_MMA(0, 1, At, B1); PG8_BAR;
            PG8_LDA(At, 1, 1); PG8_STAGE(PG8_SA(1, 0), a3, voffA);
            PG8_BAR; PG8_WAIT_L(0); PG8_MMA(1, 0, At, B0); PG8_BAR; PG8_SCHED;
            PG8_STAGE(PG8_SB(1, 1), b3 + hstep, voffB);
            PG8_WAIT_V(6); PG8_BAR; PG8_MMA(1, 1, At, B1); PG8_BAR;
            }
        }
        if constexpr (ALIGN_EPI) { if (wr == 0) PG8_BAR; }
        if constexpr (!Epi::AFTER_DRAIN) { E(acc, cur, wr, wc, fr, fq); S.done(cur); }
        if (!has_next) break;
#pragma unroll
        for (int a = 0; a < 2; ++a)
#pragma unroll
            for (int b = 0; b < 2; ++b)
#pragma unroll
                for (int m = 0; m < 4; ++m)
#pragma unroll
                    for (int n = 0; n < 2; ++n) acc[a][b][m][n] = (f32x4){0.f, 0.f, 0.f, 0.f};
        cur = nxt; cA = nA; cB = nB; ++ui;
        if constexpr (ALIGN_EPI) { if (wr == 1) PG8_BAR; }
    }
    PG8_WAIT_V(0);
    if constexpr (!ALIGN_EPI) { if (wr == 0) PG8_BAR; }
    PG8_BAR;
    if constexpr (Epi::AFTER_DRAIN) { E.fused(acc, cur, wr, wc, fr, fq, lds, wid, lane); S.done(cur); }
#undef PG8_SA
#undef PG8_SB
#undef PG8_STAGE
#undef PG8_LDA
#undef PG8_LDB
#undef PG8_MMA
#undef PG8_WAIT_V
#undef PG8_WAIT_L
#undef PG8_BAR
#undef PG8_SCHED
}
}
using namespace pg8;
using pg8::bf16_t; using pg8::bf16x8; using pg8::f32x4; using pg8::u32x4; using pg8::cvt_pk_bf16;
#define LAS __attribute__((address_space(3)))
typedef float f32x16 __attribute__((ext_vector_type(16)));
typedef unsigned u32x2 __attribute__((ext_vector_type(2)));
#define LDS_WAIT() asm volatile("s_waitcnt lgkmcnt(0)" ::: "memory")
typedef float f32x2_t __attribute__((ext_vector_type(2)));
typedef __bf16 bf16x2_t __attribute__((ext_vector_type(2)));
__device__ __forceinline__ unsigned cvtpk_s(float lo, float hi) { f32x2_t v = {lo, hi}; bf16x2_t b = __builtin_convertvector(v, bf16x2_t); return __builtin_bit_cast(unsigned, b); }

constexpr size_t WE_QKV0 = 0, WE_QKV1 = WE_QKV0 + 1536 * 1024, WE_QKV2 = WE_QKV1 + 2048 * 1024, WE_QKV3 = WE_QKV2 + 1536 * 1024;
constexpr size_t WE_WO0 = WE_QKV3 + 1536 * 1024, WE_WO1 = WE_WO0 + 1024 * 1024, WE_WO2 = WE_WO1 + 1024 * 1152, WE_WO3 = WE_WO2 + 1024 * 1024;
constexpr size_t WE_W1 = WE_WO3 + 1024 * 1024, WE_W2 = WE_W1 + 4 * (size_t)4096 * 1024, WE_END = WE_W2 + 4 * (size_t)4096 * 1024;
static_assert(WS_W + WE_END * 2 <= WS_HB, "weights fit");

struct Params { const float* in[15]; float* out; unsigned char* ws; };

__device__ __forceinline__ float wave_sum(float v) {
#pragma unroll
    for (int o = 1; o < 64; o <<= 1) v += __shfl_xor(v, o);
    return v;
}

__device__ __forceinline__ void tr_item(const float* __restrict__ W, int K, int N, int Npad, bf16_t* WT, const float* __restrict__ gain, int mode, int nheads, int nperm, LAS float* scr, int item, int lane) {
    const int nblk = Npad >> 5, kb = item / nblk, nb = item - kb * nblk, k0 = 64 * kb, R0 = 32 * nb;
    int src0 = R0; bool valid = true, perm = false;
    if (mode == 1) { const int pn = R0 >> 8, c = R0 & 255, bj = c >> 7, wc = (c >> 5) & 3, hcol = 4 * pn + wc; valid = hcol < nheads; perm = hcol < nperm; src0 = hcol * 64 + 32 * bj; }
#pragma unroll 8
    for (int i = 0; i < 32; ++i) {
        const int kk = 2 * i + (lane >> 5);
        float w = 0.f;
        if (valid) { w = W[(size_t)(k0 + kk) * N + src0 + (lane & 31)]; if (gain) w *= gain[k0 + kk]; }
        scr[kk * 33 + (lane & 31)] = w;
    }
    LDS_WAIT();
    const int c8 = lane & 7;
#pragma unroll
    for (int jj = 0; jj < 4; ++jj) {
        const int e = (lane >> 3) + 8 * jj;
        const int se = perm ? (16 * ((e >> 2) & 1) + 4 * (e >> 3) + (e & 3)) : e;
        const LAS float* s = scr + (8 * c8) * 33 + se;
        u32x4 o; o.x = cvt_pk_bf16(s[0 * 33], s[1 * 33]); o.y = cvt_pk_bf16(s[2 * 33], s[3 * 33]); o.z = cvt_pk_bf16(s[4 * 33], s[5 * 33]); o.w = cvt_pk_bf16(s[6 * 33], s[7 * 33]);
        *(u32x4*)(WT + (size_t)(R0 + e) * K + k0 + 8 * c8) = o;
    }
    LDS_WAIT();
}

__device__ __forceinline__ void prologue(const Params& p, LAS unsigned char* lds, int gw, int NGW, int wave, int lane) {
    float* ss = (float*)(p.ws + WS_SSP);
    bf16_t* WB = (bf16_t*)(p.ws + WS_W);
    LAS float* scr = (LAS float*)(lds + wave * 16384);
    const float* attn_norm = p.in[1]; const float* mlp_norm = p.in[2];
    constexpr int I_QA = 16 * (1536 / 32), I_QB = 16 * (2048 / 32), I_WO = 16 * 32, I_WOB = 18 * 32, I_W1 = 16 * 128, I_W2 = 64 * 32;
    constexpr int NITEMS = 3 * I_QA + I_QB + 3 * I_WO + I_WOB + 4 * I_W1 + 4 * I_W2;
    for (int it = gw; it < NITEMS; it += NGW) {
        int r = it;
        if (r < I_QA) { tr_item(p.in[3], 1024, 1536, 1536, WB + WE_QKV0, attn_norm + 0 * DM, 1, 24, 20, scr, r, lane); continue; } r -= I_QA;
        if (r < I_QB) { tr_item(p.in[7], 1024, 1920, 2048, WB + WE_QKV1, attn_norm + 1 * DM, 1, 30, 0, scr, r, lane); continue; } r -= I_QB;
        if (r < I_QA) { tr_item(p.in[9], 1024, 1536, 1536, WB + WE_QKV2, attn_norm + 2 * DM, 1, 24, 0, scr, r, lane); continue; } r -= I_QA;
        if (r < I_QA) { tr_item(p.in[3] + (size_t)1024 * 1536, 1024, 1536, 1536, WB + WE_QKV3, attn_norm + 3 * DM, 1, 24, 20, scr, r, lane); continue; } r -= I_QA;
        if (r < I_WO) { tr_item(p.in[6], 1024, 1024, 1024, WB + WE_WO0, nullptr, 0, 0, 0, scr, r, lane); continue; } r -= I_WO;
        if (r < I_WOB) { tr_item(p.in[8], 1152, 1024, 1024, WB + WE_WO1, nullptr, 0, 0, 0, scr, r, lane); continue; } r -= I_WOB;
        if (r < I_WO) { tr_item(p.in[11], 1024, 1024, 1024, WB + WE_WO2, nullptr, 0, 0, 0, scr, r, lane); continue; } r -= I_WO;
        if (r < I_WO) { tr_item(p.in[6] + (size_t)1024 * 1024, 1024, 1024, 1024, WB + WE_WO3, nullptr, 0, 0, 0, scr, r, lane); continue; } r -= I_WO;
        if (r < 4 * I_W1) { const int l = r / I_W1; tr_item(p.in[12] + (size_t)l * 1024 * 4096, 1024, 4096, 4096, WB + WE_W1 + (size_t)l * 4096 * 1024, mlp_norm + l * DM, 0, 0, 0, scr, r - l * I_W1, lane); continue; } r -= 4 * I_W1;
        { const int l = r / I_W2; tr_item(p.in[13] + (size_t)l * 4096 * 1024, 4096, 1024, 1024, WB + WE_W2 + (size_t)l * 4096 * 1024, nullptr, 0, 0, 0, scr, r - l * I_W2, lane); }
    }
    const float* x = p.in[0]; bf16_t* hb = (bf16_t*)(p.ws + WS_HB);
    for (int m = gw; m < MTOK; m += NGW) {
        const f32x4* xr = (const f32x4*)(x + (size_t)m * DM) + lane;
        f32x4 v[4]; float s = 0.f;
#pragma unroll
        for (int j = 0; j < 4; ++j) { v[j] = xr[64 * j]; s += (v[j].x * v[j].x + v[j].y * v[j].y) + (v[j].z * v[j].z + v[j].w * v[j].w); }
        s = wave_sum(s);
        u32x2* o8 = (u32x2*)(hb + (size_t)m * DM) + lane;
#pragma unroll
        for (int j = 0; j < 4; ++j) { u32x2 w; w.x = cvt_pk_bf16(v[j].x, v[j].y); w.y = cvt_pk_bf16(v[j].z, v[j].w); o8[64 * j] = w; }
        if (lane < 16) ss[(size_t)m * 16 + lane] = (lane == 0) ? s : 0.f;
    }
}

constexpr int AT_ROWB = 144, AT_TILEB = 64 * AT_ROWB, AT_BUFB = 2 * AT_TILEB;
template <int MODE> __device__ __forceinline__ void attn_phase(LAS unsigned char* lds, const bf16_t* __restrict__ Qg, const bf16_t* __restrict__ Kg, const bf16_t* __restrict__ Vg, bf16_t* Og, float* LSE, const float* __restrict__ sinks) {
    int tid_ = threadIdx.x; asm volatile("" : "+v"(tid_));
    const int tid = tid_, lane = tid & 63, wave = __builtin_amdgcn_readfirstlane(tid >> 6), r32 = lane & 31, hi = lane >> 5;
    constexpr int NQ = (MODE == 0) ? 2 : 1;
    constexpr int QU = 256 * NQ;
    constexpr int NUNITS = (MODE == 1) ? 3 * 768 : 2048 / NQ;
    constexpr int HQ = (MODE == 1) ? 6 : 16, HKV = (MODE == 1) ? 2 : 4, WIN = (MODE == 1) ? 64 : 128, OPITCH = (MODE == 1) ? 1152 : 1024;
    const int srow = tid >> 3, schunk = tid & 7;
    const unsigned sdst = (unsigned)(srow * AT_ROWB + schunk * 16);
    for (int un = blockIdx.x; un < NUNITS; un += gridDim.x) {
        int g = 0, vb, hq, qb;
        if (MODE == 1) { g = un / 768; const int r = un - g * 768; const int nqbs = 4 - 2 * g;   qb = r & ((1 << nqbs) - 1); const int r2 = r >> nqbs; hq = r2 % 6; vb = r2 / 6; }
        else if (MODE == 0) { qb = un & 7; hq = (un >> 3) & 15; vb = un >> 7; }
        else { qb = un & 15; hq = (un >> 4) & 15; vb = un >> 8; }
        const int gsh = 2 * g, lsh = 12 - gsh, L = 1 << lsh;
        const int kvh = (MODE == 1) ? hq / 3 : hq >> 2;
        const int q0 = qb * QU, qw = q0 + 32 * NQ * wave;
        const size_t gq = (MODE == 1) ? (size_t)g * ((size_t)NBATCH * 6 * SEQ * 64) : 0, gk = (MODE == 1) ? (size_t)g * ((size_t)NBATCH * 2 * SEQ * 64) : 0;
        bf16x8 qf[NQ][4];
#pragma unroll
        for (int j = 0; j < NQ; ++j) {
            const bf16_t* qp = Qg + gq + ((((size_t)(vb * HQ + hq)) << lsh) + qw + 32 * j + r32) * 64 + 8 * hi;
#pragma unroll
            for (int s = 0; s < 4; ++s) qf[j][s] = *(const bf16x8*)(qp + 16 * s);
        }
        const bf16_t* kbase = Kg + gk + (((size_t)(vb * HKV + kvh)) << lsh) * 64;
        const bf16_t* vbase = Vg + gk + ((((size_t)(vb * HKV + kvh)) * 64) << lsh);
        int lo = 0, hiT = L >> 6;
        if (MODE != 0) { lo = (q0 - WIN) >> 6; if (lo < 0) lo = 0; int h2 = ((q0 + 255 + WIN) >> 6) + 1; if (h2 < hiT) hiT = h2; }
        float slope2 = 0.f;
        if (MODE == 1) slope2 = exp2f(-8.0f * (float)(g * 6 + hq + 1) / 18.0f) * (float)(1 << gsh) * LOG2E;
        if (MODE == 2) slope2 = exp2f(-8.0f * (float)(hq + 1) / 16.0f) * LOG2E;
        float mrun[NQ], lrun[NQ];
        f32x16 oacc[NQ][2];
#pragma unroll
        for (int j = 0; j < NQ; ++j) {
            mrun[j] = NEG_BIG; lrun[j] = 0.f;
            if (MODE == 2) { mrun[j] = sinks[hq] * LOG2E; lrun[j] = (hi == 0) ? 1.f : 0.f; }
#pragma unroll
            for (int i = 0; i < 16; ++i) { oacc[j][0][i] = 0.f; oacc[j][1][i] = 0.f; }
        }
        u32x4 kreg, vreg;
        kreg = *(const u32x4*)(kbase + (size_t)lo * 4096 + tid * 8);
        vreg = *(const u32x4*)(vbase + ((size_t)srow << lsh) + lo * 64 + schunk * 8);
        *(LAS u32x4*)(lds + sdst) = kreg; *(LAS u32x4*)(lds + AT_TILEB + sdst) = vreg;
        __syncthreads();
        for (int kt = lo; kt < hiT; ++kt) {
            const int buf = (kt - lo) & 1;
            const bool more = (kt + 1 < hiT);
            if (more) {
                kreg = *(const u32x4*)(kbase + (size_t)(kt + 1) * 4096 + tid * 8);
                vreg = *(const u32x4*)(vbase + ((size_t)srow << lsh) + (kt + 1) * 64 + schunk * 8);
            }
            bool active = true;
            if (MODE != 0) active = !((64 * kt + 63 < qw - WIN) || (64 * kt > qw + 31 + WIN));
            if (active) {
                const LAS unsigned char* kl = lds + buf * AT_BUFB;
                const LAS unsigned char* vl = kl + AT_TILEB;
                f32x16 sacc[NQ][2];
#pragma unroll
                for (int kb = 0; kb < 2; ++kb) {
#pragma unroll
                    for (int j = 0; j < NQ; ++j)
#pragma unroll
                        for (int i = 0; i < 16; ++i) sacc[j][kb][i] = 0.f;
#pragma unroll
                    for (int s = 0; s < 4; ++s) {
                        const bf16x8 kf = *(const LAS bf16x8*)(kl + (32 * kb + r32) * AT_ROWB + (2 * s + hi) * 16);
#pragma unroll
                        for (int j = 0; j < NQ; ++j) sacc[j][kb] = __builtin_amdgcn_mfma_f32_32x32x16_bf16(kf, qf[j][s], sacc[j][kb], 0, 0, 0);
                    }
                }
                bf16x8 pf[NQ][2][2];
#pragma unroll
                for (int j = 0; j < NQ; ++j) {
                    if (MODE != 0) {
                        const float fd0 = (float)(64 * kt + 4 * hi - (qw + r32));
#pragma unroll
                        for (int kb = 0; kb < 2; ++kb)
#pragma unroll
                            for (int i = 0; i < 16; ++i) {
                                const float dist = fabsf(fd0 + (float)(32 * kb + 8 * (i >> 2) + (i & 3)));
                                sacc[j][kb][i] = (dist <= (float)WIN) ? (sacc[j][kb][i] - slope2 * dist) : NEG_BIG;
                            }
                    }
                    float mx = sacc[j][0][0];
#pragma unroll
                    for (int i = 1; i < 16; ++i) mx = fmaxf(mx, sacc[j][0][i]);
#pragma unroll
                    for (int i = 0; i < 16; ++i) mx = fmaxf(mx, sacc[j][1][i]);
                    mx = fmaxf(mx, __shfl_xor(mx, 32));
                    if (__builtin_amdgcn_ballot_w64(mx > mrun[j]) != 0ull) {
                        const float mnew = fmaxf(mrun[j], mx);
                        const float alpha = __builtin_amdgcn_exp2f(mrun[j] - mnew);
                        mrun[j] = mnew;
                        lrun[j] *= alpha;
#pragma unroll
                        for (int i = 0; i < 16; ++i) { oacc[j][0][i] *= alpha; oacc[j][1][i] *= alpha; }
                    }
                    const float mcur = mrun[j];
                    float ps = 0.f;
#pragma unroll
                    for (int kb = 0; kb < 2; ++kb)
#pragma unroll
                        for (int i = 0; i < 16; ++i) { const float pv = __builtin_amdgcn_exp2f(sacc[j][kb][i] - mcur); sacc[j][kb][i] = pv; ps += pv; }
                    lrun[j] += ps;
#pragma unroll
                    for (int kb = 0; kb < 2; ++kb)
#pragma unroll
                        for (int hh = 0; hh < 2; ++hh) {
                            u32x4 w; w.x = cvtpk_s(sacc[j][kb][8 * hh + 0], sacc[j][kb][8 * hh + 1]); w.y = cvtpk_s(sacc[j][kb][8 * hh + 2], sacc[j][kb][8 * hh + 3]);
                            w.z = cvtpk_s(sacc[j][kb][8 * hh + 4], sacc[j][kb][8 * hh + 5]); w.w = cvtpk_s(sacc[j][kb][8 * hh + 6], sacc[j][kb][8 * hh + 7]);
                            pf[j][kb][hh] = __builtin_bit_cast(bf16x8, w);
                        }
                }
#pragma unroll
                for (int db = 0; db < 2; ++db)
#pragma unroll
                    for (int kb = 0; kb < 2; ++kb)
#pragma unroll
                        for (int hh = 0; hh < 2; ++hh) {
                            const bf16x8 vf = *(const LAS bf16x8*)(vl + (32 * db + r32) * AT_ROWB + (2 * (2 * kb + hh) + hi) * 16);
#pragma unroll
                            for (int j = 0; j < NQ; ++j) oacc[j][db] = __builtin_amdgcn_mfma_f32_32x32x16_bf16(vf, pf[j][kb][hh], oacc[j][db], 0, 0, 0);
                        }
            }
            if (more) {
                LAS unsigned char* nb = lds + (buf ^ 1) * AT_BUFB;
                *(LAS u32x4*)(nb + sdst) = kreg; *(LAS u32x4*)(nb + AT_TILEB + sdst) = vreg;
            }
            __syncthreads();
        }
#pragma unroll
        for (int j = 0; j < NQ; ++j) {
            const float ltot = lrun[j] + __shfl_xor(lrun[j], 32);
            const float inv = 1.0f / ltot;
            int row, hglob;
            if (MODE == 1) { const int dmask = (1 << gsh) - 1; const int b = vb >> gsh, rr = vb & dmask; row = b * SEQ + rr + ((qw + r32) << gsh); hglob = g * 6 + hq; }
            else { row = vb * SEQ + qw + 32 * j + r32; hglob = hq; }
            bf16_t* op = Og + (size_t)row * OPITCH + hglob * 64 + 4 * hi;
#pragma unroll
            for (int db = 0; db < 2; ++db)
#pragma unroll
                for (int q4 = 0; q4 < 4; ++q4) {
                    u32x2 w; w.x = cvtpk_s(oacc[j][db][4 * q4 + 0] * inv, oacc[j][db][4 * q4 + 1] * inv); w.y = cvtpk_s(oacc[j][db][4 * q4 + 2] * inv, oacc[j][db][4 * q4 + 3] * inv);
                    *(u32x2*)(op + 32 * db + 8 * q4) = w;
                }
            if (MODE == 1) { if (hi == 0) LSE[(size_t)row * 18 + hglob] = mrun[j] + __builtin_amdgcn_logf(ltot); }
        }
    }
}

__device__ __forceinline__ void attn_dense_fast(LAS unsigned char* lds, const bf16_t* __restrict__ Qg, const bf16_t* __restrict__ Kg, const bf16_t* __restrict__ Vg, bf16_t* Og) {
    int tid_ = threadIdx.x; asm volatile("" : "+v"(tid_));
    const int tid = tid_, lane = tid & 63, wave = __builtin_amdgcn_readfirstlane(tid >> 6), r32 = lane & 31, hi = lane >> 5;
    constexpr int NQ = 2, NUNITS = 1024, NT = SEQ / 64;
    constexpr int VRING = 2 * AT_TILEB;
    const int srow = tid >> 3, schunk = tid & 7;
    const unsigned sdst = (unsigned)(srow * AT_ROWB + schunk * 16);
    { unsigned z = 0u; asm volatile("" : "+v"(z));
      for (int i = tid; i < 3 * AT_TILEB / 16; i += 512) *(LAS u32x4*)(lds + VRING + i * 16) = (u32x4){z, z, z, z}; }
    __syncthreads();
    for (int un = blockIdx.x; un < NUNITS; un += gridDim.x) {
        const int qb = un & 7, hq = (un >> 3) & 15, vb = un >> 7, kvh = hq >> 2;
        const int qw = qb * 512 + 64 * wave;
        bf16x8 qf[NQ][4];
#pragma unroll
        for (int j = 0; j < NQ; ++j) {
            const bf16_t* qp = Qg + ((size_t)(vb * 16 + hq) * SEQ + qw + 32 * j + r32) * 64 + 8 * hi;
#pragma unroll
            for (int s = 0; s < 4; ++s) qf[j][s] = *(const bf16x8*)(qp + 16 * s);
        }
        const char* kbu = (const char*)(Kg + (size_t)(vb * 4 + kvh) * SEQ * 64);
        const char* vbu = (const char*)(Vg + (size_t)(vb * 4 + kvh) * 64 * SEQ);
        const unsigned kof = (unsigned)tid * 16u, vof = (unsigned)(srow * SEQ + schunk * 8) * 2u;
        float lsum[NQ]; f32x16 oacc[NQ][2]; bf16x8 pfp[NQ][2][2];
#pragma unroll
        for (int j = 0; j < NQ; ++j) {
            lsum[j] = 0.f;
#pragma unroll
            for (int i = 0; i < 16; ++i) { oacc[j][0][i] = 0.f; oacc[j][1][i] = 0.f; }
#pragma unroll
            for (int kb = 0; kb < 2; ++kb)
#pragma unroll
                for (int hh = 0; hh < 2; ++hh) pfp[j][kb][hh] = (bf16x8){0, 0, 0, 0, 0, 0, 0, 0};
        }
        u32x4 kreg = *(const u32x4*)(kbu + kof), vreg = *(const u32x4*)(vbu + vof);
        *(LAS u32x4*)(lds + sdst) = kreg; *(LAS u32x4*)(lds + VRING + sdst) = vreg;
        __syncthreads();
        int vprev = VRING + 2 * AT_TILEB, vcur = VRING, vnext = VRING + AT_TILEB;
        f32x16 sB[NQ];
#pragma unroll
        for (int j = 0; j < NQ; ++j)
#pragma unroll
            for (int i = 0; i < 16; ++i) sB[j][i] = NEG_BIG;
#pragma unroll 1
        for (int kt = 0; kt < NT; ++kt) {
            const int tn = (kt + 1 < NT) ? kt + 1 : kt;
            kreg = *(const u32x4*)(kbu + (size_t)tn * 8192 + kof);
            vreg = *(const u32x4*)(vbu + (size_t)tn * 128 + vof);
            const LAS unsigned char* kl = lds + (kt & 1) * AT_TILEB;
            const LAS unsigned char* vl = lds + vprev;
#define AF_QK(dst, kb) do { _Pragma("unroll") for (int j = 0; j < NQ; ++j) _Pragma("unroll") for (int i = 0; i < 16; ++i) dst[j][i] = 0.f; \
            _Pragma("unroll") for (int s = 0; s < 4; ++s) { const bf16x8 kf = *(const LAS bf16x8*)(kl + (32 * (kb) + r32) * AT_ROWB + (2 * s + hi) * 16); \
                _Pragma("unroll") for (int j = 0; j < NQ; ++j) dst[j] = __builtin_amdgcn_mfma_f32_32x32x16_bf16(kf, qf[j][s], dst[j], 0, 0, 0); } } while (0)
#define AF_PV(kb) do { _Pragma("unroll") for (int hh = 0; hh < 2; ++hh) _Pragma("unroll") for (int db = 0; db < 2; ++db) { \
            const bf16x8 vf = *(const LAS bf16x8*)(vl + (32 * db + r32) * AT_ROWB + (2 * (2 * (kb) + hh) + hi) * 16); \
            _Pragma("unroll") for (int j = 0; j < NQ; ++j) oacc[j][db] = __builtin_amdgcn_mfma_f32_32x32x16_bf16(vf, pfp[j][kb][hh], oacc[j][db], 0, 0, 0); } } while (0)
#define AF_EXP(src, kb) do { _Pragma("unroll") for (int j = 0; j < NQ; ++j) { float ps = 0.f; \
            _Pragma("unroll") for (int i = 0; i < 16; ++i) { const float pv = __builtin_amdgcn_exp2f(src[j][i]); src[j][i] = pv; ps += pv; } \
            lsum[j] += ps; \
            _Pragma("unroll") for (int hh = 0; hh < 2; ++hh) { u32x4 w; w.x = cvtpk_s(src[j][8 * hh + 0], src[j][8 * hh + 1]); w.y = cvtpk_s(src[j][8 * hh + 2], src[j][8 * hh + 3]); \
                w.z = cvtpk_s(src[j][8 * hh + 4], src[j][8 * hh + 5]); w.w = cvtpk_s(src[j][8 * hh + 6], src[j][8 * hh + 7]); pfp[j][kb][hh] = __builtin_bit_cast(bf16x8, w); } } } while (0)
#define AF_SCHED() do { _Pragma("unroll") for (int q_ = 0; q_ < 16; ++q_) { __builtin_amdgcn_sched_group_barrier(0x008, 1, 0); __builtin_amdgcn_sched_group_barrier(0x400, 2, 0); \
            __builtin_amdgcn_sched_group_barrier(0x002, 3, 0); __builtin_amdgcn_sched_group_barrier(0x100, 1, 0); } } while (0)
            f32x16 sA[NQ];
            AF_QK(sA, 0); AF_PV(0); AF_EXP(sB, 1);
            AF_SCHED();
            AF_QK(sB, 1); AF_PV(1); AF_EXP(sA, 0);
            AF_SCHED();
            *(LAS u32x4*)(lds + ((kt + 1) & 1) * AT_TILEB + sdst) = kreg; *(LAS u32x4*)(lds + vnext + sdst) = vreg;
            { const int tmp = vprev; vprev = vcur; vcur = vnext; vnext = tmp; }
            __syncthreads();
        }
        {
            const LAS unsigned char* vl = lds + vprev;
            AF_EXP(sB, 1);
            AF_PV(0); AF_PV(1);
        }
        __syncthreads();
#pragma unroll
        for (int j = 0; j < NQ; ++j) {
            const float ltot = lsum[j] + __shfl_xor(lsum[j], 32);
            const float inv = 1.0f / ltot;
            const int row = vb * SEQ + qw + 32 * j + r32;
            bf16_t* op = Og + (size_t)row * 1024 + hq * 64 + 4 * hi;
#pragma unroll
            for (int db = 0; db < 2; ++db)
#pragma unroll
                for (int q4 = 0; q4 < 4; ++q4) {
                    u32x2 w; w.x = cvtpk_s(oacc[j][db][4 * q4 + 0] * inv, oacc[j][db][4 * q4 + 1] * inv); w.y = cvtpk_s(oacc[j][db][4 * q4 + 2] * inv, oacc[j][db][4 * q4 + 3] * inv);
                    *(u32x2*)(op + 32 * db + 8 * q4) = w;
                }
        }
    }
}

template <int MODE> __device__ __forceinline__ void attn_banded(const bf16_t* __restrict__ Qg, const bf16_t* __restrict__ Kg, const bf16_t* __restrict__ Vg, bf16_t* Og, float* LSE, const float* __restrict__ sinks, int gw, int NGW) {
    int lane = threadIdx.x & 63; asm volatile("" : "+v"(lane));
    const int r32 = lane & 31, hi = lane >> 5;
    constexpr int HQ = (MODE == 1) ? 6 : 16, HKV = (MODE == 1) ? 2 : 4, WIN = (MODE == 1) ? 64 : 128, OPITCH = (MODE == 1) ? 1152 : 1024;
    constexpr int NITEMS = (MODE == 1) ? 3 * 6144 : 16384;
    for (int it = gw; it < NITEMS; it += NGW) {
        int g = 0, vb, hq, qblk;
        if (MODE == 1) { g = it / 6144; const int r = it - g * 6144; const int nqs = 7 - 2 * g;   qblk = r & ((1 << nqs) - 1); const int r2 = r >> nqs; hq = r2 % 6; vb = r2 / 6; }
        else { qblk = it & 127; hq = (it >> 7) & 15; vb = it >> 11; }
        const int gsh = 2 * g, lsh = 12 - gsh, L = 1 << lsh;
        const int kvh = (MODE == 1) ? hq / 3 : hq >> 2;
        const int qw = qblk * 32;
        const size_t gq = (MODE == 1) ? (size_t)g * ((size_t)NBATCH * 6 * SEQ * 64) : 0, gk = (MODE == 1) ? (size_t)g * ((size_t)NBATCH * 2 * SEQ * 64) : 0;
        bf16x8 qf[4];
        { const bf16_t* qp = Qg + gq + ((((size_t)(vb * HQ + hq)) << lsh) + qw + r32) * 64 + 8 * hi;
#pragma unroll
          for (int s = 0; s < 4; ++s) qf[s] = *(const bf16x8*)(qp + 16 * s); }
        const char* kp = (const char*)(Kg + gk + (((size_t)(vb * HKV + kvh)) << lsh) * 64) + lane * 16;
        const char* vp = (const char*)(Vg + gk + ((((size_t)(vb * HKV + kvh)) * 64) << lsh)) + lane * 16;
        int lo = (qw - WIN) >> 6; if (lo < 0) lo = 0;
        int hiT = ((qw + 31 + WIN) >> 6) + 1; if (hiT > (L >> 6)) hiT = L >> 6;
        float slope2;
        if (MODE == 1) slope2 = exp2f(-8.0f * (float)(g * 6 + hq + 1) / 18.0f) * (float)(1 << gsh) * LOG2E;
        else slope2 = exp2f(-8.0f * (float)(hq + 1) / 16.0f) * LOG2E;
        float mrun = NEG_BIG, lrun = 0.f;
        if (MODE == 2) { mrun = sinks[hq] * LOG2E; lrun = (hi == 0) ? 1.f : 0.f; }
        f32x16 oacc[2];
#pragma unroll
        for (int i = 0; i < 16; ++i) { oacc[0][i] = 0.f; oacc[1][i] = 0.f; }
        bf16x8 kf[2][4], vf[2][2][2];
#define AB_LDK(t_) do { const char* b_ = kp + (size_t)(t_) * 8192; _Pragma("unroll") for (int kb = 0; kb < 2; ++kb) _Pragma("unroll") for (int s = 0; s < 4; ++s) kf[kb][s] = *(const bf16x8*)(b_ + kb * 4096 + s * 1024); } while (0)
#define AB_LDV(t_) do { const char* b_ = vp + (size_t)(t_) * 8192; _Pragma("unroll") for (int db = 0; db < 2; ++db) _Pragma("unroll") for (int kb = 0; kb < 2; ++kb) _Pragma("unroll") for (int hh = 0; hh < 2; ++hh) \
            vf[db][kb][hh] = *(const bf16x8*)(b_ + db * 4096 + (2 * kb + hh) * 1024); } while (0)
        AB_LDK(lo); AB_LDV(lo);
#pragma unroll 1
        for (int kt = lo; kt < hiT; ++kt) {
            const int tn = (kt + 1 < hiT) ? kt + 1 : kt;
            f32x16 sacc[2];
#pragma unroll
            for (int kb = 0; kb < 2; ++kb) {
#pragma unroll
                for (int i = 0; i < 16; ++i) sacc[kb][i] = 0.f;
#pragma unroll
                for (int s = 0; s < 4; ++s) sacc[kb] = __builtin_amdgcn_mfma_f32_32x32x16_bf16(kf[kb][s], qf[s], sacc[kb], 0, 0, 0);
            }
            AB_LDK(tn);
            {
                const float fd0 = (float)(64 * kt + 4 * hi - (qw + r32));
#pragma unroll
                for (int kb = 0; kb < 2; ++kb)
#pragma unroll
                    for (int i = 0; i < 16; ++i) {
                        const float dist = fabsf(fd0 + (float)(32 * kb + 8 * (i >> 2) + (i & 3)));
                        sacc[kb][i] = (dist <= (float)WIN) ? (sacc[kb][i] - slope2 * dist) : NEG_BIG;
                    }
            }
            float mx = sacc[0][0];
#pragma unroll
            for (int i = 1; i < 16; ++i) mx = fmaxf(mx, sacc[0][i]);
#pragma unroll
            for (int i = 0; i < 16; ++i) mx = fmaxf(mx, sacc[1][i]);
            mx = fmaxf(mx, __shfl_xor(mx, 32));
            if (__builtin_amdgcn_ballot_w64(mx > mrun) != 0ull) {
                const float mnew = fmaxf(mrun, mx);
                const float alpha = __builtin_amdgcn_exp2f(mrun - mnew);
                mrun = mnew; lrun *= alpha;
#pragma unroll
                for (int i = 0; i < 16; ++i) { oacc[0][i] *= alpha; oacc[1][i] *= alpha; }
            }
            const float mcur = mrun;
            float ps = 0.f;
#pragma unroll
            for (int kb = 0; kb < 2; ++kb)
#pragma unroll
                for (int i = 0; i < 16; ++i) { const float pv = __builtin_amdgcn_exp2f(sacc[kb][i] - mcur); sacc[kb][i] = pv; ps += pv; }
            lrun += ps;
            bf16x8 pf[2][2];
#pragma unroll
            for (int kb = 0; kb < 2; ++kb)
#pragma unroll
                for (int hh = 0; hh < 2; ++hh) {
                    u32x4 w; w.x = cvtpk_s(sacc[kb][8 * hh + 0], sacc[kb][8 * hh + 1]); w.y = cvtpk_s(sacc[kb][8 * hh + 2], sacc[kb][8 * hh + 3]);
                    w.z = cvtpk_s(sacc[kb][8 * hh + 4], sacc[kb][8 * hh + 5]); w.w = cvtpk_s(sacc[kb][8 * hh + 6], sacc[kb][8 * hh + 7]);
                    pf[kb][hh] = __builtin_bit_cast(bf16x8, w);
                }
#pragma unroll
            for (int db = 0; db < 2; ++db)
#pragma unroll
                for (int kb = 0; kb < 2; ++kb)
#pragma unroll
                    for (int hh = 0; hh < 2; ++hh) oacc[db] = __builtin_amdgcn_mfma_f32_32x32x16_bf16(vf[db][kb][hh], pf[kb][hh], oacc[db], 0, 0, 0);
            AB_LDV(tn);
        }
#undef AB_LDK
#undef AB_LDV
        const float ltot = lrun + __shfl_xor(lrun, 32);
        const float inv = 1.0f / ltot;
        int row, hglob;
        if (MODE == 1) { const int dmask = (1 << gsh) - 1; const int b = vb >> gsh, rr = vb & dmask; row = b * SEQ + rr + ((qw + r32) << gsh); hglob = g * 6 + hq; }
        else { row = vb * SEQ + qw + r32; hglob = hq; }
        bf16_t* op = Og + (size_t)row * OPITCH + hglob * 64 + 4 * hi;
#pragma unroll
        for (int db = 0; db < 2; ++db)
#pragma unroll
            for (int q4 = 0; q4 < 4; ++q4) {
                u32x2 w; w.x = cvtpk_s(oacc[db][4 * q4 + 0] * inv, oacc[db][4 * q4 + 1] * inv); w.y = cvtpk_s(oacc[db][4 * q4 + 2] * inv, oacc[db][4 * q4 + 3] * inv);
                *(u32x2*)(op + 32 * db + 8 * q4) = w;
            }
        if (MODE == 1) { if (hi == 0) LSE[(size_t)row * 18 + hglob] = mrun + __builtin_amdgcn_logf(ltot); }
    }
}

__device__ __forceinline__ void mixb_fix(bf16_t* Og, const float* LSE, int gw, int NGW, int lane) {
    asm volatile("" : "+v"(lane));
    for (int m = gw; m < MTOK; m += NGW) {
        const float* ls = LSE + (size_t)m * 18;
#pragma unroll
        for (int c3 = 0; c3 < 3; ++c3) {
            const int c = lane + 64 * c3;
            if (c < 144) {
                const int head = c >> 3, g = head / 6, kr = head - 6 * g;
                const float l0 = ls[kr], l1 = ls[6 + kr], l2 = ls[12 + kr];
                const float mx = fmaxf(l0, fmaxf(l1, l2));
                const float e0 = exp2f(l0 - mx), e1 = exp2f(l1 - mx), e2 = exp2f(l2 - mx);
                const float a = ((g == 0) ? e0 : (g == 1) ? e1 : e2) / (e0 + e1 + e2);
                u32x4* pp = (u32x4*)(Og + (size_t)m * 1152) + c;
                u32x4 w = *pp;
                unsigned ww[4] = {w.x, w.y, w.z, w.w};
#pragma unroll
                for (int k = 0; k < 4; ++k) { const float f0 = __builtin_bit_cast(float, ww[k] << 16) * a, f1 = __builtin_bit_cast(float, ww[k] & 0xffff0000u) * a; ww[k] = cvt_pk_bf16(f0, f1); }
                w.x = ww[0]; w.y = ww[1]; w.z = ww[2]; w.w = ww[3];
                *pp = w;
            }
        }
    }
}

#define XB_TMO      128
#define XB_XCNT(j)  (256  + 64 * (j))
#define XB_XSUB(j)  (1280 + 64 * (j))
#define XB_XGEN(j)  (2304 + 64 * (j))
#define XB_TOP      3328
#define XB_TOPGEN   3392
#define XCD_BAR_WORDS 3456
#define XB_SPIN_CAP (1u << 18)

__device__ __forceinline__ unsigned xb_ld(unsigned* p)              { return __hip_atomic_load(p, __ATOMIC_RELAXED, __HIP_MEMORY_SCOPE_AGENT); }
__device__ __forceinline__ unsigned xb_add(unsigned* p, unsigned v) { return __hip_atomic_fetch_add(p, v, __ATOMIC_RELAXED, __HIP_MEMORY_SCOPE_AGENT); }
__device__ __forceinline__ unsigned xb_xcc_id() { return (unsigned)__builtin_amdgcn_s_getreg((3 << 11) | 20) & 0xFu; }
#define XB_SPIN(cond, bar) do { unsigned _sp = 0; while (cond) { __builtin_amdgcn_s_sleep(1); \
    if ((++_sp & 255u) == 0u) { if (xb_ld(&(bar)[XB_TMO])) break; if (_sp > XB_SPIN_CAP) { atomicAdd(&(bar)[XB_TMO], 1u); break; } } } } while (0)

struct XcdBarrier {
    unsigned* bar; unsigned x;
    volatile LAS unsigned* st;
};

__device__ __forceinline__ XcdBarrier xcd_barrier_post(unsigned* bar, volatile LAS unsigned* st) {
    XcdBarrier b; b.bar = bar; b.x = xb_xcc_id(); b.st = st;
    if (threadIdx.x == 0) (void)xb_add(&bar[XB_XCNT(b.x)], 1u);
    return b;
}
__device__ __forceinline__ void xcd_barrier_complete(unsigned* bar, unsigned x, unsigned& nloc, unsigned& nx) {
    const unsigned G = gridDim.x * gridDim.y * gridDim.z;
    unsigned sum, cnt, mine, sp = 0u;
    for (;;) {
        sum = 0u; cnt = 0u; mine = 0u;
#pragma unroll
        for (unsigned j = 0; j < 16; ++j) { const unsigned c = xb_ld(&bar[XB_XCNT(j)]); sum += c; cnt += (c > 0u) ? 1u : 0u; mine = (j == x) ? c : mine; }
        if (sum == G) break;
        __builtin_amdgcn_s_sleep(1);
        if ((++sp & 255u) == 0u) { if (xb_ld(&bar[XB_TMO])) break; if (sp > XB_SPIN_CAP) { atomicAdd(&bar[XB_TMO], 1u); break; } }
    }
    nloc = mine > 0u ? mine : 1u; nx = cnt > 0u ? cnt : 1u;
}

__device__ __forceinline__ void xcd_barrier(const XcdBarrier& b) {
    asm volatile("s_waitcnt vmcnt(0)" ::: "memory");
    __syncthreads();
    if (threadIdx.x == 0) {
        unsigned* bar = b.bar;
        __builtin_amdgcn_s_waitcnt(0);
        unsigned nloc = b.st[0], nx = b.st[1];
        if (nloc == 0u) { xcd_barrier_complete(bar, b.x, nloc, nx); b.st[0] = nloc; b.st[1] = nx; }
        const unsigned old = xb_add(&bar[XB_XSUB(b.x)], 1u);
        const unsigned gen = old / nloc;
        if (old + 1u == (gen + 1u) * nloc) {
            __builtin_amdgcn_fence(__ATOMIC_RELEASE, "agent");
            asm volatile("s_waitcnt vmcnt(0)" ::: "memory");
            const unsigned og = xb_add(&bar[XB_TOP], 1u);
            const unsigned tg = og / nx;
            if (og + 1u == (tg + 1u) * nx) xb_add(&bar[XB_TOPGEN], 1u);
            else XB_SPIN(xb_ld(&bar[XB_TOPGEN]) == tg, bar);
            __builtin_amdgcn_fence(__ATOMIC_ACQUIRE, "agent");
            xb_add(&bar[XB_XGEN(b.x)], 1u);
            asm volatile("s_waitcnt vmcnt(0)" ::: "memory");
        } else {
            XB_SPIN(xb_ld(&bar[XB_XGEN(b.x)]) == gen, bar);
            __builtin_amdgcn_fence(__ATOMIC_ACQUIRE, "agent");
            asm volatile("s_waitcnt vmcnt(0)" ::: "memory");
        }
    }
    __syncthreads();
}

__device__ __forceinline__ void fill_rstd(LAS unsigned char* lds, const pg8::StaticOrder& S, const float* ssp) {
    LAS float* rs = (LAS float*)(lds + LDS_RSTD);
    int tid = threadIdx.x; asm volatile("" : "+v"(tid));
    for (int i0 = 0; i0 < 8; i0 += 2) {
        pg8::Unit u; const int i = i0 + (tid >> 8);
        if (S.next(i, u)) rs[i * 256 + (tid & 255)] = __builtin_amdgcn_rsqf(row_ss(ssp, u.pm * 256 + (tid & 255)) * (1.0f / DM) + RMS_EPS);
    }
    __syncthreads();
}

__global__ void __launch_bounds__(512, 2) fwd_kernel(Params p) {
    extern __shared__ __attribute__((aligned(16))) unsigned char lds_raw[];
    LAS unsigned char* lds = (LAS unsigned char*)lds_raw;
    cg::grid_group grid = cg::this_grid();
    volatile LAS unsigned* xst = (volatile LAS unsigned*)(lds + LDS_BYTES - 64);
    if (threadIdx.x < 2) xst[threadIdx.x] = 0u;
    __syncthreads();
    XcdBarrier xbar = xcd_barrier_post((unsigned*)(p.ws + WS_BAR), xst);
    {
        LAS float* rope = (LAS float*)(lds + LDS_ROPE); LAS float* gl = (LAS float*)(lds + LDS_GAIN);
        for (int i = threadIdx.x; i < 1024; i += 512) { const int pos = i >> 4, f = i & 15; const float ang = (float)pos * exp2f(-(float)f * 0.83048202372184059f); rope[2 * i] = cosf(ang); rope[2 * i + 1] = sinf(ang); }
        if (threadIdx.x < 256) { const int i = threadIdx.x, ja = i >> 7, qk = (i >> 6) & 1, d = i & 63; gl[i] = (qk == 0 ? p.in[4] : p.in[5])[ja * 64 + d]; }
    }
#define GRID_SYNC() do { asm volatile("s_waitcnt vmcnt(0) lgkmcnt(0)" ::: "memory"); grid.sync(); asm volatile("buffer_inv sc1\n\ts_waitcnt vmcnt(0)" ::: "memory"); GRID_SYNC2(); } while (0)
#define XBAR_SYNC() do { xcd_barrier(xbar); asm volatile("buffer_inv sc1\n\ts_waitcnt vmcnt(0)" ::: "memory"); } while (0)
#ifdef PROBE_DUP_SYNC
#define GRID_SYNC2() do { grid.sync(); asm volatile("buffer_inv sc1\n\ts_waitcnt vmcnt(0)" ::: "memory"); } while (0)
#else
#define GRID_SYNC2() do { } while (0)
#endif
    const int wave = __builtin_amdgcn_readfirstlane((int)threadIdx.x >> 6);
#define LANE() ({ int l_ = (int)threadIdx.x & 63; asm volatile("" : "+v"(l_)); l_; })
    const int G = gridDim.x, gw = blockIdx.x * 8 + wave, NGW = G * 8;
    unsigned char* ws = p.ws;
#define GAS __attribute__((address_space(1)))
#define WSP() ({ GAS unsigned char* q_ = (GAS unsigned char*)ws; asm volatile("" : "+s"(q_)); (unsigned char*)q_; })
#define SSP(i) ((float*)(WSP() + WS_SSP) + (size_t)(i) * MTOK * 16)
#define LSE_ ((float*)(WSP() + WS_LSE))
#define WB_ ((bf16_t*)(WSP() + WS_W))
#define HB_ ((bf16_t*)(WSP() + WS_HB))
#define U_ ((bf16_t*)(WSP() + WS_U))
#define Qb_ ((bf16_t*)(WSP() + WS_Q))
#define Kb_ ((bf16_t*)(WSP() + WS_K))
#define Vb_ ((bf16_t*)(WSP() + WS_VT))
#define Ob_ ((bf16_t*)(WSP() + WS_O))
    float* h = p.out;

#ifndef PHMASK
#define PHMASK 0xffff
#endif
    if (PHMASK & 1) prologue(p, lds, gw, NGW, wave, LANE());
#ifdef PROBE_DUP_PRO
    __syncthreads(); prologue(p, lds, gw, NGW, wave, LANE());
#endif
    GRID_SYNC();

#pragma unroll 1
    for (int layer = 0; layer < 4; ++layer) {
        const int kind = (layer == 3) ? 0 : layer;
        const int ja = (layer == 3) ? 1 : 0;
        const size_t weq = (layer == 0) ? WE_QKV0 : (layer == 1) ? WE_QKV1 : (layer == 2) ? WE_QKV2 : WE_QKV3;
        const size_t weo = (layer == 0) ? WE_WO0 : (layer == 1) ? WE_WO1 : (layer == 2) ? WE_WO2 : WE_WO3;
        if (kind == 0 && (PHMASK & 2)) {
            pg8::Gemm g{HB_, WB_ + weq, MTOK, 1536, DM}; pg8::StaticOrder S; S.init(MTOK, 1536, G, (int)blockIdx.x);
            fill_rstd(lds, S, SSP(2 * layer));
            pg8::EpiQKV<0> E{WSP(), lds, ja, 0};
            pg8::gemm_phase<pg8::EpiQKV<0>, pg8::StaticOrder, true, true>(lds, g, S, E);
        } else if (kind == 1 && (PHMASK & 4)) {
            pg8::Gemm g{HB_, WB_ + weq, MTOK, 2048, DM}; pg8::StaticOrder S; S.init(MTOK, 2048, G, (int)blockIdx.x);
            fill_rstd(lds, S, SSP(2 * layer));
            pg8::EpiQKV<1> E{WSP(), lds, 0, 0};
            pg8::gemm_phase<pg8::EpiQKV<1>, pg8::StaticOrder, true, true>(lds, g, S, E);
        } else if (kind == 2 && (PHMASK & 8)) {
            pg8::Gemm g{HB_, WB_ + weq, MTOK, 1536, DM}; pg8::StaticOrder S; S.init(MTOK, 1536, G, (int)blockIdx.x);
            fill_rstd(lds, S, SSP(2 * layer));
            pg8::EpiQKV<2> E{WSP(), lds, 0, 0};
            pg8::gemm_phase<pg8::EpiQKV<2>, pg8::StaticOrder, true, true>(lds, g, S, E);
        }
        XBAR_SYNC();
        if (kind == 0) {
            const LAS float* gl = (const LAS float*)(lds + LDS_GAIN) + ja * 128;
            int lane3 = threadIdx.x & 63; asm volatile("" : "+v"(lane3));
            float gq = fabsf(gl[lane3]), gk = fabsf(gl[64 + lane3]);
#pragma unroll
            for (int o = 1; o < 64; o <<= 1) { gq = fmaxf(gq, __shfl_xor(gq, o)); gk = fmaxf(gk, __shfl_xor(gk, o)); }
            const bool fastp = __builtin_amdgcn_readfirstlane((QSCALE * 64.0f * gq * gk <= 60.0f) ? 1 : 0) != 0;
            if (fastp) { if (PHMASK & 16) attn_dense_fast(lds, Qb_, Kb_, Vb_, Ob_); }
            else if (PHMASK & 16) attn_phase<0>(lds, Qb_, Kb_, Vb_, Ob_, LSE_, nullptr);
#ifdef PROBE_DUP_A
            __syncthreads(); attn_phase<0>(lds, Qb_, Kb_, Vb_, Ob_, LSE_, nullptr);
#endif
        }
        else if (kind == 1) { if (PHMASK & 32) attn_banded<1>(Qb_, Kb_, Vb_, Ob_, LSE_, nullptr, gw, NGW);
#ifdef PROBE_DUP_BC
            __syncthreads(); attn_phase<1>(lds, Qb_, Kb_, Vb_, Ob_, LSE_, nullptr);
#endif
            XBAR_SYNC(); mixb_fix(Ob_, LSE_, gw, NGW, LANE()); }
        else { if (PHMASK & 64) attn_banded<2>(Qb_, Kb_, Vb_, Ob_, LSE_, p.in[10], gw, NGW);
#ifdef PROBE_DUP_BC
            __syncthreads(); attn_phase<2>(lds, Qb_, Kb_, Vb_, Ob_, LSE_, p.in[10]);
#endif
        }
        XBAR_SYNC();
        if (PHMASK & 128) {
            const int Ko = (kind == 1) ? 1152 : 1024;
            pg8::Gemm g{Ob_, WB_ + weo, MTOK, DM, Ko}; pg8::StaticOrder S; S.init(MTOK, DM, G, (int)blockIdx.x);
            pg8::EpiRes E{HB_, SSP(2 * layer + 1)};
            pg8::gemm_phase<pg8::EpiRes, pg8::StaticOrder, true, true>(lds, g, S, E);
        }
        XBAR_SYNC();
        if (PHMASK & 256) {
            pg8::Gemm g{HB_, WB_ + WE_W1 + (size_t)layer * 4096 * 1024, MTOK, DFF, DM}; pg8::StaticOrder S; S.init(MTOK, DFF, G, (int)blockIdx.x);
            fill_rstd(lds, S, SSP(2 * layer + 1));
            pg8::EpiMlp1 E{lds, U_, 0};
            pg8::gemm_phase<pg8::EpiMlp1, pg8::StaticOrder, true, true>(lds, g, S, E);
#ifdef PROBE_DUP_MLP1
            __syncthreads(); pg8::gemm_phase<pg8::EpiMlp1, pg8::StaticOrder, true, true>(lds, g, S, E);
#endif
        }
        XBAR_SYNC();
        if (PHMASK & 512) {
            pg8::Gemm g{U_, WB_ + WE_W2 + (size_t)layer * 4096 * 1024, MTOK, DM, DFF}; pg8::StaticOrder S; S.init(MTOK, DM, G, (int)blockIdx.x);
            pg8::EpiRes E{HB_, SSP(2 * layer + 2)};
            pg8::gemm_phase<pg8::EpiRes, pg8::StaticOrder, true, true>(lds, g, S, E);
        }
        XBAR_SYNC();
    }
    {
        const float* fg = p.in[14]; const float* ss8 = SSP(8); const bf16_t* hbf = HB_;
        const int lane2 = LANE();
        f32x4 gg[4];
#pragma unroll
        for (int j = 0; j < 4; ++j) gg[j] = ((const f32x4*)fg)[4 * lane2 + j];
        for (int m = gw; m < MTOK; m += NGW) {
            const float rstd = __builtin_amdgcn_rsqf(row_ss(ss8, m) * (1.0f / DM) + RMS_EPS);
            const u32x4* hr = (const u32x4*)(hbf + (size_t)m * DM) + 2 * lane2;
            const u32x4 w0 = hr[0], w1 = hr[1];
            const unsigned ww[8] = {w0.x, w0.y, w0.z, w0.w, w1.x, w1.y, w1.z, w1.w};
            f32x4* orow = (f32x4*)(h + (size_t)m * DM) + 4 * lane2;
#pragma unroll
            for (int j = 0; j < 4; ++j) {
                f32x4 v;
                v[0] = __builtin_bit_cast(float, ww[2 * j] << 16); v[1] = __builtin_bit_cast(float, ww[2 * j] & 0xffff0000u);
                v[2] = __builtin_bit_cast(float, ww[2 * j + 1] << 16); v[3] = __builtin_bit_cast(float, ww[2 * j + 1] & 0xffff0000u);
                orow[j] = v * rstd * gg[j];
            }
        }
    }
}

extern "C" void kernel_launch(void* const* d_in, const int* in_sizes, int n_in, void* d_out, int out_size, void* d_ws, size_t ws_size, hipStream_t stream) {
    static int grid = 0;
    if (grid == 0) {
        if (n_in != 15 || out_size != MTOK * DM || ws_size < WS_END) { fprintf(stderr, "kernel_launch: unexpected shapes (n_in %d out %d ws %zu)\n", n_in, out_size, ws_size); grid = -1; return; }
        int dev = 0, cus = 0, per_cu = 0;
        hipGetDevice(&dev);
        hipDeviceGetAttribute(&cus, hipDeviceAttributeMultiprocessorCount, dev);
        if (hipFuncSetAttribute((const void*)fwd_kernel, hipFuncAttributeMaxDynamicSharedMemorySize, LDS_BYTES) != hipSuccess) { fprintf(stderr, "kernel_launch: hipFuncSetAttribute failed\n"); grid = -1; return; }
        if (hipOccupancyMaxActiveBlocksPerMultiprocessor(&per_cu, (const void*)fwd_kernel, 512, LDS_BYTES) != hipSuccess || per_cu < 1) { fprintf(stderr, "kernel_launch: occupancy query gave %d\n", per_cu); per_cu = 1; }
        (void)hipGetLastError();
        grid = cus * per_cu;
    }
    if (grid < 0) return;
    if (hipMemsetAsync((char*)d_ws + WS_BAR, 0, 16384, stream) != hipSuccess) { fprintf(stderr, "kernel_launch: hipMemsetAsync failed\n"); return; }
    Params p{};
    for (int i = 0; i < 15; ++i) p.in[i] = (const float*)d_in[i];
    p.out = (float*)d_out; p.ws = (unsigned char*)d_ws;
    void* args[] = {&p};
    hipError_t e = hipLaunchCooperativeKernel((const void*)fwd_kernel, dim3(grid), dim3(512), args, LDS_BYTES, stream);
    if (e != hipSuccess) fprintf(stderr, "cooperative launch failed: %s (grid %d)\n", hipGetErrorString(e), grid);
}
```

```cpp
#include <hip/hip_runtime.h>
#include <hip/hip_cooperative_groups.h>
#include <cstdio>
#include <cstdint>
namespace cg = cooperative_groups;

namespace pg8 {
#define PG8_LAS __attribute__((address_space(3)))
typedef unsigned short bf16_t;
typedef short bf16x8 __attribute__((ext_vector_type(8)));
typedef float f32x4 __attribute__((ext_vector_type(4)));
typedef unsigned u32x4 __attribute__((ext_vector_type(4)));
constexpr int BM = 256, BK = 64, HALF = 128, HTB = HALF * BK * 2  , STAGE_BYTES = 8 * HTB, NXCD = 8, WGM = 8;

__host__ __device__ __forceinline__ int lds_byte(int r, int c) { const int st = (r >> 4) * 2 + (c >> 5), rr = r & 15, cc = c & 31, ob = rr * 64 + cc * 2; return st * 1024 + (ob ^ (((ob >> 9) & 1) << 5)); }
__host__ __device__ __forceinline__ void stage_rc(int b, int& R, int& C) { const int st = b / 1024, sb = b % 1024, swz = sb ^ (((sb >> 9) & 1) << 5); R = (st >> 1) * 16 + swz / 64; C = (st & 1) * 32 + (swz % 64) / 2; }
__host__ __device__ __forceinline__ int perm32(int rho) { const int n = rho >> 4, i = rho & 15; return 8 * (i >> 2) + 4 * n + (i & 3); }

struct Unit { int pm, pn; };
struct Gemm { const bf16_t* A; const bf16_t* Bt; int M, N, K; };

struct StaticOrder {
    int nM, nN, nwg, G, c;
    __host__ __device__ void init(int M, int N, int G_, int c_) { nM = M / BM; nN = N / BM; nwg = nM * nN; G = G_; c = c_; }
    __host__ __device__ bool next(int i, Unit& u) const {
        const long L = (long)i * G + c; if (L >= nwg) return false;
        int wgid = (int)L; { const int q = nwg / NXCD, r = nwg % NXCD, xcd = wgid % NXCD, off = wgid / NXCD; wgid = (xcd < r ? xcd * (q + 1) : r * (q + 1) + (xcd - r) * q) + off; }
        const int nig = WGM * nN, gid = wgid / nig, fm = gid * WGM, gsz = (nM - fm) < WGM ? (nM - fm) : WGM;
        u.pm = fm + ((wgid % nig) % gsz); u.pn = (wgid % nig) / gsz; return true;
    }
    __device__ __forceinline__ void a_ready(const Unit&) const {}
    __device__ __forceinline__ void done(const Unit&) const {}
};

__device__ __forceinline__ unsigned cvt_pk_bf16(float lo, float hi) { unsigned r; asm volatile("v_cvt_pk_bf16_f32 %0, %1, %2" : "=v"(r) : "v"(lo), "v"(hi)); return r; }
constexpr int SEQ = 4096, NBATCH = 8, MTOK = NBATCH * SEQ, DM = 1024, DFF = 4096;
constexpr float RMS_EPS = 1e-6f;
constexpr float LOG2E = 1.4426950408889634f;
constexpr float QSCALE = 0.125f * LOG2E;
constexpr float NEG_BIG = -1.0e30f;

constexpr size_t MiB = 1u << 20;
constexpr size_t WS_SS = 0;
constexpr size_t WS_TAB = 6 * MiB;
constexpr size_t WS_BAR = 7 * MiB;
constexpr size_t WS_LSE = 2 * MiB;
constexpr size_t WS_W = 8 * MiB;
constexpr size_t WS_HB = 96 * MiB;
constexpr size_t WS_U = 160 * MiB;
constexpr size_t WS_Q = 160 * MiB, WS_K = 232 * MiB, WS_VT = 256 * MiB, WS_O = 280 * MiB;
constexpr size_t WS_SSP = 420 * MiB;
constexpr size_t WS_END = 440 * MiB;

constexpr int LDS_RSTD = 131072;
constexpr int LDS_ROPE = 139264;
constexpr int LDS_GAIN = 147456;
constexpr int LDS_BYTES = 163840;
__device__ __forceinline__ float row_ss(const float* ssp, int row) {
    const f32x4* q = (const f32x4*)(ssp + (size_t)row * 16);
    const f32x4 a = q[0], b = q[1], c = q[2], d = q[3];
    return ((a[0] + a[1]) + (a[2] + a[3])) + ((b[0] + b[1]) + (b[2] + b[3])) + (((c[0] + c[1]) + (c[2] + c[3])) + ((d[0] + d[1]) + (d[2] + d[3])));
}
__device__ __forceinline__ int perm_key(int i) { return (i & ~12) | ((i & 4) << 1) | ((i & 8) >> 1); }

template <int KIND> struct EpiQKV {
    static constexpr bool PERM = true, AFTER_DRAIN = false;
    unsigned char* ws; PG8_LAS unsigned char* lds; int ja; mutable int cnt;
    __device__ __forceinline__ void operator()(const f32x4 (&acc)[2][2][4][2], const Unit& u, int wr, int wc, int fr, int fq) const {
        asm volatile("" : "+v"(fr), "+v"(fq));
        asm volatile("" : "+s"(wr), "+s"(wc));
        constexpr int NQH = (KIND == 1) ? 18 : 16, NKH = (KIND == 1) ? 6 : 4;
        const int hcol = 4 * u.pn + wc;
        int type, hh;
        if (hcol < NQH) { type = 0; hh = hcol; } else if (hcol < NQH + NKH) { type = 1; hh = hcol - NQH; } else if (hcol < NQH + 2 * NKH) { type = 2; hh = hcol - NQH - NKH; } else { ++cnt; return; }
        const PG8_LAS float* ss = (const PG8_LAS float*)(lds + LDS_RSTD) + 256 * cnt;
        ++cnt;
        const PG8_LAS f32x4* rope = (const PG8_LAS f32x4*)(lds + LDS_ROPE);
        float gn[2][8];
        if (KIND == 0) {
            const PG8_LAS float* gsrc = (const PG8_LAS float*)(lds + LDS_GAIN) + ja * 128 + ((type == 0) ? 0 : 64);
            if (type < 2) {
#pragma unroll
                for (int bj = 0; bj < 2; ++bj)
#pragma unroll
                    for (int n = 0; n < 2; ++n)
#pragma unroll
                        for (int j = 0; j < 4; ++j) gn[bj][n * 4 + j] = gsrc[32 * bj + 16 * n + 4 * fq + j];
            }
        }
        int hin = hh, g = 0;
        if (KIND == 1) { if (type == 0) { g = hh / 6; hin = hh - 6 * g; } else { g = hh >> 1; hin = hh & 1; } }
        if (KIND == 1 && g == 1) body<2>(acc, u, wr, wc, fr, fq, type, hin, g, ss, rope, gn);
        else if (KIND == 1 && g == 2) body<4>(acc, u, wr, wc, fr, fq, type, hin, g, ss, rope, gn);
        else body<0>(acc, u, wr, wc, fr, fq, type, hin, g, ss, rope, gn);
    }
    template <int gsh> __device__ __forceinline__ void body(const f32x4 (&acc)[2][2][4][2], const Unit& u, int wr, int wc, int fr, int fq, int type, int hin, int g, const PG8_LAS float* ss, const PG8_LAS f32x4* rope, const float (&gn)[2][8]) const {
#pragma unroll
        for (int ai = 0; ai < 2; ++ai)
#pragma unroll
            for (int m = 0; m < 4; ++m) {
                int frl = fr; asm volatile("" : "+v"(frl));
                const int row = u.pm * BM + ai * HALF + wr * 64 + m * 16 + frl;
                const int b = row >> 12, t = row & (SEQ - 1);
                const float rstd = ss[ai * HALF + wr * 64 + m * 16 + frl];
                float v[2][8];
#pragma unroll
                for (int bj = 0; bj < 2; ++bj)
#pragma unroll
                    for (int n = 0; n < 2; ++n)
#pragma unroll
                        for (int j = 0; j < 4; ++j) v[bj][n * 4 + j] = acc[ai][bj][m][n][j] * rstd;
                if (KIND == 0 && type < 2) {
                    float s2 = 0.f;
#pragma unroll
                    for (int bj = 0; bj < 2; ++bj)
#pragma unroll
                        for (int e = 0; e < 8; ++e) s2 += v[bj][e] * v[bj][e];
                    s2 += __shfl_xor(s2, 16); s2 += __shfl_xor(s2, 32);
                    const float r = __builtin_amdgcn_rsqf(s2 * (1.0f / 64.0f) + RMS_EPS);
#pragma unroll
                    for (int bj = 0; bj < 2; ++bj)
#pragma unroll
                        for (int e = 0; e < 8; ++e) v[bj][e] *= r * gn[bj][e];
#pragma unroll
                    for (int bj = 0; bj < 2; ++bj) {
                        const int pos = (bj == 0) ? (t >> 6) : (t & 63);
                        const f32x4 cs0 = rope[(pos * 16 + 4 * fq) >> 1], cs1 = rope[((pos * 16 + 4 * fq) >> 1) + 1];
                        const float cc[4] = {cs0[0], cs0[2], cs1[0], cs1[2]}, sn[4] = {cs0[1], cs0[3], cs1[1], cs1[3]};
#pragma unroll
                        for (int j = 0; j < 4; ++j) {
                            const float x1 = v[bj][j], x2 = v[bj][4 + j];
                            v[bj][j] = x1 * cc[j] - x2 * sn[j]; v[bj][4 + j] = x2 * cc[j] + x1 * sn[j];
                        }
                    }
                }
                if (type == 0) {
#pragma unroll
                    for (int bj = 0; bj < 2; ++bj)
#pragma unroll
                        for (int e = 0; e < 8; ++e) v[bj][e] *= QSCALE;
                }
                const int dmask = (1 << gsh) - 1;
                const int vb = (b << gsh) + (t & dmask), idx = t >> gsh, lsh = 12 - gsh;
                if (type < 2) {
                    const int nh = (type == 0) ? ((KIND == 1) ? 6 : 16) : ((KIND == 1) ? 2 : 4);
                    unsigned char* base = ws + ((type == 0) ? WS_Q : WS_K) + ((KIND == 1) ? (size_t)g * ((size_t)NBATCH * nh * SEQ * 128) : 0);
                    unsigned off = ((unsigned)(((vb * nh + hin) << lsh) + idx) * 64u + 8u * fq) * 2u; unsigned bjstep = 64u;
                    if (KIND != 0 && type == 1) {
                        off = (unsigned)((vb * nh + hin) << lsh) * 128u + ((unsigned)(idx >> 5) * 4u + (fq >> 1)) * 1024u + ((fq & 1) * 32u + (idx & 31)) * 16u; bjstep = 2048u;
                    }
#pragma unroll
                    for (int bj = 0; bj < 2; ++bj) {
                        u32x4 w; w.x = cvt_pk_bf16(v[bj][0], v[bj][1]); w.y = cvt_pk_bf16(v[bj][2], v[bj][3]); w.z = cvt_pk_bf16(v[bj][4], v[bj][5]); w.w = cvt_pk_bf16(v[bj][6], v[bj][7]);
                        *(u32x4*)(base + off + bjstep * bj) = w;
                    }
                } else {
                    const int nh = (KIND == 1) ? 2 : 4;
                    unsigned char* base = ws + WS_VT + ((KIND == 1) ? (size_t)g * ((size_t)NBATCH * nh * SEQ * 128) : 0);
                    unsigned off = ((unsigned)((((vb * nh + hin) * 64 + 8 * fq) << lsh) + perm_key(idx))) * 2u;
                    unsigned dstep = 2u << lsh, bjskip = 24u * dstep;
                    if (KIND != 0) {
                        const unsigned pk_ = (unsigned)perm_key(idx), ks = pk_ & 63u, c8 = ks >> 3;
                        off = (unsigned)(((vb * nh + hin) * 64) << lsh) * 2u + (((pk_ >> 6) * 2u) * 4u + (c8 >> 1)) * 1024u + (c8 & 1u) * 512u + (8u * fq) * 16u + (ks & 7u) * 2u;
                        dstep = 16u; bjskip = 4096u - 8u * 16u;
                    }
#pragma unroll
                    for (int bj = 0; bj < 2; ++bj) {
#pragma unroll
                        for (int e = 0; e < 8; ++e) {
                            const unsigned pk = cvt_pk_bf16(v[bj][e], 0.f);
                            *(bf16_t*)(base + off) = (bf16_t)(pk & 0xffffu);
                            off += dstep;
                        }
                        off += bjskip;
                    }
                }
                __builtin_amdgcn_sched_barrier(0);
            }
    }
};

struct EpiRes {
    static constexpr bool PERM = true, AFTER_DRAIN = false;
    bf16_t* hb; float* ssout;
    __device__ __forceinline__ void operator()(const f32x4 (&acc)[2][2][4][2], const Unit& u, int wr, int wc, int fr, int fq) const {
        asm volatile("" : "+v"(fr), "+v"(fq));
        const unsigned o0 = (unsigned)((u.pm * BM + wr * 64 + fr) * DM + u.pn * BM + wc * 32 + 8 * fq);
        u32x4 hv[2][2];
#pragma unroll
        for (int bj = 0; bj < 2; ++bj) hv[0][bj] = *(const u32x4*)((const char*)hb + (o0 + bj * HALF) * 2u);
#pragma unroll
        for (int it = 0; it < 8; ++it) {
            const int ai = it >> 2, m = it & 3, cur = it & 1, nxt = cur ^ 1;
            if (it + 1 < 8) {
                const int ai2 = (it + 1) >> 2, m2 = (it + 1) & 3;
                const unsigned o2 = o0 + (unsigned)((ai2 * HALF + m2 * 16) * DM);
#pragma unroll
                for (int bj = 0; bj < 2; ++bj) hv[nxt][bj] = *(const u32x4*)((const char*)hb + (o2 + bj * HALF) * 2u);
            }
            const unsigned o1 = o0 + (unsigned)((ai * HALF + m * 16) * DM);
            float q = 0.f;
#pragma unroll
            for (int bj = 0; bj < 2; ++bj) {
                const unsigned o = o1 + bj * HALF;
                const u32x4 hw = hv[cur][bj];
                f32x4 v0, v1;
                v0[0] = __builtin_bit_cast(float, hw.x << 16); v0[1] = __builtin_bit_cast(float, hw.x & 0xffff0000u); v0[2] = __builtin_bit_cast(float, hw.y << 16); v0[3] = __builtin_bit_cast(float, hw.y & 0xffff0000u);
                v1[0] = __builtin_bit_cast(float, hw.z << 16); v1[1] = __builtin_bit_cast(float, hw.z & 0xffff0000u); v1[2] = __builtin_bit_cast(float, hw.w << 16); v1[3] = __builtin_bit_cast(float, hw.w & 0xffff0000u);
                v0 = v0 + acc[ai][bj][m][0]; v1 = v1 + acc[ai][bj][m][1];
                u32x4 w; w.x = cvt_pk_bf16(v0[0], v0[1]); w.y = cvt_pk_bf16(v0[2], v0[3]); w.z = cvt_pk_bf16(v1[0], v1[1]); w.w = cvt_pk_bf16(v1[2], v1[3]);
                *(u32x4*)((char*)hb + o * 2u) = w;
                q += (v0[0] * v0[0] + v0[1] * v0[1]) + (v0[2] * v0[2] + v0[3] * v0[3]) + (v1[0] * v1[0] + v1[1] * v1[1]) + (v1[2] * v1[2] + v1[3] * v1[3]);
            }
            q += __shfl_xor(q, 16); q += __shfl_xor(q, 32);
            const int row = u.pm * BM + ai * HALF + wr * 64 + m * 16 + fr;
            if (fq == 0) ssout[(size_t)row * 16 + u.pn * 4 + wc] = q;
        }
    }
};

struct EpiMlp1 {
    static constexpr bool PERM = true, AFTER_DRAIN = false;
    PG8_LAS unsigned char* lds; bf16_t* U; mutable int cnt;
    __device__ __forceinline__ void operator()(const f32x4 (&acc)[2][2][4][2], const Unit& u, int wr, int wc, int fr, int fq) const {
        const PG8_LAS float* ss = (const PG8_LAS float*)(lds + LDS_RSTD) + 256 * cnt;
        ++cnt;
#pragma unroll
        for (int ai = 0; ai < 2; ++ai)
#pragma unroll
            for (int m = 0; m < 4; ++m) {
                const int row = u.pm * BM + ai * HALF + wr * 64 + m * 16 + fr;
                const float rstd = ss[ai * HALF + wr * 64 + m * 16 + fr];
#pragma unroll
                for (int bj = 0; bj < 2; ++bj) {
                    f32x4 v0 = acc[ai][bj][m][0] * rstd, v1 = acc[ai][bj][m][1] * rstd;
#pragma unroll
                    for (int j = 0; j < 4; ++j) { const float a = fmaxf(v0[j], 0.f), c = fmaxf(v1[j], 0.f); v0[j] = a * a; v1[j] = c * c; }
                    u32x4 w; w.x = cvt_pk_bf16(v0[0], v0[1]); w.y = cvt_pk_bf16(v0[2], v0[3]); w.z = cvt_pk_bf16(v1[0], v1[1]); w.w = cvt_pk_bf16(v1[2], v1[3]);
                    *(u32x4*)((char*)U + (unsigned)(row * DFF + u.pn * BM + bj * HALF + wc * 32 + 8 * fq) * 2u) = w;
                }
            }
    }
};
template <class Epi, class Sched, bool ALIGN_EPI = false, bool SP2 = false>
__device__ __forceinline__ void gemm_phase(PG8_LAS unsigned char* lds, const Gemm g, const Sched& S, const Epi& E) {
    int tid_ = threadIdx.x; asm volatile("" : "+v"(tid_));
    const int tid = tid_, wid = __builtin_amdgcn_readfirstlane(tid >> 6), lane = tid & 63, wr = wid >> 2, wc = wid & 3, fr = lane & 15, fq = lane >> 4;
    const int K = g.K, nt = K / BK;
    unsigned voffA[2], voffB[2];
#pragma unroll
    for (int i = 0; i < 2; ++i) { int R, C; stage_rc(tid * 16 + i * 8192, R, C); const int Rb = Epi::PERM ? ((R & ~31) + perm32(R & 31)) : R;
        voffA[i] = (unsigned)(R * K + C) * 2u; voffB[i] = (unsigned)(Rb * K + C) * 2u; }
    const size_t kstep = (size_t)(BK * 2);
    const size_t hstep = (size_t)HALF * K * 2;
    const size_t tstep = 2 * hstep;
    const unsigned ldsw = (unsigned)wid * 1024u;
    const int aoff = lds_byte(wr * 64 + fr, fq * 8), boff = lds_byte(wc * 32 + fr, fq * 8);
#define PG8_SA(b, h) (((b) * 2 + (h)) * HTB)
#define PG8_SB(b, h) ((4 + (b) * 2 + (h)) * HTB)
#define PG8_STAGE(bufoff, gbase, voff) do { _Pragma("unroll") for (int _i = 0; _i < 2; ++_i) \
        __builtin_amdgcn_global_load_lds((const unsigned*)((const char*)(gbase) + (voff)[_i]), (PG8_LAS unsigned*)(lds + (bufoff) + ldsw + _i * 8192), 16, 0, 0); } while (0)
#define PG8_LDA(dst, b, h) do { _Pragma("unroll") for (int m = 0; m < 4; ++m) _Pragma("unroll") for (int k = 0; k < 2; ++k) dst[m][k] = *(const PG8_LAS bf16x8*)(lds + PG8_SA(b, h) + aoff + m * 2048 + k * 1024); } while (0)
#define PG8_LDB(dst, b, h) do { _Pragma("unroll") for (int n = 0; n < 2; ++n) _Pragma("unroll") for (int k = 0; k < 2; ++k) dst[n][k] = *(const PG8_LAS bf16x8*)(lds + PG8_SB(b, h) + boff + n * 2048 + k * 1024); } while (0)
#define PG8_MMA(ai, bj, At, Bt) do { __builtin_amdgcn_s_setprio(1); _Pragma("unroll") for (int m = 0; m < 4; ++m) _Pragma("unroll") for (int n = 0; n < 2; ++n) _Pragma("unroll") for (int k = 0; k < 2; ++k) \
        acc[ai][bj][m][n] = __builtin_amdgcn_mfma_f32_16x16x32_bf16(Bt[n][k], At[m][k], acc[ai][bj][m][n], 0, 0, 0); __builtin_amdgcn_s_setprio(0); } while (0)
#define PG8_WAIT_V(n) asm volatile("s_waitcnt vmcnt(" #n ")" ::: "memory")
#define PG8_WAIT_L(n) asm volatile("s_waitcnt lgkmcnt(" #n ")" ::: "memory")
#define PG8_BAR __builtin_amdgcn_s_barrier()
#define PG8_SCHED __builtin_amdgcn_sched_barrier(0)
    Unit cur, nxt; int ui = 0;
    if (!S.next(0, cur)) return;
    f32x4 acc[2][2][4][2];
#pragma unroll
    for (int a = 0; a < 2; ++a)
#pragma unroll
        for (int b = 0; b < 2; ++b)
#pragma unroll
            for (int m = 0; m < 4; ++m)
#pragma unroll
                for (int n = 0; n < 2; ++n) acc[a][b][m][n] = (f32x4){0.f, 0.f, 0.f, 0.f};
    bf16x8 At[4][2], B0[2][2], B1[2][2];
    const char* cA = (const char*)g.A + (size_t)cur.pm * tstep; const char* cB = (const char*)g.Bt + (size_t)cur.pn * tstep;
    S.a_ready(cur);
    if constexpr (SP2) {
        PG8_STAGE(PG8_SB(0, 0), cB, voffB); PG8_STAGE(PG8_SB(0, 1), cB + hstep, voffB); PG8_STAGE(PG8_SA(0, 0), cA, voffA); PG8_STAGE(PG8_SA(0, 1), cA + hstep, voffA);
        if (wr == 1) PG8_BAR;
        PG8_WAIT_V(2); PG8_BAR;
        PG8_STAGE(PG8_SB(1, 0), cB + kstep, voffB); PG8_STAGE(PG8_SA(1, 0), cA + kstep, voffA); PG8_STAGE(PG8_SB(1, 1), cB + hstep + kstep, voffB);
        PG8_WAIT_V(6); PG8_BAR;
    } else {
        PG8_STAGE(PG8_SB(0, 0), cB, voffB); PG8_STAGE(PG8_SA(0, 0), cA, voffA); PG8_STAGE(PG8_SB(0, 1), cB + hstep, voffB); PG8_STAGE(PG8_SA(0, 1), cA + hstep, voffA);
        if (wr == 1) PG8_BAR;
        PG8_WAIT_V(4); PG8_BAR;
        PG8_STAGE(PG8_SB(1, 0), cB + kstep, voffB); PG8_STAGE(PG8_SA(1, 0), cA + kstep, voffA); PG8_STAGE(PG8_SB(1, 1), cB + hstep + kstep, voffB);
        PG8_WAIT_V(6); PG8_BAR;
    }
    for (;;) {
        const bool has_next = S.next(ui + 1, nxt);
        const char* nA = has_next ? (const char*)g.A + (size_t)nxt.pm * tstep : cA; const char* nB = has_next ? (const char*)g.Bt + (size_t)nxt.pn * tstep : cB;
        for (int t = 0; t < nt; t += 2) {
            const bool last = (t == nt - 2);
            const char* a1 = cA + (size_t)(t + 1) * kstep;
            const char* a2 = last ? nA : cA + (size_t)(t + 2) * kstep; const char* b2 = last ? nB : cB + (size_t)(t + 2) * kstep;
            const char* a3 = a2 + kstep; const char* b3 = b2 + kstep;
            if (last && has_next) S.a_ready(nxt);
            if constexpr (SP2) {
            PG8_LDB(B0, 0, 0); PG8_LDB(B1, 0, 1); PG8_SCHED; PG8_LDA(At, 0, 0); PG8_STAGE(PG8_SA(1, 1), a1 + hstep, voffA);
            PG8_WAIT_V(8); PG8_WAIT_L(0); PG8_BAR; PG8_MMA(0, 0, At, B0); PG8_MMA(0, 1, At, B1); PG8_BAR; PG8_SCHED;
            PG8_LDA(At, 0, 1); PG8_STAGE(PG8_SB(0, 0), b2, voffB); PG8_STAGE(PG8_SB(0, 1), b2 + hstep, voffB); PG8_STAGE(PG8_SA(0, 0), a2, voffA);
            PG8_WAIT_V(8); PG8_WAIT_L(0); PG8_BAR; PG8_MMA(1, 0, At, B0); PG8_MMA(1, 1, At, B1); PG8_BAR; PG8_SCHED;
            PG8_LDB(B0, 1, 0); PG8_LDB(B1, 1, 1); PG8_SCHED; PG8_LDA(At, 1, 0); PG8_STAGE(PG8_SA(0, 1), a2 + hstep, voffA);
            PG8_WAIT_V(8); PG8_WAIT_L(0); PG8_BAR; PG8_MMA(0, 0, At, B0); PG8_MMA(0, 1, At, B1); PG8_BAR; PG8_SCHED;
            PG8_LDA(At, 1, 1); PG8_STAGE(PG8_SB(1, 0), b3, voffB); PG8_STAGE(PG8_SB(1, 1), b3 + hstep, voffB); PG8_STAGE(PG8_SA(1, 0), a3, voffA);
            PG8_WAIT_V(8); PG8_WAIT_L(0); PG8_BAR; PG8_MMA(1, 0, At, B0); PG8_MMA(1, 1, At, B1); PG8_BAR; PG8_SCHED;
            } else {
            PG8_LDB(B0, 0, 0); PG8_SCHED; PG8_LDA(At, 0, 0); PG8_STAGE(PG8_SA(1, 1), a1 + hstep, voffA);
            PG8_WAIT_L(8); PG8_BAR; PG8_WAIT_L(0); PG8_MMA(0, 0, At, B0); PG8_BAR; PG8_SCHED;
            PG8_LDB(B1, 0, 1); PG8_STAGE(PG8_SB(0, 0), b2, voffB);
            PG8_BAR; PG8_WAIT_L(0); PG8_MMA(0, 1, At, B1); PG8_BAR;
            PG8_LDA(At, 0, 1); PG8_STAGE(PG8_SA(0, 0), a2, voffA);
            PG8_BAR; PG8_WAIT_L(0); PG8_MMA(1, 0, At, B0); PG8_BAR; PG8_SCHED;
            PG8_STAGE(PG8_SB(0, 1), b2 + hstep, voffB);
            PG8_WAIT_V(6); PG8_BAR; PG8_MMA(1, 1, At, B1); PG8_BAR;
            PG8_LDB(B0, 1, 0); PG8_SCHED; PG8_LDA(At, 1, 0); PG8_STAGE(PG8_SA(0, 1), a2 + hstep, voffA);
            PG8_WAIT_L(8); PG8_BAR; PG8_WAIT_L(0); PG8_MMA(0, 0, At, B0); PG8_BAR; PG8_SCHED;
            PG8_LDB(B1, 1, 1); PG8_STAGE(PG8_SB(1, 0), b3, voffB);
            PG8_BAR; PG8_WAIT_L(0); PG8_MMA(0, 1, At, B1); PG8_BAR;
            PG8_LDA(At, 1, 1); PG8_STAGE(PG8_SA(1, 0), a3, voffA);
            PG8_BAR; PG8_WAIT_L(0); PG8_MMA(1, 0, At, B0); PG8_BAR; PG8_SCHED;
            PG8_STAGE(PG8_SB(1, 1), b3 + hstep, voffB);
            PG8_WAIT_V(6); PG8_BAR; PG8_MMA(1, 1, At, B1); PG8_BAR;
            }
        }
        if constexpr (ALIGN_EPI) { if (wr == 0) PG8_BAR; }
        if constexpr (!Epi::AFTER_DRAIN) { E(acc, cur, wr, wc, fr, fq); S.done(cur); }
        if (!has_next) break;
#pragma unroll
        for (int a = 0; a < 2; ++a)
#pragma unroll
            for (int b = 0; b < 2; ++b)
#pragma unroll
                for (int m = 0; m < 4; ++m)
#pragma unroll
                    for (int n = 0; n < 2; ++n) acc[a][b][m][n] = (f32x4){0.f, 0.f, 0.f, 0.f};
        cur = nxt; cA = nA; cB = nB; ++ui;
        if constexpr (ALIGN_EPI) { if (wr == 1) PG8_BAR; }
    }
    PG8_WAIT_V(0);
    if constexpr (!ALIGN_EPI) { if (wr == 0) PG8_BAR; }
    PG8_BAR;
    if constexpr (Epi::AFTER_DRAIN) { E.fused(acc, cur, wr, wc, fr, fq, lds, wid, lane); S.done(cur); }
#undef PG8_SA
#undef PG8_SB
#undef PG8_STAGE
#undef PG8_LDA
#undef PG8_LDB
#undef PG8_MMA
#undef PG8_WAIT_V
#undef PG8_WAIT_L
#undef PG8_BAR
#undef PG8_SCHED
}
}
using namespace pg8;
using pg8::bf16_t; using pg8::bf16x8; using pg8::f32x4; using pg8::u32x4; using pg8::cvt_pk_bf16;
#define LAS __attribute__((address_space(3)))
typedef float f32x16 __attribute__((ext_vector_type(16)));
typedef unsigned u32x2 __attribute__((ext_vector_type(2)));
#define LDS_WAIT() asm volatile("s_waitcnt lgkmcnt(0)" ::: "memory")
typedef float f32x2_t __attribute__((ext_vector_type(2)));
typedef __bf16 bf16x2_t __attribute__((ext_vector_type(2)));
__device__ __forceinline__ unsigned cvtpk_s(float lo, float hi) { f32x2_t v = {lo, hi}; bf16x2_t b = __builtin_convertvector(v, bf16x2_t); return __builtin_bit_cast(unsigned, b); }

constexpr size_t WE_QKV0 = 0, WE_QKV1 = WE_QKV0 + 1536 * 1024, WE_QKV2 = WE_QKV1 + 2048 * 1024, WE_QKV3 = WE_QKV2 + 1536 * 1024;
constexpr size_t WE_WO0 = WE_QKV3 + 1536 * 1024, WE_WO1 = WE_WO0 + 1024 * 1024, WE_WO2 = WE_WO1 + 1024 * 1152, WE_WO3 = WE_WO2 + 1024 * 1024;
constexpr size_t WE_W1 = WE_WO3 + 1024 * 1024, WE_W2 = WE_W1 + 4 * (size_t)4096 * 1024, WE_END = WE_W2 + 4 * (size_t)4096 * 1024;
static_assert(WS_W + WE_END * 2 <= WS_HB, "weights fit");

struct Params { const float* in[15]; float* out; unsigned char* ws; };

__device__ __forceinline__ float wave_sum(float v) {
#pragma unroll
    for (int o = 1; o < 64; o <<= 1) v += __shfl_xor(v, o);
    return v;
}

struct TrDesc { const float* W; bf16_t* WT; const float* gain; int K, N, k0, R0, src0; bool valid, perm; };
__device__ __forceinline__ TrDesc tr_make(const float* W, int K, int N, int Npad, bf16_t* WT, const float* gain, int mode, int nheads, int nperm, int item) {
    TrDesc d; d.W = W; d.WT = WT; d.gain = gain; d.K = K; d.N = N;
    const int nblk = Npad >> 5, kb = item / nblk, nb = item - kb * nblk; d.k0 = 64 * kb; d.R0 = 32 * nb; d.src0 = d.R0; d.valid = true; d.perm = false;
    if (mode == 1) { const int pn = d.R0 >> 8, c = d.R0 & 255, bj = c >> 7, wc = (c >> 5) & 3, hcol = 4 * pn + wc; d.valid = hcol < nheads; d.perm = hcol < nperm; d.src0 = hcol * 64 + 32 * bj; }
    return d;
}
__device__ __forceinline__ TrDesc tr_decode(const Params& p, int it) {
    bf16_t* WB = (bf16_t*)(p.ws + WS_W);
    const float* attn_norm = p.in[1]; const float* mlp_norm = p.in[2];
    constexpr int I_QA = 16 * (1536 / 32), I_QB = 16 * (2048 / 32), I_WO = 16 * 32, I_WOB = 18 * 32, I_W1 = 16 * 128, I_W2 = 64 * 32;
    int r = it;
    if (r < I_QA) return tr_make(p.in[3], 1024, 1536, 1536, WB + WE_QKV0, attn_norm + 0 * DM, 1, 24, 20, r); r -= I_QA;
    if (r < I_QB) return tr_make(p.in[7], 1024, 1920, 2048, WB + WE_QKV1, attn_norm + 1 * DM, 1, 30, 0, r); r -= I_QB;
    if (r < I_QA) return tr_make(p.in[9], 1024, 1536, 1536, WB + WE_QKV2, attn_norm + 2 * DM, 1, 24, 0, r); r -= I_QA;
    if (r < I_QA) return tr_make(p.in[3] + (size_t)1024 * 1536, 1024, 1536, 1536, WB + WE_QKV3, attn_norm + 3 * DM, 1, 24, 20, r); r -= I_QA;
    if (r < I_WO) return tr_make(p.in[6], 1024, 1024, 1024, WB + WE_WO0, nullptr, 0, 0, 0, r); r -= I_WO;
    if (r < I_WOB) return tr_make(p.in[8], 1152, 1024, 1024, WB + WE_WO1, nullptr, 0, 0, 0, r); r -= I_WOB;
    if (r < I_WO) return tr_make(p.in[11], 1024, 1024, 1024, WB + WE_WO2, nullptr, 0, 0, 0, r); r -= I_WO;
    if (r < I_WO) return tr_make(p.in[6] + (size_t)1024 * 1024, 1024, 1024, 1024, WB + WE_WO3, nullptr, 0, 0, 0, r); r -= I_WO;
    if (r < 4 * I_W1) { const int l = r / I_W1; return tr_make(p.in[12] + (size_t)l * 1024 * 4096, 1024, 4096, 4096, WB + WE_W1 + (size_t)l * 4096 * 1024, mlp_norm + l * DM, 0, 0, 0, r - l * I_W1); } r -= 4 * I_W1;
    { const int l = r / I_W2; return tr_make(p.in[13] + (size_t)l * 4096 * 1024, 4096, 1024, 1024, WB + WE_W2 + (size_t)l * 4096 * 1024, nullptr, 0, 0, 0, r - l * I_W2); }
}
__device__ __forceinline__ void tr_load(const TrDesc& d, int lane, float (&w)[32]) {
#pragma unroll
    for (int i = 0; i < 32; ++i) { const int kk = 2 * i + (lane >> 5); w[i] = d.valid ? d.W[(size_t)(d.k0 + kk) * d.N + d.src0 + (lane & 31)] : 0.f; }
}
__device__ __forceinline__ void tr_finish(const TrDesc& d, int lane, LAS float* scr, const float (&w)[32]) {
#pragma unroll
    for (int i = 0; i < 32; ++i) { const int kk = 2 * i + (lane >> 5); scr[kk * 33 + (lane & 31)] = w[i]; }
    const int c8 = lane & 7;
    f32x4 g0 = {1.f, 1.f, 1.f, 1.f}, g1 = {1.f, 1.f, 1.f, 1.f};
    if (d.gain) { g0 = *(const f32x4*)(d.gain + d.k0 + 8 * c8); g1 = *(const f32x4*)(d.gain + d.k0 + 8 * c8 + 4); }
    LDS_WAIT();
#pragma unroll
    for (int jj = 0; jj < 4; ++jj) {
        const int e = (lane >> 3) + 8 * jj;
        const int se = d.perm ? (16 * ((e >> 2) & 1) + 4 * (e >> 3) + (e & 3)) : e;
        const LAS float* s = scr + (8 * c8) * 33 + se;
        u32x4 o; o.x = cvt_pk_bf16(s[0 * 33] * g0[0], s[1 * 33] * g0[1]); o.y = cvt_pk_bf16(s[2 * 33] * g0[2], s[3 * 33] * g0[3]); o.z = cvt_pk_bf16(s[4 * 33] * g1[0], s[5 * 33] * g1[1]); o.w = cvt_pk_bf16(s[6 * 33] * g1[2], s[7 * 33] * g1[3]);
        *(u32x4*)(d.WT + (size_t)(d.R0 + e) * d.K + d.k0 + 8 * c8) = o;
    }
    LDS_WAIT();
}

__device__ __forceinline__ void prologue(const Params& p, LAS unsigned char* lds, int gw, int NGW, int wave, int lane) {
    float* ss = (float*)(p.ws + WS_SSP);
    LAS float* scr = (LAS float*)(lds + wave * 16384);
    constexpr int I_QA = 16 * (1536 / 32), I_QB = 16 * (2048 / 32), I_WO = 16 * 32, I_WOB = 18 * 32, I_W1 = 16 * 128, I_W2 = 64 * 32;
    constexpr int NITEMS = 3 * I_QA + I_QB + 3 * I_WO + I_WOB + 4 * I_W1 + 4 * I_W2;
    {
        int it = gw; TrDesc dA, dB; float wA[32], wB[32];
        if (it < NITEMS) { dA = tr_decode(p, it); tr_load(dA, lane, wA); }
        while (it < NITEMS) {
            const int n1 = it + NGW; if (n1 < NITEMS) { dB = tr_decode(p, n1); tr_load(dB, lane, wB); }
            tr_finish(dA, lane, scr, wA); it = n1; if (it >= NITEMS) break;
            const int n2 = it + NGW; if (n2 < NITEMS) { dA = tr_decode(p, n2); tr_load(dA, lane, wA); }
            tr_finish(dB, lane, scr, wB); it = n2;
        }
    }
    const float* x = p.in[0]; bf16_t* hb = (bf16_t*)(p.ws + WS_HB);
    for (int m0 = gw; m0 < MTOK; m0 += 4 * NGW) {
        f32x4 v[4][4];
#pragma unroll
        for (int r = 0; r < 4; ++r) { const int m = m0 + r * NGW; if (m < MTOK) { const f32x4* xr = (const f32x4*)(x + (size_t)m * DM) + lane;
#pragma unroll
            for (int j = 0; j < 4; ++j) v[r][j] = xr[64 * j]; } }
#pragma unroll
        for (int r = 0; r < 4; ++r) { const int m = m0 + r * NGW; if (m < MTOK) {
            float s = 0.f;
#pragma unroll
            for (int j = 0; j < 4; ++j) s += (v[r][j].x * v[r][j].x + v[r][j].y * v[r][j].y) + (v[r][j].z * v[r][j].z + v[r][j].w * v[r][j].w);
            s = wave_sum(s);
            u32x2* o8 = (u32x2*)(hb + (size_t)m * DM) + lane;
#pragma unroll
            for (int j = 0; j < 4; ++j) { u32x2 w; w.x = cvt_pk_bf16(v[r][j].x, v[r][j].y); w.y = cvt_pk_bf16(v[r][j].z, v[r][j].w); o8[64 * j] = w; }
            if (lane < 16) ss[(size_t)m * 16 + lane] = (lane == 0) ? s : 0.f; } }
    }
}

constexpr int AT_ROWB = 144, AT_TILEB = 64 * AT_ROWB, AT_BUFB = 2 * AT_TILEB;
template <int MODE> __device__ __forceinline__ void attn_phase(LAS unsigned char* lds, const bf16_t* __restrict__ Qg, const bf16_t* __restrict__ Kg, const bf16_t* __restrict__ Vg, bf16_t* Og, float* LSE, const float* __restrict__ sinks) {
    int tid_ = threadIdx.x; asm volatile("" : "+v"(tid_));
    const int tid = tid_, lane = tid & 63, wave = __builtin_amdgcn_readfirstlane(tid >> 6), r32 = lane & 31, hi = lane >> 5;
    constexpr int NQ = (MODE == 0) ? 2 : 1;
    constexpr int QU = 256 * NQ;
    constexpr int NUNITS = (MODE == 1) ? 3 * 768 : 2048 / NQ;
    constexpr int HQ = (MODE == 1) ? 6 : 16, HKV = (MODE == 1) ? 2 : 4, WIN = (MODE == 1) ? 64 : 128, OPITCH = (MODE == 1) ? 1152 : 1024;
    const int srow = tid >> 3, schunk = tid & 7;
    const unsigned sdst = (unsigned)(srow * AT_ROWB + schunk * 16);
    for (int un = blockIdx.x; un < NUNITS; un += gridDim.x) {
        int g = 0, vb, hq, qb;
        if (MODE == 1) { g = un / 768; const int r = un - g * 768; const int nqbs = 4 - 2 * g;   qb = r & ((1 << nqbs) - 1); const int r2 = r >> nqbs; hq = r2 % 6; vb = r2 / 6; }
        else if (MODE == 0) { qb = un & 7; hq = (un >> 3) & 15; vb = un >> 7; }
        else { qb = un & 15; hq = (un >> 4) & 15; vb = un >> 8; }
        const int gsh = 2 * g, lsh = 12 - gsh, L = 1 << lsh;
        const int kvh = (MODE == 1) ? hq / 3 : hq >> 2;
        const int q0 = qb * QU, qw = q0 + 32 * NQ * wave;
        const size_t gq = (MODE == 1) ? (size_t)g * ((size_t)NBATCH * 6 * SEQ * 64) : 0, gk = (MODE == 1) ? (size_t)g * ((size_t)NBATCH * 2 * SEQ * 64) : 0;
        bf16x8 qf[NQ][4];
#pragma unroll
        for (int j = 0; j < NQ; ++j) {
            const bf16_t* qp = Qg + gq + ((((size_t)(vb * HQ + hq)) << lsh) + qw + 32 * j + r32) * 64 + 8 * hi;
#pragma unroll
            for (int s = 0; s < 4; ++s) qf[j][s] = *(const bf16x8*)(qp + 16 * s);
        }
        const bf16_t* kbase = Kg + gk + (((size_t)(vb * HKV + kvh)) << lsh) * 64;
        const bf16_t* vbase = Vg + gk + ((((size_t)(vb * HKV + kvh)) * 64) << lsh);
        int lo = 0, hiT = L >> 6;
        if (MODE != 0) { lo = (q0 - WIN) >> 6; if (lo < 0) lo = 0; int h2 = ((q0 + 255 + WIN) >> 6) + 1; if (h2 < hiT) hiT = h2; }
        float slope2 = 0.f;
        if (MODE == 1) slope2 = exp2f(-8.0f * (float)(g * 6 + hq + 1) / 18.0f) * (float)(1 << gsh) * LOG2E;
        if (MODE == 2) slope2 = exp2f(-8.0f * (float)(hq + 1) / 16.0f) * LOG2E;
        float mrun[NQ], lrun[NQ];
        f32x16 oacc[NQ][2];
#pragma unroll
        for (int j = 0; j < NQ; ++j) {
            mrun[j] = NEG_BIG; lrun[j] = 0.f;
            if (MODE == 2) { mrun[j] = sinks[hq] * LOG2E; lrun[j] = (hi == 0) ? 1.f : 0.f; }
#pragma unroll
            for (int i = 0; i < 16; ++i) { oacc[j][0][i] = 0.f; oacc[j][1][i] = 0.f; }
        }
        u32x4 kreg, vreg;
        kreg = *(const u32x4*)(kbase + (size_t)lo * 4096 + tid * 8);
        vreg = *(const u32x4*)(vbase + ((size_t)srow << lsh) + lo * 64 + schunk * 8);
        *(LAS u32x4*)(lds + sdst) = kreg; *(LAS u32x4*)(lds + AT_TILEB + sdst) = vreg;
        __syncthreads();
        for (int kt = lo; kt < hiT; ++kt) {
            const int buf = (kt - lo) & 1;
            const bool more = (kt + 1 < hiT);
            if (more) {
                kreg = *(const u32x4*)(kbase + (size_t)(kt + 1) * 4096 + tid * 8);
                vreg = *(const u32x4*)(vbase + ((size_t)srow << lsh) + (kt + 1) * 64 + schunk * 8);
            }
            bool active = true;
            if (MODE != 0) active = !((64 * kt + 63 < qw - WIN) || (64 * kt > qw + 31 + WIN));
            if (active) {
                const LAS unsigned char* kl = lds + buf * AT_BUFB;
                const LAS unsigned char* vl = kl + AT_TILEB;
                f32x16 sacc[NQ][2];
#pragma unroll
                for (int kb = 0; kb < 2; ++kb) {
#pragma unroll
                    for (int j = 0; j < NQ; ++j)
#pragma unroll
                        for (int i = 0; i < 16; ++i) sacc[j][kb][i] = 0.f;
#pragma unroll
                    for (int s = 0; s < 4; ++s) {
                        const bf16x8 kf = *(const LAS bf16x8*)(kl + (32 * kb + r32) * AT_ROWB + (2 * s + hi) * 16);
#pragma unroll
                        for (int j = 0; j < NQ; ++j) sacc[j][kb] = __builtin_amdgcn_mfma_f32_32x32x16_bf16(kf, qf[j][s], sacc[j][kb], 0, 0, 0);
                    }
                }
                bf16x8 pf[NQ][2][2];
#pragma unroll
                for (int j = 0; j < NQ; ++j) {
                    if (MODE != 0) {
                        const float fd0 = (float)(64 * kt + 4 * hi - (qw + r32));
#pragma unroll
                        for (int kb = 0; kb < 2; ++kb)
#pragma unroll
                            for (int i = 0; i < 16; ++i) {
                                const float dist = fabsf(fd0 + (float)(32 * kb + 8 * (i >> 2) + (i & 3)));
                                sacc[j][kb][i] = (dist <= (float)WIN) ? (sacc[j][kb][i] - slope2 * dist) : NEG_BIG;
                            }
                    }
                    float mx = sacc[j][0][0];
#pragma unroll
                    for (int i = 1; i < 16; ++i) mx = fmaxf(mx, sacc[j][0][i]);
#pragma unroll
                    for (int i = 0; i < 16; ++i) mx = fmaxf(mx, sacc[j][1][i]);
                    mx = fmaxf(mx, __shfl_xor(mx, 32));
                    if (__builtin_amdgcn_ballot_w64(mx > mrun[j]) != 0ull) {
                        const float mnew = fmaxf(mrun[j], mx);
                        const float alpha = __builtin_amdgcn_exp2f(mrun[j] - mnew);
                        mrun[j] = mnew;
                        lrun[j] *= alpha;
#pragma unroll
                        for (int i = 0; i < 16; ++i) { oacc[j][0][i] *= alpha; oacc[j][1][i] *= alpha; }
                    }
                    const float mcur = mrun[j];
                    float ps = 0.f;
#pragma unroll
                    for (int kb = 0; kb < 2; ++kb)
#pragma unroll
                        for (int i = 0; i < 16; ++i) { const float pv = __builtin_amdgcn_exp2f(sacc[j][kb][i] - mcur); sacc[j][kb][i] = pv; ps += pv; }
                    lrun[j] += ps;
#pragma unroll
                    for (int kb = 0; kb < 2; ++kb)
#pragma unroll
                        for (int hh = 0; hh < 2; ++hh) {
                            u32x4 w; w.x = cvtpk_s(sacc[j][kb][8 * hh + 0], sacc[j][kb][8 * hh + 1]); w.y = cvtpk_s(sacc[j][kb][8 * hh + 2], sacc[j][kb][8 * hh + 3]);
                            w.z = cvtpk_s(sacc[j][kb][8 * hh + 4], sacc[j][kb][8 * hh + 5]); w.w = cvtpk_s(sacc[j][kb][8 * hh + 6], sacc[j][kb][8 * hh + 7]);
                            pf[j][kb][hh] = __builtin_bit_cast(bf16x8, w);
                        }
                }
#pragma unroll
                for (int db = 0; db < 2; ++db)
#pragma unroll
                    for (int kb = 0; kb < 2; ++kb)
#pragma unroll
                        for (int hh = 0; hh < 2; ++hh) {
                            const bf16x8 vf = *(const LAS bf16x8*)(vl + (32 * db + r32) * AT_ROWB + (2 * (2 * kb + hh) + hi) * 16);
#pragma unroll
                            for (int j = 0; j < NQ; ++j) oacc[j][db] = __builtin_amdgcn_mfma_f32_32x32x16_bf16(vf, pf[j][kb][hh], oacc[j][db], 0, 0, 0);
                        }
            }
            if (more) {
                LAS unsigned char* nb = lds + (buf ^ 1) * AT_BUFB;
                *(LAS u32x4*)(nb + sdst) = kreg; *(LAS u32x4*)(nb + AT_TILEB + sdst) = vreg;
            }
            __syncthreads();
        }
#pragma unroll
        for (int j = 0; j < NQ; ++j) {
            const float ltot = lrun[j] + __shfl_xor(lrun[j], 32);
            const float inv = 1.0f / ltot;
            int row, hglob;
            if (MODE == 1) { const int dmask = (1 << gsh) - 1; const int b = vb >> gsh, rr = vb & dmask; row = b * SEQ + rr + ((qw + r32) << gsh); hglob = g * 6 + hq; }
            else { row = vb * SEQ + qw + 32 * j + r32; hglob = hq; }
            bf16_t* op = Og + (size_t)row * OPITCH + hglob * 64 + 4 * hi;
#pragma unroll
            for (int db = 0; db < 2; ++db)
#pragma unroll
                for (int q4 = 0; q4 < 4; ++q4) {
                    u32x2 w; w.x = cvtpk_s(oacc[j][db][4 * q4 + 0] * inv, oacc[j][db][4 * q4 + 1] * inv); w.y = cvtpk_s(oacc[j][db][4 * q4 + 2] * inv, oacc[j][db][4 * q4 + 3] * inv);
                    *(u32x2*)(op + 32 * db + 8 * q4) = w;
                }
            if (MODE == 1) { if (hi == 0) LSE[(size_t)row * 18 + hglob] = mrun[j] + __builtin_amdgcn_logf(ltot); }
        }
    }
}

__device__ __forceinline__ void attn_dense_fast(LAS unsigned char* lds, const bf16_t* __restrict__ Qg, const bf16_t* __restrict__ Kg, const bf16_t* __restrict__ Vg, bf16_t* Og) {
    int tid_ = threadIdx.x; asm volatile("" : "+v"(tid_));
    const int tid = tid_, lane = tid & 63, wave = __builtin_amdgcn_readfirstlane(tid >> 6), r32 = lane & 31, hi = lane >> 5;
    constexpr int NQ = 2, NUNITS = 1024, NT = SEQ / 64;
    constexpr int VRING = 2 * AT_TILEB;
    const int srow = tid >> 3, schunk = tid & 7;
    const unsigned sdst = (unsigned)(srow * AT_ROWB + schunk * 16);
    { unsigned z = 0u; asm volatile("" : "+v"(z));
      for (int i = tid; i < 3 * AT_TILEB / 16; i += 512) *(LAS u32x4*)(lds + VRING + i * 16) = (u32x4){z, z, z, z}; }
    __syncthreads();
    for (int un = blockIdx.x; un < NUNITS; un += gridDim.x) {
        const int qb = un & 7, hq = (un >> 3) & 15, vb = un >> 7, kvh = hq >> 2;
        const int qw = qb * 512 + 64 * wave;
        bf16x8 qf[NQ][4];
#pragma unroll
        for (int j = 0; j < NQ; ++j) {
            const bf16_t* qp = Qg + ((size_t)(vb * 16 + hq) * SEQ + qw + 32 * j + r32) * 64 + 8 * hi;
#pragma unroll
            for (int s = 0; s < 4; ++s) qf[j][s] = *(const bf16x8*)(qp + 16 * s);
        }
        const char* kbu = (const char*)(Kg + (size_t)(vb * 4 + kvh) * SEQ * 64);
        const char* vbu = (const char*)(Vg + (size_t)(vb * 4 + kvh) * 64 * SEQ);
        const unsigned kof = (unsigned)tid * 16u, vof = (unsigned)(srow * SEQ + schunk * 8) * 2u;
        float lsum[NQ]; f32x16 oacc[NQ][2]; bf16x8 pfp[NQ][2][2];
#pragma unroll
        for (int j = 0; j < NQ; ++j) {
            lsum[j] = 0.f;
#pragma unroll
            for (int i = 0; i < 16; ++i) { oacc[j][0][i] = 0.f; oacc[j][1][i] = 0.f; }
#pragma unroll
            for (int kb = 0; kb < 2; ++kb)
#pragma unroll
                for (int hh = 0; hh < 2; ++hh) pfp[j][kb][hh] = (bf16x8){0, 0, 0, 0, 0, 0, 0, 0};
        }
        u32x4 kreg = *(const u32x4*)(kbu + kof), vreg = *(const u32x4*)(vbu + vof);
        *(LAS u32x4*)(lds + sdst) = kreg; *(LAS u32x4*)(lds + VRING + sdst) = vreg;
        __syncthreads();
        int vprev = VRING + 2 * AT_TILEB, vcur = VRING, vnext = VRING + AT_TILEB;
        f32x16 sB[NQ];
#pragma unroll
        for (int j = 0; j < NQ; ++j)
#pragma unroll
            for (int i = 0; i < 16; ++i) sB[j][i] = NEG_BIG;
#pragma unroll 1
        for (int kt = 0; kt < NT; ++kt) {
            const int tn = (kt + 1 < NT) ? kt + 1 : kt;
            kreg = *(const u32x4*)(kbu + (size_t)tn * 8192 + kof);
            vreg = *(const u32x4*)(vbu + (size_t)tn * 128 + vof);
            const LAS unsigned char* kl = lds + (kt & 1) * AT_TILEB;
            const LAS unsigned char* vl = lds + vprev;
#define AF_QK(dst, kb) do { _Pragma("unroll") for (int j = 0; j < NQ; ++j) _Pragma("unroll") for (int i = 0; i < 16; ++i) dst[j][i] = 0.f; \
            _Pragma("unroll") for (int s = 0; s < 4; ++s) { const bf16x8 kf = *(const LAS bf16x8*)(kl + (32 * (kb) + r32) * AT_ROWB + (2 * s + hi) * 16); \
                _Pragma("unroll") for (int j = 0; j < NQ; ++j) dst[j] = __builtin_amdgcn_mfma_f32_32x32x16_bf16(kf, qf[j][s], dst[j], 0, 0, 0); } } while (0)
#define AF_PV(kb) do { _Pragma("unroll") for (int hh = 0; hh < 2; ++hh) _Pragma("unroll") for (int db = 0; db < 2; ++db) { \
            const bf16x8 vf = *(const LAS bf16x8*)(vl + (32 * db + r32) * AT_ROWB + (2 * (2 * (kb) + hh) + hi) * 16); \
            _Pragma("unroll") for (int j = 0; j < NQ; ++j) oacc[j][db] = __builtin_amdgcn_mfma_f32_32x32x16_bf16(vf, pfp[j][kb][hh], oacc[j][db], 0, 0, 0); } } while (0)
#define AF_EXP(src, kb) do { _Pragma("unroll") for (int j = 0; j < NQ; ++j) { float ps = 0.f; \
            _Pragma("unroll") for (int i = 0; i < 16; ++i) { const float pv = __builtin_amdgcn_exp2f(src[j][i]); src[j][i] = pv; ps += pv; } \
            lsum[j] += ps; \
            _Pragma("unroll") for (int hh = 0; hh < 2; ++hh) { u32x4 w; w.x = cvtpk_s(src[j][8 * hh + 0], src[j][8 * hh + 1]); w.y = cvtpk_s(src[j][8 * hh + 2], src[j][8 * hh + 3]); \
                w.z = cvtpk_s(src[j][8 * hh + 4], src[j][8 * hh + 5]); w.w = cvtpk_s(src[j][8 * hh + 6], src[j][8 * hh + 7]); pfp[j][kb][hh] = __builtin_bit_cast(bf16x8, w); } } } while (0)
#define AF_SCHED() do { _Pragma("unroll") for (int q_ = 0; q_ < 16; ++q_) { __builtin_amdgcn_sched_group_barrier(0x008, 1, 0); __builtin_amdgcn_sched_group_barrier(0x400, 2, 0); \
            __builtin_amdgcn_sched_group_barrier(0x002, 3, 0); __builtin_amdgcn_sched_group_barrier(0x100, 1, 0); } } while (0)
            f32x16 sA[NQ];
            AF_QK(sA, 0); AF_PV(0); AF_EXP(sB, 1);
            AF_SCHED();
            AF_QK(sB, 1); AF_PV(1); AF_EXP(sA, 0);
            AF_SCHED();
            *(LAS u32x4*)(lds + ((kt + 1) & 1) * AT_TILEB + sdst) = kreg; *(LAS u32x4*)(lds + vnext + sdst) = vreg;
            { const int tmp = vprev; vprev = vcur; vcur = vnext; vnext = tmp; }
            __syncthreads();
        }
        {
            const LAS unsigned char* vl = lds + vprev;
            AF_EXP(sB, 1);
            AF_PV(0); AF_PV(1);
        }
        __syncthreads();
#pragma unroll
        for (int j = 0; j < NQ; ++j) {
            const float ltot = lsum[j] + __shfl_xor(lsum[j], 32);
            const float inv = 1.0f / ltot;
            const int row = vb * SEQ + qw + 32 * j + r32;
            bf16_t* op = Og + (size_t)row * 1024 + hq * 64 + 4 * hi;
#pragma unroll
            for (int db = 0; db < 2; ++db)
#pragma unroll
                for (int q4 = 0; q4 < 4; ++q4) {
                    u32x2 w; w.x = cvtpk_s(oacc[j][db][4 * q4 + 0] * inv, oacc[j][db][4 * q4 + 1] * inv); w.y = cvtpk_s(oacc[j][db][4 * q4 + 2] * inv, oacc[j][db][4 * q4 + 3] * inv);
                    *(u32x2*)(op + 32 * db + 8 * q4) = w;
                }
        }
    }
}

template <int MODE> __device__ __forceinline__ void attn_banded(const bf16_t* __restrict__ Qg, const bf16_t* __restrict__ Kg, const bf16_t* __restrict__ Vg, bf16_t* Og, float* LSE, const float* __restrict__ sinks, int gw, int NGW) {
    int lane = threadIdx.x & 63; asm volatile("" : "+v"(lane));
    const int r32 = lane & 31, hi = lane >> 5;
    constexpr int HQ = (MODE == 1) ? 6 : 16, HKV = (MODE == 1) ? 2 : 4, WIN = (MODE == 1) ? 64 : 128, OPITCH = (MODE == 1) ? 1152 : 1024;
    constexpr int NITEMS = (MODE == 1) ? 3 * 6144 : 16384;
    for (int it = gw; it < NITEMS; it += NGW) {
        int g = 0, vb, hq, qblk;
        if (MODE == 1) { g = it / 6144; const int r = it - g * 6144; const int nqs = 7 - 2 * g;   qblk = r & ((1 << nqs) - 1); const int r2 = r >> nqs; hq = r2 % 6; vb = r2 / 6; }
        else { qblk = it & 127; hq = (it >> 7) & 15; vb = it >> 11; }
        const int gsh = 2 * g, lsh = 12 - gsh, L = 1 << lsh;
        const int kvh = (MODE == 1) ? hq / 3 : hq >> 2;
        const int qw = qblk * 32;
        const size_t gq = (MODE == 1) ? (size_t)g * ((size_t)NBATCH * 6 * SEQ * 64) : 0, gk = (MODE == 1) ? (size_t)g * ((size_t)NBATCH * 2 * SEQ * 64) : 0;
        bf16x8 qf[4];
        { const bf16_t* qp = Qg + gq + ((((size_t)(vb * HQ + hq)) << lsh) + qw + r32) * 64 + 8 * hi;
#pragma unroll
          for (int s = 0; s < 4; ++s) qf[s] = *(const bf16x8*)(qp + 16 * s); }
        const char* kp = (const char*)(Kg + gk + (((size_t)(vb * HKV + kvh)) << lsh) * 64) + lane * 16;
        const char* vp = (const char*)(Vg + gk + ((((size_t)(vb * HKV + kvh)) * 64) << lsh)) + lane * 16;
        int lo = (qw - WIN) >> 6; if (lo < 0) lo = 0;
        int hiT = ((qw + 31 + WIN) >> 6) + 1; if (hiT > (L >> 6)) hiT = L >> 6;
        float slope2;
        if (MODE == 1) slope2 = exp2f(-8.0f * (float)(g * 6 + hq + 1) / 18.0f) * (float)(1 << gsh) * LOG2E;
        else slope2 = exp2f(-8.0f * (float)(hq + 1) / 16.0f) * LOG2E;
        float mrun = NEG_BIG, lrun = 0.f;
        if (MODE == 2) { mrun = sinks[hq] * LOG2E; lrun = (hi == 0) ? 1.f : 0.f; }
        f32x16 oacc[2];
#pragma unroll
        for (int i = 0; i < 16; ++i) { oacc[0][i] = 0.f; oacc[1][i] = 0.f; }
        bf16x8 kf[2][4], vf[2][2][2];
#define AB_LDK(t_) do { const char* b_ = kp + (size_t)(t_) * 8192; _Pragma("unroll") for (int kb = 0; kb < 2; ++kb) _Pragma("unroll") for (int s = 0; s < 4; ++s) kf[kb][s] = *(const bf16x8*)(b_ + kb * 4096 + s * 1024); } while (0)
#define AB_LDV(t_) do { const char* b_ = vp + (size_t)(t_) * 8192; _Pragma("unroll") for (int db = 0; db < 2; ++db) _Pragma("unroll") for (int kb = 0; kb < 2; ++kb) _Pragma("unroll") for (int hh = 0; hh < 2; ++hh) \
            vf[db][kb][hh] = *(const bf16x8*)(b_ + db * 4096 + (2 * kb + hh) * 1024); } while (0)
        AB_LDK(lo); AB_LDV(lo);
#pragma unroll 1
        for (int kt = lo; kt < hiT; ++kt) {
            const int tn = (kt + 1 < hiT) ? kt + 1 : kt;
            f32x16 sacc[2];
#pragma unroll
            for (int kb = 0; kb < 2; ++kb) {
#pragma unroll
                for (int i = 0; i < 16; ++i) sacc[kb][i] = 0.f;
#pragma unroll
                for (int s = 0; s < 4; ++s) sacc[kb] = __builtin_amdgcn_mfma_f32_32x32x16_bf16(kf[kb][s], qf[s], sacc[kb], 0, 0, 0);
            }
            AB_LDK(tn);
            {
                const float fd0 = (float)(64 * kt + 4 * hi - (qw + r32));
#pragma unroll
                for (int kb = 0; kb < 2; ++kb)
#pragma unroll
                    for (int i = 0; i < 16; ++i) {
                        const float dist = fabsf(fd0 + (float)(32 * kb + 8 * (i >> 2) + (i & 3)));
                        sacc[kb][i] = (dist <= (float)WIN) ? (sacc[kb][i] - slope2 * dist) : NEG_BIG;
                    }
            }
            float mx = sacc[0][0];
#pragma unroll
            for (int i = 1; i < 16; ++i) mx = fmaxf(mx, sacc[0][i]);
#pragma unroll
            for (int i = 0; i < 16; ++i) mx = fmaxf(mx, sacc[1][i]);
            mx = fmaxf(mx, __shfl_xor(mx, 32));
            if (__builtin_amdgcn_ballot_w64(mx > mrun) != 0ull) {
                const float mnew = fmaxf(mrun, mx);
                const float alpha = __builtin_amdgcn_exp2f(mrun - mnew);
                mrun = mnew; lrun *= alpha;
#pragma unroll
                for (int i = 0; i < 16; ++i) { oacc[0][i] *= alpha; oacc[1][i] *= alpha; }
            }
            const float mcur = mrun;
            float ps = 0.f;
#pragma unroll
            for (int kb = 0; kb < 2; ++kb)
#pragma unroll
                for (int i = 0; i < 16; ++i) { const float pv = __builtin_amdgcn_exp2f(sacc[kb][i] - mcur); sacc[kb][i] = pv; ps += pv; }
            lrun += ps;
            bf16x8 pf[2][2];
#pragma unroll
            for (int kb = 0; kb < 2; ++kb)
#pragma unroll
                for (int hh = 0; hh < 2; ++hh) {
                    u32x4 w; w.x = cvtpk_s(sacc[kb][8 * hh + 0], sacc[kb][8 * hh + 1]); w.y = cvtpk_s(sacc[kb][8 * hh + 2], sacc[kb][8 * hh + 3]);
                    w.z = cvtpk_s(sacc[kb][8 * hh + 4], sacc[kb][8 * hh + 5]); w.w = cvtpk_s(sacc[kb][8 * hh + 6], sacc[kb][8 * hh + 7]);
                    pf[kb][hh] = __builtin_bit_cast(bf16x8, w);
                }
#pragma unroll
            for (int db = 0; db < 2; ++db)
#pragma unroll
                for (int kb = 0; kb < 2; ++kb)
#pragma unroll
                    for (int hh = 0; hh < 2; ++hh) oacc[db] = __builtin_amdgcn_mfma_f32_32x32x16_bf16(vf[db][kb][hh], pf[kb][hh], oacc[db], 0, 0, 0);
            AB_LDV(tn);
        }
#undef AB_LDK
#undef AB_LDV
        const float ltot = lrun + __shfl_xor(lrun, 32);
        const float inv = 1.0f / ltot;
        int row, hglob;
        if (MODE == 1) { const int dmask = (1 << gsh) - 1; const int b = vb >> gsh, rr = vb & dmask; row = b * SEQ + rr + ((qw + r32) << gsh); hglob = g * 6 + hq; }
        else { row = vb * SEQ + qw + r32; hglob = hq; }
        bf16_t* op = Og + (size_t)row * OPITCH + hglob * 64 + 4 * hi;
#pragma unroll
        for (int db = 0; db < 2; ++db)
#pragma unroll
            for (int q4 = 0; q4 < 4; ++q4) {
                u32x2 w; w.x = cvtpk_s(oacc[db][4 * q4 + 0] * inv, oacc[db][4 * q4 + 1] * inv); w.y = cvtpk_s(oacc[db][4 * q4 + 2] * inv, oacc[db][4 * q4 + 3] * inv);
                *(u32x2*)(op + 32 * db + 8 * q4) = w;
            }
        if (MODE == 1) { if (hi == 0) LSE[(size_t)row * 18 + hglob] = mrun + __builtin_amdgcn_logf(ltot); }
    }
}

__device__ __forceinline__ void mixb_fix(bf16_t* Og, const float* LSE, int gw, int NGW, int lane) {
    asm volatile("" : "+v"(lane));
    for (int m = gw; m < MTOK; m += NGW) {
        const float* ls = LSE + (size_t)m * 18;
#pragma unroll
        for (int c3 = 0; c3 < 3; ++c3) {
            const int c = lane + 64 * c3;
            if (c < 144) {
                const int head = c >> 3, g = head / 6, kr = head - 6 * g;
                const float l0 = ls[kr], l1 = ls[6 + kr], l2 = ls[12 + kr];
                const float mx = fmaxf(l0, fmaxf(l1, l2));
                const float e0 = exp2f(l0 - mx), e1 = exp2f(l1 - mx), e2 = exp2f(l2 - mx);
                const float a = ((g == 0) ? e0 : (g == 1) ? e1 : e2) / (e0 + e1 + e2);
                u32x4* pp = (u32x4*)(Og + (size_t)m * 1152) + c;
                u32x4 w = *pp;
                unsigned ww[4] = {w.x, w.y, w.z, w.w};
#pragma unroll
                for (int k = 0; k < 4; ++k) { const float f0 = __builtin_bit_cast(float, ww[k] << 16) * a, f1 = __builtin_bit_cast(float, ww[k] & 0xffff0000u) * a; ww[k] = cvt_pk_bf16(f0, f1); }
                w.x = ww[0]; w.y = ww[1]; w.z = ww[2]; w.w = ww[3];
                *pp = w;
            }
        }
    }
}

#define XB_TMO      128
#define XB_XCNT(j)  (256  + 64 * (j))
#define XB_XSUB(j)  (1280 + 64 * (j))
#define XB_XGEN(j)  (2304 + 64 * (j))
#define XB_TOP      3328
#define XB_TOPGEN   3392
#define XCD_BAR_WORDS 3456
#define XB_SPIN_CAP (1u << 18)

__device__ __forceinline__ unsigned xb_ld(unsigned* p)              { return __hip_atomic_load(p, __ATOMIC_RELAXED, __HIP_MEMORY_SCOPE_AGENT); }
__device__ __forceinline__ unsigned xb_add(unsigned* p, unsigned v) { return __hip_atomic_fetch_add(p, v, __ATOMIC_RELAXED, __HIP_MEMORY_SCOPE_AGENT); }
__device__ __forceinline__ unsigned xb_xcc_id() { return (unsigned)__builtin_amdgcn_s_getreg((3 << 11) | 20) & 0xFu; }
#define XB_SPIN(cond, bar) do { unsigned _sp = 0; while (cond) { __builtin_amdgcn_s_sleep(1); \
    if ((++_sp & 255u) == 0u) { if (xb_ld(&(bar)[XB_TMO])) break; if (_sp > XB_SPIN_CAP) { atomicAdd(&(bar)[XB_TMO], 1u); break; } } } } while (0)

struct XcdBarrier {
    unsigned* bar; unsigned x;
    volatile LAS unsigned* st;
};

__device__ __forceinline__ XcdBarrier xcd_barrier_post(unsigned* bar, volatile LAS unsigned* st) {
    XcdBarrier b; b.bar = bar; b.x = xb_xcc_id(); b.st = st;
    if (threadIdx.x == 0) (void)xb_add(&bar[XB_XCNT(b.x)], 1u);
    return b;
}
__device__ __forceinline__ void xcd_barrier_complete(unsigned* bar, unsigned x, unsigned& nloc, unsigned& nx) {
    const unsigned G = gridDim.x * gridDim.y * gridDim.z;
    unsigned sum, cnt, mine, sp = 0u;
    for (;;) {
        sum = 0u; cnt = 0u; mine = 0u;
#pragma unroll
        for (unsigned j = 0; j < 16; ++j) { const unsigned c = xb_ld(&bar[XB_XCNT(j)]); sum += c; cnt += (c > 0u) ? 1u : 0u; mine = (j == x) ? c : mine; }
        if (sum == G) break;
        __builtin_amdgcn_s_sleep(1);
        if ((++sp & 255u) == 0u) { if (xb_ld(&bar[XB_TMO])) break; if (sp > XB_SPIN_CAP) { atomicAdd(&bar[XB_TMO], 1u); break; } }
    }
    nloc = mine > 0u ? mine : 1u; nx = cnt > 0u ? cnt : 1u;
}

__device__ __forceinline__ void xcd_barrier(const XcdBarrier& b) {
    asm volatile("s_waitcnt vmcnt(0)" ::: "memory");
    __syncthreads();
    if (threadIdx.x == 0) {
        unsigned* bar = b.bar;
        __builtin_amdgcn_s_waitcnt(0);
        unsigned nloc = b.st[0], nx = b.st[1];
        if (nloc == 0u) { xcd_barrier_complete(bar, b.x, nloc, nx); b.st[0] = nloc; b.st[1] = nx; }
        const unsigned old = xb_add(&bar[XB_XSUB(b.x)], 1u);
        const unsigned gen = old / nloc;
        if (old + 1u == (gen + 1u) * nloc) {
            __builtin_amdgcn_fence(__ATOMIC_RELEASE, "agent");
            asm volatile("s_waitcnt vmcnt(0)" ::: "memory");
            const unsigned og = xb_add(&bar[XB_TOP], 1u);
            const unsigned tg = og / nx;
            if (og + 1u == (tg + 1u) * nx) xb_add(&bar[XB_TOPGEN], 1u);
            else XB_SPIN(xb_ld(&bar[XB_TOPGEN]) == tg, bar);
            __builtin_amdgcn_fence(__ATOMIC_ACQUIRE, "agent");
            xb_add(&bar[XB_XGEN(b.x)], 1u);
            asm volatile("s_waitcnt vmcnt(0)" ::: "memory");
        } else {
            XB_SPIN(xb_ld(&bar[XB_XGEN(b.x)]) == gen, bar);
            __builtin_amdgcn_fence(__ATOMIC_ACQUIRE, "agent");
            asm volatile("s_waitcnt vmcnt(0)" ::: "memory");
        }
    }
    __syncthreads();
}

__device__ __forceinline__ void fill_rstd(LAS unsigned char* lds, const pg8::StaticOrder& S, const float* ssp) {
    LAS float* rs = (LAS float*)(lds + LDS_RSTD);
    int tid = threadIdx.x; asm volatile("" : "+v"(tid));
    for (int i0 = 0; i0 < 8; i0 += 2) {
        pg8::Unit u; const int i = i0 + (tid >> 8);
        if (S.next(i, u)) rs[i * 256 + (tid & 255)] = __builtin_amdgcn_rsqf(row_ss(ssp, u.pm * 256 + (tid & 255)) * (1.0f / DM) + RMS_EPS);
    }
    __syncthreads();
}

__global__ void __launch_bounds__(512, 2) fwd_kernel(Params p) {
    extern __shared__ __attribute__((aligned(16))) unsigned char lds_raw[];
    LAS unsigned char* lds = (LAS unsigned char*)lds_raw;
    cg::grid_group grid = cg::this_grid();
    volatile LAS unsigned* xst = (volatile LAS unsigned*)(lds + LDS_BYTES - 64);
    if (threadIdx.x < 2) xst[threadIdx.x] = 0u;
    __syncthreads();
    XcdBarrier xbar = xcd_barrier_post((unsigned*)(p.ws + WS_BAR), xst);
    {
        LAS float* rope = (LAS float*)(lds + LDS_ROPE); LAS float* gl = (LAS float*)(lds + LDS_GAIN);
        for (int i = threadIdx.x; i < 1024; i += 512) { const int pos = i >> 4, f = i & 15; const float ang = (float)pos * exp2f(-(float)f * 0.83048202372184059f); rope[2 * i] = cosf(ang); rope[2 * i + 1] = sinf(ang); }
        if (threadIdx.x < 256) { const int i = threadIdx.x, ja = i >> 7, qk = (i >> 6) & 1, d = i & 63; gl[i] = (qk == 0 ? p.in[4] : p.in[5])[ja * 64 + d]; }
    }
#define GRID_SYNC() do { asm volatile("s_waitcnt vmcnt(0) lgkmcnt(0)" ::: "memory"); grid.sync(); asm volatile("buffer_inv sc1\n\ts_waitcnt vmcnt(0)" ::: "memory"); GRID_SYNC2(); } while (0)
#define XBAR_SYNC() do { xcd_barrier(xbar); asm volatile("buffer_inv sc1\n\ts_waitcnt vmcnt(0)" ::: "memory"); } while (0)
#ifdef PROBE_DUP_SYNC
#define GRID_SYNC2() do { grid.sync(); asm volatile("buffer_inv sc1\n\ts_waitcnt vmcnt(0)" ::: "memory"); } while (0)
#else
#define GRID_SYNC2() do { } while (0)
#endif
    const int wave = __builtin_amdgcn_readfirstlane((int)threadIdx.x >> 6);
#define LANE() ({ int l_ = (int)threadIdx.x & 63; asm volatile("" : "+v"(l_)); l_; })
    const int G = gridDim.x, gw = blockIdx.x * 8 + wave, NGW = G * 8;
    unsigned char* ws = p.ws;
#define GAS __attribute__((address_space(1)))
#define WSP() ({ GAS unsigned char* q_ = (GAS unsigned char*)ws; asm volatile("" : "+s"(q_)); (unsigned char*)q_; })
#define SSP(i) ((float*)(WSP() + WS_SSP) + (size_t)(i) * MTOK * 16)
#define LSE_ ((float*)(WSP() + WS_LSE))
#define WB_ ((bf16_t*)(WSP() + WS_W))
#define HB_ ((bf16_t*)(WSP() + WS_HB))
#define U_ ((bf16_t*)(WSP() + WS_U))
#define Qb_ ((bf16_t*)(WSP() + WS_Q))
#define Kb_ ((bf16_t*)(WSP() + WS_K))
#define Vb_ ((bf16_t*)(WSP() + WS_VT))
#define Ob_ ((bf16_t*)(WSP() + WS_O))
    float* h = p.out;

#ifndef PHMASK
#define PHMASK 0xffff
#endif
    if (PHMASK & 1) prologue(p, lds, gw, NGW, wave, LANE());
#ifdef PROBE_DUP_PRO
    __syncthreads(); prologue(p, lds, gw, NGW, wave, LANE());
#endif
    GRID_SYNC();

#pragma unroll 1
    for (int layer = 0; layer < 4; ++layer) {
        const int kind = (layer == 3) ? 0 : layer;
        const int ja = (layer == 3) ? 1 : 0;
        const size_t weq = (layer == 0) ? WE_QKV0 : (layer == 1) ? WE_QKV1 : (layer == 2) ? WE_QKV2 : WE_QKV3;
        const size_t weo = (layer == 0) ? WE_WO0 : (layer == 1) ? WE_WO1 : (layer == 2) ? WE_WO2 : WE_WO3;
        if (kind == 0 && (PHMASK & 2)) {
            pg8::Gemm g{HB_, WB_ + weq, MTOK, 1536, DM}; pg8::StaticOrder S; S.init(MTOK, 1536, G, (int)blockIdx.x);
            fill_rstd(lds, S, SSP(2 * layer));
            pg8::EpiQKV<0> E{WSP(), lds, ja, 0};
            pg8::gemm_phase<pg8::EpiQKV<0>, pg8::StaticOrder, true, true>(lds, g, S, E);
        } else if (kind == 1 && (PHMASK & 4)) {
            pg8::Gemm g{HB_, WB_ + weq, MTOK, 2048, DM}; pg8::StaticOrder S; S.init(MTOK, 2048, G, (int)blockIdx.x);
            fill_rstd(lds, S, SSP(2 * layer));
            pg8::EpiQKV<1> E{WSP(), lds, 0, 0};
            pg8::gemm_phase<pg8::EpiQKV<1>, pg8::StaticOrder, true, true>(lds, g, S, E);
        } else if (kind == 2 && (PHMASK & 8)) {
            pg8::Gemm g{HB_, WB_ + weq, MTOK, 1536, DM}; pg8::StaticOrder S; S.init(MTOK, 1536, G, (int)blockIdx.x);
            fill_rstd(lds, S, SSP(2 * layer));
            pg8::EpiQKV<2> E{WSP(), lds, 0, 0};
            pg8::gemm_phase<pg8::EpiQKV<2>, pg8::StaticOrder, true, true>(lds, g, S, E);
        }
        XBAR_SYNC();
        if (kind == 0) {
            const LAS float* gl = (const LAS float*)(lds + LDS_GAIN) + ja * 128;
            int lane3 = threadIdx.x & 63; asm volatile("" : "+v"(lane3));
            float gq = fabsf(gl[lane3]), gk = fabsf(gl[64 + lane3]);
#pragma unroll
            for (int o = 1; o < 64; o <<= 1) { gq = fmaxf(gq, __shfl_xor(gq, o)); gk = fmaxf(gk, __shfl_xor(gk, o)); }
            const bool fastp = __builtin_amdgcn_readfirstlane((QSCALE * 64.0f * gq * gk <= 60.0f) ? 1 : 0) != 0;
            if (fastp) { if (PHMASK & 16) attn_dense_fast(lds, Qb_, Kb_, Vb_, Ob_); }
            else if (PHMASK & 16) attn_phase<0>(lds, Qb_, Kb_, Vb_, Ob_, LSE_, nullptr);
#ifdef PROBE_DUP_A
            __syncthreads(); attn_phase<0>(lds, Qb_, Kb_, Vb_, Ob_, LSE_, nullptr);
#endif
        }
        else if (kind == 1) { if (PHMASK & 32) attn_banded<1>(Qb_, Kb_, Vb_, Ob_, LSE_, nullptr, gw, NGW);
#ifdef PROBE_DUP_BC
            __syncthreads(); attn_phase<1>(lds, Qb_, Kb_, Vb_, Ob_, LSE_, nullptr);
#endif
            XBAR_SYNC(); mixb_fix(Ob_, LSE_, gw, NGW, LANE()); }
        else { if (PHMASK & 64) attn_banded<2>(Qb_, Kb_, Vb_, Ob_, LSE_, p.in[10], gw, NGW);
#ifdef PROBE_DUP_BC
            __syncthreads(); attn_phase<2>(lds, Qb_, Kb_, Vb_, Ob_, LSE_, p.in[10]);
#endif
        }
        XBAR_SYNC();
        if (PHMASK & 128) {
            const int Ko = (kind == 1) ? 1152 : 1024;
            pg8::Gemm g{Ob_, WB_ + weo, MTOK, DM, Ko}; pg8::StaticOrder S; S.init(MTOK, DM, G, (int)blockIdx.x);
            pg8::EpiRes E{HB_, SSP(2 * layer + 1)};
            pg8::gemm_phase<pg8::EpiRes, pg8::StaticOrder, true, true>(lds, g, S, E);
        }
        XBAR_SYNC();
        if (PHMASK & 256) {
            pg8::Gemm g{HB_, WB_ + WE_W1 + (size_t)layer * 4096 * 1024, MTOK, DFF, DM}; pg8::StaticOrder S; S.init(MTOK, DFF, G, (int)blockIdx.x);
            fill_rstd(lds, S, SSP(2 * layer + 1));
            pg8::EpiMlp1 E{lds, U_, 0};
            pg8::gemm_phase<pg8::EpiMlp1, pg8::StaticOrder, true, true>(lds, g, S, E);
#ifdef PROBE_DUP_MLP1
            __syncthreads(); pg8::gemm_phase<pg8::EpiMlp1, pg8::StaticOrder, true, true>(lds, g, S, E);
#endif
        }
        XBAR_SYNC();
        if (PHMASK & 512) {
            pg8::Gemm g{U_, WB_ + WE_W2 + (size_t)layer * 4096 * 1024, MTOK, DM, DFF}; pg8::StaticOrder S; S.init(MTOK, DM, G, (int)blockIdx.x);
            pg8::EpiRes E{HB_, SSP(2 * layer + 2)};
            pg8::gemm_phase<pg8::EpiRes, pg8::StaticOrder, true, true>(lds, g, S, E);
        }
        XBAR_SYNC();
    }
    {
        const float* fg = p.in[14]; const float* ss8 = SSP(8); const bf16_t* hbf = HB_;
        const int lane2 = LANE();
        f32x4 gg[4];
#pragma unroll
        for (int j = 0; j < 4; ++j) gg[j] = ((const f32x4*)fg)[4 * lane2 + j];
        for (int m = gw; m < MTOK; m += NGW) {
            const float rstd = __builtin_amdgcn_rsqf(row_ss(ss8, m) * (1.0f / DM) + RMS_EPS);
            const u32x4* hr = (const u32x4*)(hbf + (size_t)m * DM) + 2 * lane2;
            const u32x4 w0 = hr[0], w1 = hr[1];
            const unsigned ww[8] = {w0.x, w0.y, w0.z, w0.w, w1.x, w1.y, w1.z, w1.w};
            f32x4* orow = (f32x4*)(h + (size_t)m * DM) + 4 * lane2;
#pragma unroll
            for (int j = 0; j < 4; ++j) {
                f32x4 v;
                v[0] = __builtin_bit_cast(float, ww[2 * j] << 16); v[1] = __builtin_bit_cast(float, ww[2 * j] & 0xffff0000u);
                v[2] = __builtin_bit_cast(float, ww[2 * j + 1] << 16); v[3] = __builtin_bit_cast(float, ww[2 * j + 1] & 0xffff0000u);
                orow[j] = v * rstd * gg[j];
            }
        }
    }
}

extern "C" void kernel_launch(void* const* d_in, const int* in_sizes, int n_in, void* d_out, int out_size, void* d_ws, size_t ws_size, hipStream_t stream) {
    static int grid = 0;
    if (grid == 0) {
        if (n_in != 15 || out_size != MTOK * DM || ws_size < WS_END) { fprintf(stderr, "kernel_launch: unexpected shapes (n_in %d out %d ws %zu)\n", n_in, out_size, ws_size); grid = -1; return; }
        int dev = 0, cus = 0, per_cu = 0;
        hipGetDevice(&dev);
        hipDeviceGetAttribute(&cus, hipDeviceAttributeMultiprocessorCount, dev);
        if (hipFuncSetAttribute((const void*)fwd_kernel, hipFuncAttributeMaxDynamicSharedMemorySize, LDS_BYTES) != hipSuccess) { fprintf(stderr, "kernel_launch: hipFuncSetAttribute failed\n"); grid = -1; return; }
        if (hipOccupancyMaxActiveBlocksPerMultiprocessor(&per_cu, (const void*)fwd_kernel, 512, LDS_BYTES) != hipSuccess || per_cu < 1) { fprintf(stderr, "kernel_launch: occupancy query gave %d\n", per_cu); per_cu = 1; }
        (void)hipGetLastError();
        grid = cus * per_cu;
    }
    if (grid < 0) return;
    if (hipMemsetAsync((char*)d_ws + WS_BAR, 0, 16384, stream) != hipSuccess) { fprintf(stderr, "kernel_launch: hipMemsetAsync failed\n"); return; }
    Params p{};
    for (int i = 0; i < 15; ++i) p.in[i] = (const float*)d_in[i];
    p.out = (float*)d_out; p.ws = (unsigned char*)d_ws;
    void* args[] = {&p};
    hipError_t e = hipLaunchCooperativeKernel((const void*)fwd_kernel, dim3(grid), dim3(512), args, LDS_BYTES, stream);
    if (e != hipSuccess) fprintf(stderr, "cooperative launch failed: %s (grid %d)\n", hipGetErrorString(e), grid);
}
```

```cpp
#include <hip/hip_runtime.h>
#include <hip/hip_cooperative_groups.h>
#include <cstdio>
#include <cstdint>
namespace cg = cooperative_groups;

namespace pg8 {
#define PG8_LAS __attribute__((address_space(3)))
typedef unsigned short bf16_t;
typedef short bf16x8 __attribute__((ext_vector_type(8)));
typedef float f32x4 __attribute__((ext_vector_type(4)));
typedef unsigned u32x4 __attribute__((ext_vector_type(4)));
constexpr int BM = 256, BK = 64, HALF = 128, HTB = HALF * BK * 2  , STAGE_BYTES = 8 * HTB, NXCD = 8, WGM = 8;

__host__ __device__ __forceinline__ int lds_byte(int r, int c) { const int st = (r >> 4) * 2 + (c >> 5), rr = r & 15, cc = c & 31, ob = rr * 64 + cc * 2; return st * 1024 + (ob ^ (((ob >> 9) & 1) << 5)); }
__host__ __device__ __forceinline__ void stage_rc(int b, int& R, int& C) { const int st = b / 1024, sb = b % 1024, swz = sb ^ (((sb >> 9) & 1) << 5); R = (st >> 1) * 16 + swz / 64; C = (st & 1) * 32 + (swz % 64) / 2; }
__host__ __device__ __forceinline__ int perm32(int rho) { const int n = rho >> 4, i = rho & 15; return 8 * (i >> 2) + 4 * n + (i & 3); }

struct Unit { int pm, pn; };
struct Gemm { const bf16_t* A; const bf16_t* Bt; int M, N, K; };

struct StaticOrder {
    int nM, nN, nwg, G, c;
    __host__ __device__ void init(int M, int N, int G_, int c_) { nM = M / BM; nN = N / BM; nwg = nM * nN; G = G_; c = c_; }
    __host__ __device__ bool next(int i, Unit& u) const {
        const long L = (long)i * G + c; if (L >= nwg) return false;
        int wgid = (int)L; { const int q = nwg / NXCD, r = nwg % NXCD, xcd = wgid % NXCD, off = wgid / NXCD; wgid = (xcd < r ? xcd * (q + 1) : r * (q + 1) + (xcd - r) * q) + off; }
        const int nig = WGM * nN, gid = wgid / nig, fm = gid * WGM, gsz = (nM - fm) < WGM ? (nM - fm) : WGM;
        u.pm = fm + ((wgid % nig) % gsz); u.pn = (wgid % nig) / gsz; return true;
    }
    __device__ __forceinline__ void a_ready(const Unit&) const {}
    __device__ __forceinline__ void done(const Unit&) const {}
};

__device__ __forceinline__ unsigned cvt_pk_bf16(float lo, float hi) { unsigned r; asm volatile("v_cvt_pk_bf16_f32 %0, %1, %2" : "=v"(r) : "v"(lo), "v"(hi)); return r; }
constexpr int SEQ = 4096, NBATCH = 8, MTOK = NBATCH * SEQ, DM = 1024, DFF = 4096;
constexpr float RMS_EPS = 1e-6f;
constexpr float LOG2E = 1.4426950408889634f;
constexpr float QSCALE = 0.125f * LOG2E;
constexpr float NEG_BIG = -1.0e30f;

constexpr size_t MiB = 1u << 20;
constexpr size_t WS_SS = 0;
constexpr size_t WS_TAB = 6 * MiB;
constexpr size_t WS_BAR = 7 * MiB;
constexpr size_t WS_LSE = 2 * MiB;
constexpr size_t WS_W = 8 * MiB;
constexpr size_t WS_HB = 96 * MiB;
constexpr size_t WS_U = 160 * MiB;
constexpr size_t WS_Q = 160 * MiB, WS_K = 232 * MiB, WS_VT = 256 * MiB, WS_O = 280 * MiB;
constexpr size_t WS_SSP = 420 * MiB;
constexpr size_t WS_END = 440 * MiB;

constexpr int LDS_RSTD = 131072;
constexpr int LDS_ROPE = 139264;
constexpr int LDS_GAIN = 147456;
constexpr int LDS_BYTES = 163840;
__device__ __forceinline__ float row_ss(const float* ssp, int row) {
    const f32x4* q = (const f32x4*)(ssp + (size_t)row * 16);
    const f32x4 a = q[0], b = q[1], c = q[2], d = q[3];
    return ((a[0] + a[1]) + (a[2] + a[3])) + ((b[0] + b[1]) + (b[2] + b[3])) + (((c[0] + c[1]) + (c[2] + c[3])) + ((d[0] + d[1]) + (d[2] + d[3])));
}
__device__ __forceinline__ int perm_key(int i) { return (i & ~12) | ((i & 4) << 1) | ((i & 8) >> 1); }

template <int KIND> struct EpiQKV {
    static constexpr bool PERM = true, AFTER_DRAIN = false;
    unsigned char* ws; PG8_LAS unsigned char* lds; int ja; mutable int cnt;
    __device__ __forceinline__ void operator()(const f32x4 (&acc)[2][2][4][2], const Unit& u, int wr, int wc, int fr, int fq) const {
        asm volatile("" : "+v"(fr), "+v"(fq));
        asm volatile("" : "+s"(wr), "+s"(wc));
        constexpr int NQH = (KIND == 1) ? 18 : 16, NKH = (KIND == 1) ? 6 : 4;
        const int hcol = 4 * u.pn + wc;
        int type, hh;
        if (hcol < NQH) { type = 0; hh = hcol; } else if (hcol < NQH + NKH) { type = 1; hh = hcol - NQH; } else if (hcol < NQH + 2 * NKH) { type = 2; hh = hcol - NQH - NKH; } else { ++cnt; return; }
        const PG8_LAS float* ss = (const PG8_LAS float*)(lds + LDS_RSTD) + 256 * cnt;
        ++cnt;
        const PG8_LAS f32x4* rope = (const PG8_LAS f32x4*)(lds + LDS_ROPE);
        float gn[2][8];
        if (KIND == 0) {
            const PG8_LAS float* gsrc = (const PG8_LAS float*)(lds + LDS_GAIN) + ja * 128 + ((type == 0) ? 0 : 64);
            if (type < 2) {
#pragma unroll
                for (int bj = 0; bj < 2; ++bj)
#pragma unroll
                    for (int n = 0; n < 2; ++n)
#pragma unroll
                        for (int j = 0; j < 4; ++j) gn[bj][n * 4 + j] = gsrc[32 * bj + 16 * n + 4 * fq + j];
            }
        }
        int hin = hh, g = 0;
        if (KIND == 1) { if (type == 0) { g = hh / 6; hin = hh - 6 * g; } else { g = hh >> 1; hin = hh & 1; } }
        if (KIND == 1 && g == 1) body<2>(acc, u, wr, wc, fr, fq, type, hin, g, ss, rope, gn);
        else if (KIND == 1 && g == 2) body<4>(acc, u, wr, wc, fr, fq, type, hin, g, ss, rope, gn);
        else body<0>(acc, u, wr, wc, fr, fq, type, hin, g, ss, rope, gn);
    }
    template <int gsh> __device__ __forceinline__ void body(const f32x4 (&acc)[2][2][4][2], const Unit& u, int wr, int wc, int fr, int fq, int type, int hin, int g, const PG8_LAS float* ss, const PG8_LAS f32x4* rope, const float (&gn)[2][8]) const {
#pragma unroll
        for (int ai = 0; ai < 2; ++ai)
#pragma unroll
            for (int m = 0; m < 4; ++m) {
                int frl = fr; asm volatile("" : "+v"(frl));
                const int row = u.pm * BM + ai * HALF + wr * 64 + m * 16 + frl;
                const int b = row >> 12, t = row & (SEQ - 1);
                const float rstd = ss[ai * HALF + wr * 64 + m * 16 + frl];
                float v[2][8];
#pragma unroll
                for (int bj = 0; bj < 2; ++bj)
#pragma unroll
                    for (int n = 0; n < 2; ++n)
#pragma unroll
                        for (int j = 0; j < 4; ++j) v[bj][n * 4 + j] = acc[ai][bj][m][n][j] * rstd;
                if (KIND == 0 && type < 2) {
                    float s2 = 0.f;
#pragma unroll
                    for (int bj = 0; bj < 2; ++bj)
#pragma unroll
                        for (int e = 0; e < 8; ++e) s2 += v[bj][e] * v[bj][e];
                    s2 += __shfl_xor(s2, 16); s2 += __shfl_xor(s2, 32);
                    const float r = __builtin_amdgcn_rsqf(s2 * (1.0f / 64.0f) + RMS_EPS);
#pragma unroll
                    for (int bj = 0; bj < 2; ++bj)
#pragma unroll
                        for (int e = 0; e < 8; ++e) v[bj][e] *= r * gn[bj][e];
#pragma unroll
                    for (int bj = 0; bj < 2; ++bj) {
                        const int pos = (bj == 0) ? (t >> 6) : (t & 63);
                        const f32x4 cs0 = rope[(pos * 16 + 4 * fq) >> 1], cs1 = rope[((pos * 16 + 4 * fq) >> 1) + 1];
                        const float cc[4] = {cs0[0], cs0[2], cs1[0], cs1[2]}, sn[4] = {cs0[1], cs0[3], cs1[1], cs1[3]};
#pragma unroll
                        for (int j = 0; j < 4; ++j) {
                            const float x1 = v[bj][j], x2 = v[bj][4 + j];
                            v[bj][j] = x1 * cc[j] - x2 * sn[j]; v[bj][4 + j] = x2 * cc[j] + x1 * sn[j];
                        }
                    }
                }
                if (type == 0) {
#pragma unroll
                    for (int bj = 0; bj < 2; ++bj)
#pragma unroll
                        for (int e = 0; e < 8; ++e) v[bj][e] *= QSCALE;
                }
                const int dmask = (1 << gsh) - 1;
                const int vb = (b << gsh) + (t & dmask), idx = t >> gsh, lsh = 12 - gsh;
                if (type < 2) {
                    const int nh = (type == 0) ? ((KIND == 1) ? 6 : 16) : ((KIND == 1) ? 2 : 4);
                    unsigned char* base = ws + ((type == 0) ? WS_Q : WS_K) + ((KIND == 1) ? (size_t)g * ((size_t)NBATCH * nh * SEQ * 128) : 0);
                    unsigned off = ((unsigned)(((vb * nh + hin) << lsh) + idx) * 64u + 8u * fq) * 2u; unsigned bjstep = 64u;
                    if (KIND != 0 && type == 1) {
                        off = (unsigned)((vb * nh + hin) << lsh) * 128u + ((unsigned)(idx >> 5) * 4u + (fq >> 1)) * 1024u + ((fq & 1) * 32u + (idx & 31)) * 16u; bjstep = 2048u;
                    }
#pragma unroll
                    for (int bj = 0; bj < 2; ++bj) {
                        u32x4 w; w.x = cvt_pk_bf16(v[bj][0], v[bj][1]); w.y = cvt_pk_bf16(v[bj][2], v[bj][3]); w.z = cvt_pk_bf16(v[bj][4], v[bj][5]); w.w = cvt_pk_bf16(v[bj][6], v[bj][7]);
                        *(u32x4*)(base + off + bjstep * bj) = w;
                    }
                } else {
                    const int nh = (KIND == 1) ? 2 : 4;
                    unsigned char* base = ws + WS_VT + ((KIND == 1) ? (size_t)g * ((size_t)NBATCH * nh * SEQ * 128) : 0);
                    unsigned off = ((unsigned)((((vb * nh + hin) * 64 + 8 * fq) << lsh) + perm_key(idx))) * 2u;
                    unsigned dstep = 2u << lsh, bjskip = 24u * dstep;
                    if (KIND != 0) {
                        const unsigned pk_ = (unsigned)perm_key(idx), ks = pk_ & 63u, c8 = ks >> 3;
                        off = (unsigned)(((vb * nh + hin) * 64) << lsh) * 2u + (((pk_ >> 6) * 2u) * 4u + (c8 >> 1)) * 1024u + (c8 & 1u) * 512u + (8u * fq) * 16u + (ks & 7u) * 2u;
                        dstep = 16u; bjskip = 4096u - 8u * 16u;
                    }
#pragma unroll
                    for (int bj = 0; bj < 2; ++bj) {
#pragma unroll
                        for (int e = 0; e < 8; ++e) {
                            const unsigned pk = cvt_pk_bf16(v[bj][e], 0.f);
                            *(bf16_t*)(base + off) = (bf16_t)(pk & 0xffffu);
                            off += dstep;
                        }
                        off += bjskip;
                    }
                }
                __builtin_amdgcn_sched_barrier(0);
            }
    }
};

struct EpiRes {
    static constexpr bool PERM = true, AFTER_DRAIN = false;
    bf16_t* hb; float* ssout;
    __device__ __forceinline__ void operator()(const f32x4 (&acc)[2][2][4][2], const Unit& u, int wr, int wc, int fr, int fq) const {
        asm volatile("" : "+v"(fr), "+v"(fq));
        const unsigned o0 = (unsigned)((u.pm * BM + wr * 64 + fr) * DM + u.pn * BM + wc * 32 + 8 * fq);
        u32x4 hv[2][2];
#pragma unroll
        for (int bj = 0; bj < 2; ++bj) hv[0][bj] = *(const u32x4*)((const char*)hb + (o0 + bj * HALF) * 2u);
#pragma unroll
        for (int it = 0; it < 8; ++it) {
            const int ai = it >> 2, m = it & 3, cur = it & 1, nxt = cur ^ 1;
            if (it + 1 < 8) {
                const int ai2 = (it + 1) >> 2, m2 = (it + 1) & 3;
                const unsigned o2 = o0 + (unsigned)((ai2 * HALF + m2 * 16) * DM);
#pragma unroll
                for (int bj = 0; bj < 2; ++bj) hv[nxt][bj] = *(const u32x4*)((const char*)hb + (o2 + bj * HALF) * 2u);
            }
            const unsigned o1 = o0 + (unsigned)((ai * HALF + m * 16) * DM);
            float q = 0.f;
#pragma unroll
            for (int bj = 0; bj < 2; ++bj) {
                const unsigned o = o1 + bj * HALF;
                const u32x4 hw = hv[cur][bj];
                f32x4 v0, v1;
                v0[0] = __builtin_bit_cast(float, hw.x << 16); v0[1] = __builtin_bit_cast(float, hw.x & 0xffff0000u); v0[2] = __builtin_bit_cast(float, hw.y << 16); v0[3] = __builtin_bit_cast(float, hw.y & 0xffff0000u);
                v1[0] = __builtin_bit_cast(float, hw.z << 16); v1[1] = __builtin_bit_cast(float, hw.z & 0xffff0000u); v1[2] = __builtin_bit_cast(float, hw.w << 16); v1[3] = __builtin_bit_cast(float, hw.w & 0xffff0000u);
                v0 = v0 + acc[ai][bj][m][0]; v1 = v1 + acc[ai][bj][m][1];
                u32x4 w; w.x = cvt_pk_bf16(v0[0], v0[1]); w.y = cvt_pk_bf16(v0[2], v0[3]); w.z = cvt_pk_bf16(v1[0], v1[1]); w.w = cvt_pk_bf16(v1[2], v1[3]);
                *(u32x4*)((char*)hb + o * 2u) = w;
                q += (v0[0] * v0[0] + v0[1] * v0[1]) + (v0[2] * v0[2] + v0[3] * v0[3]) + (v1[0] * v1[0] + v1[1] * v1[1]) + (v1[2] * v1[2] + v1[3] * v1[3]);
            }
            q += __shfl_xor(q, 16); q += __shfl_xor(q, 32);
            const int row = u.pm * BM + ai * HALF + wr * 64 + m * 16 + fr;
            if (fq == 0) ssout[(size_t)row * 16 + u.pn * 4 + wc] = q;
        }
    }
};

struct EpiMlp1 {
    static constexpr bool PERM = true, AFTER_DRAIN = false;
    PG8_LAS unsigned char* lds; bf16_t* U; mutable int cnt;
    __device__ __forceinline__ void operator()(const f32x4 (&acc)[2][2][4][2], const Unit& u, int wr, int wc, int fr, int fq) const {
        const PG8_LAS float* ss = (const PG8_LAS float*)(lds + LDS_RSTD) + 256 * cnt;
        ++cnt;
#pragma unroll
        for (int ai = 0; ai < 2; ++ai)
#pragma unroll
            for (int m = 0; m < 4; ++m) {
                const int row = u.pm * BM + ai * HALF + wr * 64 + m * 16 + fr;
                const float rstd = ss[ai * HALF + wr * 64 + m * 16 + fr];
#pragma unroll
                for (int bj = 0; bj < 2; ++bj) {
                    f32x4 v0 = acc[ai][bj][m][0] * rstd, v1 = acc[ai][bj][m][1] * rstd;
#pragma unroll
                    for (int j = 0; j < 4; ++j) { const float a = fmaxf(v0[j], 0.f), c = fmaxf(v1[j], 0.f); v0[j] = a * a; v1[j] = c * c; }
                    u32x4 w; w.x = cvt_pk_bf16(v0[0], v0[1]); w.y = cvt_pk_bf16(v0[2], v0[3]); w.z = cvt_pk_bf16(v1[0], v1[1]); w.w = cvt_pk_bf16(v1[2], v1[3]);
                    *(u32x4*)((char*)U + (unsigned)(row * DFF + u.pn * BM + bj * HALF + wc * 32 + 8 * fq) * 2u) = w;
                }
            }
    }
};
template <class Epi, class Sched, bool ALIGN_EPI = false, bool SP2 = false>
__device__ __forceinline__ void gemm_phase(PG8_LAS unsigned char* lds, const Gemm g, const Sched& S, const Epi& E) {
    int tid_ = threadIdx.x; asm volatile("" : "+v"(tid_));
    const int tid = tid_, wid = __builtin_amdgcn_readfirstlane(tid >> 6), lane = tid & 63, wr = wid >> 2, wc = wid & 3, fr = lane & 15, fq = lane >> 4;
    const int K = g.K, nt = K / BK;
    unsigned voffA[2], voffB[2];
#pragma unroll
    for (int i = 0; i < 2; ++i) { int R, C; stage_rc(tid * 16 + i * 8192, R, C); const int Rb = Epi::PERM ? ((R & ~31) + perm32(R & 31)) : R;
        voffA[i] = (unsigned)(R * K + C) * 2u; voffB[i] = (unsigned)(Rb * K + C) * 2u; }
    const size_t kstep = (size_t)(BK * 2);
    const size_t hstep = (size_t)HALF * K * 2;
    const size_t tstep = 2 * hstep;
    const unsigned ldsw = (unsigned)wid * 1024u;
    const int aoff = lds_byte(wr * 64 + fr, fq * 8), boff = lds_byte(wc * 32 + fr, fq * 8);
#define PG8_SA(b, h) (((b) * 2 + (h)) * HTB)
#define PG8_SB(b, h) ((4 + (b) * 2 + (h)) * HTB)
#define PG8_STAGE(bufoff, gbase, voff) do { _Pragma("unroll") for (int _i = 0; _i < 2; ++_i) \
        __builtin_amdgcn_global_load_lds((const unsigned*)((const char*)(gbase) + (voff)[_i]), (PG8_LAS unsigned*)(lds + (bufoff) + ldsw + _i * 8192), 16, 0, 0); } while (0)
#define PG8_LDA(dst, b, h) do { _Pragma("unroll") for (int m = 0; m < 4; ++m) _Pragma("unroll") for (int k = 0; k < 2; ++k) dst[m][k] = *(const PG8_LAS bf16x8*)(lds + PG8_SA(b, h) + aoff + m * 2048 + k * 1024); } while (0)
#define PG8_LDB(dst, b, h) do { _Pragma("unroll") for (int n = 0; n < 2; ++n) _Pragma("unroll") for (int k = 0; k < 2; ++k) dst[n][k] = *(const PG8_LAS bf16x8*)(lds + PG8_SB(b, h) + boff + n * 2048 + k * 1024); } while (0)
#define PG8_MMA(ai, bj, At, Bt) do { __builtin_amdgcn_s_setprio(1); _Pragma("unroll") for (int m = 0; m < 4; ++m) _Pragma("unroll") for (int n = 0; n < 2; ++n) _Pragma("unroll") for (int k = 0; k < 2; ++k) \
        acc[ai][bj][m][n] = __builtin_amdgcn_mfma_f32_16x16x32_bf16(Bt[n][k], At[m][k], acc[ai][bj][m][n], 0, 0, 0); __builtin_amdgcn_s_setprio(0); } while (0)
#define PG8_WAIT_V(n) asm volatile("s_waitcnt vmcnt(" #n ")" ::: "memory")
#define PG8_WAIT_L(n) asm volatile("s_waitcnt lgkmcnt(" #n ")" ::: "memory")
#define PG8_BAR __builtin_amdgcn_s_barrier()
#define PG8_SCHED __builtin_amdgcn_sched_barrier(0)
    Unit cur, nxt; int ui = 0;
    if (!S.next(0, cur)) return;
    f32x4 acc[2][2][4][2];
#pragma unroll
    for (int a = 0; a < 2; ++a)
#pragma unroll
        for (int b = 0; b < 2; ++b)
#pragma unroll
            for (int m = 0; m < 4; ++m)
#pragma unroll
                for (int n = 0; n < 2; ++n) acc[a][b][m][n] = (f32x4){0.f, 0.f, 0.f, 0.f};
    bf16x8 At[4][2], B0[2][2], B1[2][2];
    const char* cA = (const char*)g.A + (size_t)cur.pm * tstep; const char* cB = (const char*)g.Bt + (size_t)cur.pn * tstep;
    S.a_ready(cur);
    if constexpr (SP2) {
        PG8_STAGE(PG8_SB(0, 0), cB, voffB); PG8_STAGE(PG8_SB(0, 1), cB + hstep, voffB); PG8_STAGE(PG8_SA(0, 0), cA, voffA); PG8_STAGE(PG8_SA(0, 1), cA + hstep, voffA);
        if (wr == 1) PG8_BAR;
        PG8_WAIT_V(2); PG8_BAR;
        PG8_STAGE(PG8_SB(1, 0), cB + kstep, voffB); PG8_STAGE(PG8_SA(1, 0), cA + kstep, voffA); PG8_STAGE(PG8_SB(1, 1), cB + hstep + kstep, voffB);
        PG8_WAIT_V(6); PG8_BAR;
    } else {
        PG8_STAGE(PG8_SB(0, 0), cB, voffB); PG8_STAGE(PG8_SA(0, 0), cA, voffA); PG8_STAGE(PG8_SB(0, 1), cB + hstep, voffB); PG8_STAGE(PG8_SA(0, 1), cA + hstep, voffA);
        if (wr == 1) PG8_BAR;
        PG8_WAIT_V(4); PG8_BAR;
        PG8_STAGE(PG8_SB(1, 0), cB + kstep, voffB); PG8_STAGE(PG8_SA(1, 0), cA + kstep, voffA); PG8_STAGE(PG8_SB(1, 1), cB + hstep + kstep, voffB);
        PG8_WAIT_V(6); PG8_BAR;
    }
    for (;;) {
        const bool has_next = S.next(ui + 1, nxt);
        const char* nA = has_next ? (const char*)g.A + (size_t)nxt.pm * tstep : cA; const char* nB = has_next ? (const char*)g.Bt + (size_t)nxt.pn * tstep : cB;
        for (int t = 0; t < nt; t += 2) {
            const bool last = (t == nt - 2);
            const char* a1 = cA + (size_t)(t + 1) * kstep;
            const char* a2 = last ? nA : cA + (size_t)(t + 2) * kstep; const char* b2 = last ? nB : cB + (size_t)(t + 2) * kstep;
            const char* a3 = a2 + kstep; const char* b3 = b2 + kstep;
            if (last && has_next) S.a_ready(nxt);
            if constexpr (SP2) {
            PG8_LDB(B0, 0, 0); PG8_LDB(B1, 0, 1); PG8_SCHED; PG8_LDA(At, 0, 0); PG8_STAGE(PG8_SA(1, 1), a1 + hstep, voffA);
            PG8_WAIT_V(8); PG8_WAIT_L(0); PG8_BAR; PG8_MMA(0, 0, At, B0); PG8_MMA(0, 1, At, B1); PG8_BAR; PG8_SCHED;
            PG8_LDA(At, 0, 1); PG8_STAGE(PG8_SB(0, 0), b2, voffB); PG8_STAGE(PG8_SB(0, 1), b2 + hstep, voffB); PG8_STAGE(PG8_SA(0, 0), a2, voffA);
            PG8_WAIT_V(8); PG8_WAIT_L(0); PG8_BAR; PG8_MMA(1, 0, At, B0); PG8_MMA(1, 1, At, B1); PG8_BAR; PG8_SCHED;
            PG8_LDB(B0, 1, 0); PG8_LDB(B1, 1, 1); PG8_SCHED; PG8_LDA(At, 1, 0); PG8_STAGE(PG8_SA(0, 1), a2 + hstep, voffA);
            PG8_WAIT_V(8); PG8_WAIT_L(0); PG8_BAR; PG8_MMA(0, 0, At, B0); PG8_MMA(0, 1, At, B1); PG8_BAR; PG8_SCHED;
            PG8_LDA(At, 1, 1); PG8_STAGE(PG8_SB(1, 0), b3, voffB); PG8_STAGE(PG8_SB(1, 1), b3 + hstep, voffB); PG8_STAGE(PG8_SA(1, 0), a3, voffA);
            PG8_WAIT_V(8); PG8_WAIT_L(0); PG8_BAR; PG8_MMA(1, 0, At, B0); PG8_MMA(1, 1, At, B1); PG8_BAR; PG8_SCHED;
            } else {
            PG8_LDB(B0, 0, 0); PG8_SCHED; PG8_LDA(At, 0, 0); PG8_STAGE(PG8_SA(1, 1), a1 + hstep, voffA);
            PG8_WAIT_L(8); PG8_BAR; PG8_WAIT_L(0); PG8_MMA(0, 0, At, B0); PG8_BAR; PG8_SCHED;
            PG8_LDB(B1, 0, 1); PG8_STAGE(PG8_SB(0, 0), b2, voffB);
            PG8_BAR; PG8_WAIT_L(0); PG8_MMA(0, 1, At, B1); PG8_BAR;
            PG8_LDA(At, 0, 1); PG8_STAGE(PG8_SA(0, 0), a2, voffA);
            PG8_BAR; PG8_WAIT_L(0); PG8_MMA(1, 0, At, B0); PG8_BAR; PG8_SCHED;
            PG8_STAGE(PG8_SB(0, 1), b2 + hstep, voffB);
            PG8_WAIT_V(6); PG8_BAR; PG8_MMA(1, 1, At, B1); PG8_BAR;
            PG8_LDB(B0, 1, 0); PG8_SCHED; PG8_LDA(At, 1, 0); PG8_STAGE(PG8_SA(0, 1), a2 + hstep, voffA);
            PG8_WAIT_L(8); PG8_BAR; PG8_WAIT_L(0); PG8_MMA(0, 0, At, B0); PG8_BAR; PG8_SCHED;
            PG8_LDB(B1, 1, 1); PG8_STAGE(PG8_SB(1, 0), b3, voffB);
            PG8_BAR; PG8_WAIT_L(0); PG8_MMA(0, 1, At, B1); PG8_BAR;
            PG8_LDA(At, 1, 1); PG8_STAGE(PG8_SA(1, 0), a3, voffA);
            PG8_BAR; PG8_WAIT_L(0); PG8_MMA(1, 0, At, B0); PG8_BAR; PG8_SCHED;
            PG8_STAGE(PG8_SB(1, 1), b3 + hstep, voffB);
            PG8_WAIT_V(6); PG8_BAR; PG8_MMA(1, 1, At, B1); PG8_BAR;
            }
        }
        if constexpr (ALIGN_EPI) { if (wr == 0) PG8_BAR; }
        if constexpr (!Epi::AFTER_DRAIN) { E(acc, cur, wr, wc, fr, fq); S.done(cur); }
        if (!has_next) break;
#pragma unroll
        for (int a = 0; a < 2; ++a)
#pragma unroll
            for (int b = 0; b < 2; ++b)
#pragma unroll
                for (int m = 0; m < 4; ++m)
#pragma unroll
                    for (int n = 0; n < 2; ++n) acc[a][b][m][n] = (f32x4){0.f, 0.f, 0.f, 0.f};
        cur = nxt; cA = nA; cB = nB; ++ui;
        if constexpr (ALIGN_EPI) { if (wr == 1) PG8_BAR; }
    }
    PG8_WAIT_V(0);
    if constexpr (!ALIGN_EPI) { if (wr == 0) PG8_BAR; }
    PG8_BAR;
    if constexpr (Epi::AFTER_DRAIN) { E.fused(acc, cur, wr, wc, fr, fq, lds, wid, lane); S.done(cur); }
#undef PG8_SA
#undef PG8_SB
#undef PG8_STAGE
#undef PG8_LDA
#undef PG8_LDB
#undef PG8_MMA
#undef PG8_WAIT_V
#undef PG8_WAIT_L
#undef PG8_BAR
#undef PG8_SCHED
}
}
using namespace pg8;
using pg8::bf16_t; using pg8::bf16x8; using pg8::f32x4; using pg8::u32x4; using pg8::cvt_pk_bf16;
#define LAS __attribute__((address_space(3)))
typedef float f32x16 __attribute__((ext_vector_type(16)));
typedef unsigned u32x2 __attribute__((ext_vector_type(2)));
#define LDS_WAIT() asm volatile("s_waitcnt lgkmcnt(0)" ::: "memory")
typedef float f32x2_t __attribute__((ext_vector_type(2)));
typedef __bf16 bf16x2_t __attribute__((ext_vector_type(2)));
__device__ __forceinline__ unsigned cvtpk_s(float lo, float hi) { f32x2_t v = {lo, hi}; bf16x2_t b = __builtin_convertvector(v, bf16x2_t); return __builtin_bit_cast(unsigned, b); }

constexpr size_t WE_QKV0 = 0, WE_QKV1 = WE_QKV0 + 1536 * 1024, WE_QKV2 = WE_QKV1 + 2048 * 1024, WE_QKV3 = WE_QKV2 + 1536 * 1024;
constexpr size_t WE_WO0 = WE_QKV3 + 1536 * 1024, WE_WO1 = WE_WO0 + 1024 * 1024, WE_WO2 = WE_WO1 + 1024 * 1152, WE_WO3 = WE_WO2 + 1024 * 1024;
constexpr size_t WE_W1 = WE_WO3 + 1024 * 1024, WE_W2 = WE_W1 + 4 * (size_t)4096 * 1024, WE_END = WE_W2 + 4 * (size_t)4096 * 1024;
static_assert(WS_W + WE_END * 2 <= WS_HB, "weights fit");

struct Params { const float* in[15]; float* out; unsigned char* ws; };

__device__ __forceinline__ float wave_sum(float v) {
#pragma unroll
    for (int o = 1; o < 64; o <<= 1) v += __shfl_xor(v, o);
    return v;
}

struct TrDesc { const float* W; bf16_t* WT; const float* gain; int K, N, k0, R0, src0; bool valid, perm; };
__device__ __forceinline__ TrDesc tr_make(const float* W, int K, int N, int Npad, bf16_t* WT, const float* gain, int mode, int nheads, int nperm, int item) {
    TrDesc d; d.W = W; d.WT = WT; d.gain = gain; d.K = K; d.N = N;
    const int nblk = Npad >> 5, kb = item / nblk, nb = item - kb * nblk; d.k0 = 64 * kb; d.R0 = 32 * nb; d.src0 = d.R0; d.valid = true; d.perm = false;
    if (mode == 1) { const int pn = d.R0 >> 8, c = d.R0 & 255, bj = c >> 7, wc = (c >> 5) & 3, hcol = 4 * pn + wc; d.valid = hcol < nheads; d.perm = hcol < nperm; d.src0 = hcol * 64 + 32 * bj; }
    return d;
}
__device__ __forceinline__ TrDesc tr_decode(const Params& p, int it) {
    bf16_t* WB = (bf16_t*)(p.ws + WS_W);
    const float* attn_norm = p.in[1]; const float* mlp_norm = p.in[2];
    constexpr int I_QA = 16 * (1536 / 32), I_QB = 16 * (2048 / 32), I_WO = 16 * 32, I_WOB = 18 * 32, I_W1 = 16 * 128, I_W2 = 64 * 32;
    int r = it;
    if (r < I_QA) return tr_make(p.in[3], 1024, 1536, 1536, WB + WE_QKV0, attn_norm + 0 * DM, 1, 24, 20, r); r -= I_QA;
    if (r < I_QB) return tr_make(p.in[7], 1024, 1920, 2048, WB + WE_QKV1, attn_norm + 1 * DM, 1, 30, 0, r); r -= I_QB;
    if (r < I_QA) return tr_make(p.in[9], 1024, 1536, 1536, WB + WE_QKV2, attn_norm + 2 * DM, 1, 24, 0, r); r -= I_QA;
    if (r < I_QA) return tr_make(p.in[3] + (size_t)1024 * 1536, 1024, 1536, 1536, WB + WE_QKV3, attn_norm + 3 * DM, 1, 24, 20, r); r -= I_QA;
    if (r < I_WO) return tr_make(p.in[6], 1024, 1024, 1024, WB + WE_WO0, nullptr, 0, 0, 0, r); r -= I_WO;
    if (r < I_WOB) return tr_make(p.in[8], 1152, 1024, 1024, WB + WE_WO1, nullptr, 0, 0, 0, r); r -= I_WOB;
    if (r < I_WO) return tr_make(p.in[11], 1024, 1024, 1024, WB + WE_WO2, nullptr, 0, 0, 0, r); r -= I_WO;
    if (r < I_WO) return tr_make(p.in[6] + (size_t)1024 * 1024, 1024, 1024, 1024, WB + WE_WO3, nullptr, 0, 0, 0, r); r -= I_WO;
    if (r < 4 * I_W1) { const int l = r / I_W1; return tr_make(p.in[12] + (size_t)l * 1024 * 4096, 1024, 4096, 4096, WB + WE_W1 + (size_t)l * 4096 * 1024, mlp_norm + l * DM, 0, 0, 0, r - l * I_W1); } r -= 4 * I_W1;
    { const int l = r / I_W2; return tr_make(p.in[13] + (size_t)l * 4096 * 1024, 4096, 1024, 1024, WB + WE_W2 + (size_t)l * 4096 * 1024, nullptr, 0, 0, 0, r - l * I_W2); }
}
__device__ __forceinline__ void tr_load(const TrDesc& d, int lane, float (&w)[32]) {
#pragma unroll
    for (int i = 0; i < 32; ++i) { const int kk = 2 * i + (lane >> 5); w[i] = d.valid ? d.W[(size_t)(d.k0 + kk) * d.N + d.src0 + (lane & 31)] : 0.f; }
}
__device__ __forceinline__ void tr_finish(const TrDesc& d, int lane, LAS float* scr, const float (&w)[32]) {
#pragma unroll
    for (int i = 0; i < 32; ++i) { const int kk = 2 * i + (lane >> 5); scr[kk * 33 + (lane & 31)] = w[i]; }
    const int c8 = lane & 7;
    f32x4 g0 = {1.f, 1.f, 1.f, 1.f}, g1 = {1.f, 1.f, 1.f, 1.f};
    if (d.gain) { g0 = *(const f32x4*)(d.gain + d.k0 + 8 * c8); g1 = *(const f32x4*)(d.gain + d.k0 + 8 * c8 + 4); }
    LDS_WAIT();
#pragma unroll
    for (int jj = 0; jj < 4; ++jj) {
        const int e = (lane >> 3) + 8 * jj;
        const int se = d.perm ? (16 * ((e >> 2) & 1) + 4 * (e >> 3) + (e & 3)) : e;
        const LAS float* s = scr + (8 * c8) * 33 + se;
        u32x4 o; o.x = cvt_pk_bf16(s[0 * 33] * g0[0], s[1 * 33] * g0[1]); o.y = cvt_pk_bf16(s[2 * 33] * g0[2], s[3 * 33] * g0[3]); o.z = cvt_pk_bf16(s[4 * 33] * g1[0], s[5 * 33] * g1[1]); o.w = cvt_pk_bf16(s[6 * 33] * g1[2], s[7 * 33] * g1[3]);
        *(u32x4*)(d.WT + (size_t)(d.R0 + e) * d.K + d.k0 + 8 * c8) = o;
    }
    LDS_WAIT();
}

__device__ __forceinline__ void prologue(const Params& p, LAS unsigned char* lds, int gw, int NGW, int wave, int lane) {
    float* ss = (float*)(p.ws + WS_SSP);
    LAS float* scr = (LAS float*)(lds + wave * 16384);
    constexpr int I_QA = 16 * (1536 / 32), I_QB = 16 * (2048 / 32), I_WO = 16 * 32, I_WOB = 18 * 32, I_W1 = 16 * 128, I_W2 = 64 * 32;
    constexpr int NITEMS = 3 * I_QA + I_QB + 3 * I_WO + I_WOB + 4 * I_W1 + 4 * I_W2;
    {
        int it = gw; TrDesc dA, dB; float wA[32], wB[32];
        if (it < NITEMS) { dA = tr_decode(p, it); tr_load(dA, lane, wA); }
        while (it < NITEMS) {
            const int n1 = it + NGW; if (n1 < NITEMS) { dB = tr_decode(p, n1); tr_load(dB, lane, wB); }
            tr_finish(dA, lane, scr, wA); it = n1; if (it >= NITEMS) break;
            const int n2 = it + NGW; if (n2 < NITEMS) { dA = tr_decode(p, n2); tr_load(dA, lane, wA); }
            tr_finish(dB, lane, scr, wB); it = n2;
        }
    }
    const float* x = p.in[0]; bf16_t* hb = (bf16_t*)(p.ws + WS_HB);
    for (int m0 = gw; m0 < MTOK; m0 += 4 * NGW) {
        f32x4 v[4][4];
#pragma unroll
        for (int r = 0; r < 4; ++r) { const int m = m0 + r * NGW; if (m < MTOK) { const f32x4* xr = (const f32x4*)(x + (size_t)m * DM) + lane;
#pragma unroll
            for (int j = 0; j < 4; ++j) v[r][j] = xr[64 * j]; } }
#pragma unroll
        for (int r = 0; r < 4; ++r) { const int m = m0 + r * NGW; if (m < MTOK) {
            float s = 0.f;
#pragma unroll
            for (int j = 0; j < 4; ++j) s += (v[r][j].x * v[r][j].x + v[r][j].y * v[r][j].y) + (v[r][j].z * v[r][j].z + v[r][j].w * v[r][j].w);
            s = wave_sum(s);
            u32x2* o8 = (u32x2*)(hb + (size_t)m * DM) + lane;
#pragma unroll
            for (int j = 0; j < 4; ++j) { u32x2 w; w.x = cvt_pk_bf16(v[r][j].x, v[r][j].y); w.y = cvt_pk_bf16(v[r][j].z, v[r][j].w); o8[64 * j] = w; }
            if (lane < 16) ss[(size_t)m * 16 + lane] = (lane == 0) ? s : 0.f; } }
    }
}

constexpr int AT_ROWB = 144, AT_TILEB = 64 * AT_ROWB, AT_BUFB = 2 * AT_TILEB;
template <int MODE> __device__ __forceinline__ void attn_phase(LAS unsigned char* lds, const bf16_t* __restrict__ Qg, const bf16_t* __restrict__ Kg, const bf16_t* __restrict__ Vg, bf16_t* Og, float* LSE, const float* __restrict__ sinks) {
    int tid_ = threadIdx.x; asm volatile("" : "+v"(tid_));
    const int tid = tid_, lane = tid & 63, wave = __builtin_amdgcn_readfirstlane(tid >> 6), r32 = lane & 31, hi = lane >> 5;
    constexpr int NQ = (MODE == 0) ? 2 : 1;
    constexpr int QU = 256 * NQ;
    constexpr int NUNITS = (MODE == 1) ? 3 * 768 : 2048 / NQ;
    constexpr int HQ = (MODE == 1) ? 6 : 16, HKV = (MODE == 1) ? 2 : 4, WIN = (MODE == 1) ? 64 : 128, OPITCH = (MODE == 1) ? 1152 : 1024;
    const int srow = tid >> 3, schunk = tid & 7;
    const unsigned sdst = (unsigned)(srow * AT_ROWB + schunk * 16);
    for (int un = blockIdx.x; un < NUNITS; un += gridDim.x) {
        int g = 0, vb, hq, qb;
        if (MODE == 1) { g = un / 768; const int r = un - g * 768; const int nqbs = 4 - 2 * g;   qb = r & ((1 << nqbs) - 1); const int r2 = r >> nqbs; hq = r2 % 6; vb = r2 / 6; }
        else if (MODE == 0) { qb = un & 7; hq = (un >> 3) & 15; vb = un >> 7; }
        else { qb = un & 15; hq = (un >> 4) & 15; vb = un >> 8; }
        const int gsh = 2 * g, lsh = 12 - gsh, L = 1 << lsh;
        const int kvh = (MODE == 1) ? hq / 3 : hq >> 2;
        const int q0 = qb * QU, qw = q0 + 32 * NQ * wave;
        const size_t gq = (MODE == 1) ? (size_t)g * ((size_t)NBATCH * 6 * SEQ * 64) : 0, gk = (MODE == 1) ? (size_t)g * ((size_t)NBATCH * 2 * SEQ * 64) : 0;
        bf16x8 qf[NQ][4];
#pragma unroll
        for (int j = 0; j < NQ; ++j) {
            const bf16_t* qp = Qg + gq + ((((size_t)(vb * HQ + hq)) << lsh) + qw + 32 * j + r32) * 64 + 8 * hi;
#pragma unroll
            for (int s = 0; s < 4; ++s) qf[j][s] = *(const bf16x8*)(qp + 16 * s);
        }
        const bf16_t* kbase = Kg + gk + (((size_t)(vb * HKV + kvh)) << lsh) * 64;
        const bf16_t* vbase = Vg + gk + ((((size_t)(vb * HKV + kvh)) * 64) << lsh);
        int lo = 0, hiT = L >> 6;
        if (MODE != 0) { lo = (q0 - WIN) >> 6; if (lo < 0) lo = 0; int h2 = ((q0 + 255 + WIN) >> 6) + 1; if (h2 < hiT) hiT = h2; }
        float slope2 = 0.f;
        if (MODE == 1) slope2 = exp2f(-8.0f * (float)(g * 6 + hq + 1) / 18.0f) * (float)(1 << gsh) * LOG2E;
        if (MODE == 2) slope2 = exp2f(-8.0f * (float)(hq + 1) / 16.0f) * LOG2E;
        float mrun[NQ], lrun[NQ];
        f32x16 oacc[NQ][2];
#pragma unroll
        for (int j = 0; j < NQ; ++j) {
            mrun[j] = NEG_BIG; lrun[j] = 0.f;
            if (MODE == 2) { mrun[j] = sinks[hq] * LOG2E; lrun[j] = (hi == 0) ? 1.f : 0.f; }
#pragma unroll
            for (int i = 0; i < 16; ++i) { oacc[j][0][i] = 0.f; oacc[j][1][i] = 0.f; }
        }
        u32x4 kreg, vreg;
        kreg = *(const u32x4*)(kbase + (size_t)lo * 4096 + tid * 8);
        vreg = *(const u32x4*)(vbase + ((size_t)srow << lsh) + lo * 64 + schunk * 8);
        *(LAS u32x4*)(lds + sdst) = kreg; *(LAS u32x4*)(lds + AT_TILEB + sdst) = vreg;
        __syncthreads();
        for (int kt = lo; kt < hiT; ++kt) {
            const int buf = (kt - lo) & 1;
            const bool more = (kt + 1 < hiT);
            if (more) {
                kreg = *(const u32x4*)(kbase + (size_t)(kt + 1) * 4096 + tid * 8);
                vreg = *(const u32x4*)(vbase + ((size_t)srow << lsh) + (kt + 1) * 64 + schunk * 8);
            }
            bool active = true;
            if (MODE != 0) active = !((64 * kt + 63 < qw - WIN) || (64 * kt > qw + 31 + WIN));
            if (active) {
                const LAS unsigned char* kl = lds + buf * AT_BUFB;
                const LAS unsigned char* vl = kl + AT_TILEB;
                f32x16 sacc[NQ][2];
#pragma unroll
                for (int kb = 0; kb < 2; ++kb) {
#pragma unroll
                    for (int j = 0; j < NQ; ++j)
#pragma unroll
                        for (int i = 0; i < 16; ++i) sacc[j][kb][i] = 0.f;
#pragma unroll
                    for (int s = 0; s < 4; ++s) {
                        const bf16x8 kf = *(const LAS bf16x8*)(kl + (32 * kb + r32) * AT_ROWB + (2 * s + hi) * 16);
#pragma unroll
                        for (int j = 0; j < NQ; ++j) sacc[j][kb] = __builtin_amdgcn_mfma_f32_32x32x16_bf16(kf, qf[j][s], sacc[j][kb], 0, 0, 0);
                    }
                }
                bf16x8 pf[NQ][2][2];
#pragma unroll
                for (int j = 0; j < NQ; ++j) {
                    if (MODE != 0) {
                        const float fd0 = (float)(64 * kt + 4 * hi - (qw + r32));
#pragma unroll
                        for (int kb = 0; kb < 2; ++kb)
#pragma unroll
                            for (int i = 0; i < 16; ++i) {
                                const float dist = fabsf(fd0 + (float)(32 * kb + 8 * (i >> 2) + (i & 3)));
                                sacc[j][kb][i] = (dist <= (float)WIN) ? (sacc[j][kb][i] - slope2 * dist) : NEG_BIG;
                            }
                    }
                    float mx = sacc[j][0][0];
#pragma unroll
                    for (int i = 1; i < 16; ++i) mx = fmaxf(mx, sacc[j][0][i]);
#pragma unroll
                    for (int i = 0; i < 16; ++i) mx = fmaxf(mx, sacc[j][1][i]);
                    mx = fmaxf(mx, __shfl_xor(mx, 32));
                    if (__builtin_amdgcn_ballot_w64(mx > mrun[j]) != 0ull) {
                        const float mnew = fmaxf(mrun[j], mx);
                        const float alpha = __builtin_amdgcn_exp2f(mrun[j] - mnew);
                        mrun[j] = mnew;
                        lrun[j] *= alpha;
#pragma unroll
                        for (int i = 0; i < 16; ++i) { oacc[j][0][i] *= alpha; oacc[j][1][i] *= alpha; }
                    }
                    const float mcur = mrun[j];
                    float ps = 0.f;
#pragma unroll
                    for (int kb = 0; kb < 2; ++kb)
#pragma unroll
                        for (int i = 0; i < 16; ++i) { const float pv = __builtin_amdgcn_exp2f(sacc[j][kb][i] - mcur); sacc[j][kb][i] = pv; ps += pv; }
                    lrun[j] += ps;
#pragma unroll
                    for (int kb = 0; kb < 2; ++kb)
#pragma unroll
                        for (int hh = 0; hh < 2; ++hh) {
                            u32x4 w; w.x = cvtpk_s(sacc[j][kb][8 * hh + 0], sacc[j][kb][8 * hh + 1]); w.y = cvtpk_s(sacc[j][kb][8 * hh + 2], sacc[j][kb][8 * hh + 3]);
                            w.z = cvtpk_s(sacc[j][kb][8 * hh + 4], sacc[j][kb][8 * hh + 5]); w.w = cvtpk_s(sacc[j][kb][8 * hh + 6], sacc[j][kb][8 * hh + 7]);
                            pf[j][kb][hh] = __builtin_bit_cast(bf16x8, w);
                        }
                }
#pragma unroll
                for (int db = 0; db < 2; ++db)
#pragma unroll
                    for (int kb = 0; kb < 2; ++kb)
#pragma unroll
                        for (int hh = 0; hh < 2; ++hh) {
                            const bf16x8 vf = *(const LAS bf16x8*)(vl + (32 * db + r32) * AT_ROWB + (2 * (2 * kb + hh) + hi) * 16);
#pragma unroll
                            for (int j = 0; j < NQ; ++j) oacc[j][db] = __builtin_amdgcn_mfma_f32_32x32x16_bf16(vf, pf[j][kb][hh], oacc[j][db], 0, 0, 0);
                        }
            }
            if (more) {
                LAS unsigned char* nb = lds + (buf ^ 1) * AT_BUFB;
                *(LAS u32x4*)(nb + sdst) = kreg; *(LAS u32x4*)(nb + AT_TILEB + sdst) = vreg;
            }
            __syncthreads();
        }
#pragma unroll
        for (int j = 0; j < NQ; ++j) {
            const float ltot = lrun[j] + __shfl_xor(lrun[j], 32);
            const float inv = 1.0f / ltot;
            int row, hglob;
            if (MODE == 1) { const int dmask = (1 << gsh) - 1; const int b = vb >> gsh, rr = vb & dmask; row = b * SEQ + rr + ((qw + r32) << gsh); hglob = g * 6 + hq; }
            else { row = vb * SEQ + qw + 32 * j + r32; hglob = hq; }
            bf16_t* op = Og + (size_t)row * OPITCH + hglob * 64 + 4 * hi;
#pragma unroll
            for (int db = 0; db < 2; ++db)
#pragma unroll
                for (int q4 = 0; q4 < 4; ++q4) {
                    u32x2 w; w.x = cvtpk_s(oacc[j][db][4 * q4 + 0] * inv, oacc[j][db][4 * q4 + 1] * inv); w.y = cvtpk_s(oacc[j][db][4 * q4 + 2] * inv, oacc[j][db][4 * q4 + 3] * inv);
                    *(u32x2*)(op + 32 * db + 8 * q4) = w;
                }
            if (MODE == 1) { if (hi == 0) LSE[(size_t)row * 18 + hglob] = mrun[j] + __builtin_amdgcn_logf(ltot); }
        }
    }
}

__device__ __forceinline__ void attn_dense_fast(LAS unsigned char* lds, const bf16_t* __restrict__ Qg, const bf16_t* __restrict__ Kg, const bf16_t* __restrict__ Vg, bf16_t* Og) {
    int tid_ = threadIdx.x; asm volatile("" : "+v"(tid_));
    const int tid = tid_, lane = tid & 63, wave = __builtin_amdgcn_readfirstlane(tid >> 6), r32 = lane & 31, hi = lane >> 5;
    constexpr int NQ = 2, NUNITS = 1024, NT = SEQ / 64;
    constexpr int VRING = 2 * AT_TILEB;
    const int srow = tid >> 3, schunk = tid & 7;
    const unsigned sdst = (unsigned)(srow * AT_ROWB + schunk * 16);
    { unsigned z = 0u; asm volatile("" : "+v"(z));
      for (int i = tid; i < 3 * AT_TILEB / 16; i += 512) *(LAS u32x4*)(lds + VRING + i * 16) = (u32x4){z, z, z, z}; }
    __syncthreads();
    for (int un = blockIdx.x; un < NUNITS; un += gridDim.x) {
        const int qb = un & 7, hq = (un >> 3) & 15, vb = un >> 7, kvh = hq >> 2;
        const int qw = qb * 512 + 64 * wave;
        bf16x8 qf[NQ][4];
#pragma unroll
        for (int j = 0; j < NQ; ++j) {
            const bf16_t* qp = Qg + ((size_t)(vb * 16 + hq) * SEQ + qw + 32 * j + r32) * 64 + 8 * hi;
#pragma unroll
            for (int s = 0; s < 4; ++s) qf[j][s] = *(const bf16x8*)(qp + 16 * s);
        }
        const char* kbu = (const char*)(Kg + (size_t)(vb * 4 + kvh) * SEQ * 64);
        const char* vbu = (const char*)(Vg + (size_t)(vb * 4 + kvh) * 64 * SEQ);
        const unsigned kof = (unsigned)tid * 16u, vof = (unsigned)(srow * SEQ + schunk * 8) * 2u;
        float lsum[NQ]; f32x16 oacc[NQ][2]; bf16x8 pfp[NQ][2][2];
#pragma unroll
        for (int j = 0; j < NQ; ++j) {
            lsum[j] = 0.f;
#pragma unroll
            for (int i = 0; i < 16; ++i) { oacc[j][0][i] = 0.f; oacc[j][1][i] = 0.f; }
#pragma unroll
            for (int kb = 0; kb < 2; ++kb)
#pragma unroll
                for (int hh = 0; hh < 2; ++hh) pfp[j][kb][hh] = (bf16x8){0, 0, 0, 0, 0, 0, 0, 0};
        }
        u32x4 kreg = *(const u32x4*)(kbu + kof), vreg = *(const u32x4*)(vbu + vof);
        *(LAS u32x4*)(lds + sdst) = kreg; *(LAS u32x4*)(lds + VRING + sdst) = vreg;
        __syncthreads();
        int vprev = VRING + 2 * AT_TILEB, vcur = VRING, vnext = VRING + AT_TILEB;
        f32x16 sB[NQ];
#pragma unroll
        for (int j = 0; j < NQ; ++j)
#pragma unroll
            for (int i = 0; i < 16; ++i) sB[j][i] = NEG_BIG;
#pragma unroll 1
        for (int kt = 0; kt < NT; ++kt) {
            const int tn = (kt + 1 < NT) ? kt + 1 : kt;
            kreg = *(const u32x4*)(kbu + (size_t)tn * 8192 + kof);
            vreg = *(const u32x4*)(vbu + (size_t)tn * 128 + vof);
            const LAS unsigned char* kl = lds + (kt & 1) * AT_TILEB;
            const LAS unsigned char* vl = lds + vprev;
#define AF_QK(dst, kb) do { _Pragma("unroll") for (int j = 0; j < NQ; ++j) _Pragma("unroll") for (int i = 0; i < 16; ++i) dst[j][i] = 0.f; \
            _Pragma("unroll") for (int s = 0; s < 4; ++s) { const bf16x8 kf = *(const LAS bf16x8*)(kl + (32 * (kb) + r32) * AT_ROWB + (2 * s + hi) * 16); \
                _Pragma("unroll") for (int j = 0; j < NQ; ++j) dst[j] = __builtin_amdgcn_mfma_f32_32x32x16_bf16(kf, qf[j][s], dst[j], 0, 0, 0); } } while (0)
#define AF_PV(kb) do { _Pragma("unroll") for (int hh = 0; hh < 2; ++hh) _Pragma("unroll") for (int db = 0; db < 2; ++db) { \
            const bf16x8 vf = *(const LAS bf16x8*)(vl + (32 * db + r32) * AT_ROWB + (2 * (2 * (kb) + hh) + hi) * 16); \
            _Pragma("unroll") for (int j = 0; j < NQ; ++j) oacc[j][db] = __builtin_amdgcn_mfma_f32_32x32x16_bf16(vf, pfp[j][kb][hh], oacc[j][db], 0, 0, 0); } } while (0)
#define AF_EXP(src, kb) do { _Pragma("unroll") for (int j = 0; j < NQ; ++j) { float ps = 0.f; \
            _Pragma("unroll") for (int i = 0; i < 16; ++i) { const float pv = __builtin_amdgcn_exp2f(src[j][i]); src[j][i] = pv; ps += pv; } \
            lsum[j] += ps; \
            _Pragma("unroll") for (int hh = 0; hh < 2; ++hh) { u32x4 w; w.x = cvtpk_s(src[j][8 * hh + 0], src[j][8 * hh + 1]); w.y = cvtpk_s(src[j][8 * hh + 2], src[j][8 * hh + 3]); \
                w.z = cvtpk_s(src[j][8 * hh + 4], src[j][8 * hh + 5]); w.w = cvtpk_s(src[j][8 * hh + 6], src[j][8 * hh + 7]); pfp[j][kb][hh] = __builtin_bit_cast(bf16x8, w); } } } while (0)
#define AF_SCHED() do { _Pragma("unroll") for (int q_ = 0; q_ < 16; ++q_) { __builtin_amdgcn_sched_group_barrier(0x008, 1, 0); __builtin_amdgcn_sched_group_barrier(0x400, 2, 0); \
            __builtin_amdgcn_sched_group_barrier(0x002, 3, 0); __builtin_amdgcn_sched_group_barrier(0x100, 1, 0); } } while (0)
            f32x16 sA[NQ];
            AF_QK(sA, 0); AF_PV(0); AF_EXP(sB, 1);
            AF_SCHED();
            AF_QK(sB, 1); AF_PV(1); AF_EXP(sA, 0);
            AF_SCHED();
            *(LAS u32x4*)(lds + ((kt + 1) & 1) * AT_TILEB + sdst) = kreg; *(LAS u32x4*)(lds + vnext + sdst) = vreg;
            { const int tmp = vprev; vprev = vcur; vcur = vnext; vnext = tmp; }
            __syncthreads();
        }
        {
            const LAS unsigned char* vl = lds + vprev;
            AF_EXP(sB, 1);
            AF_PV(0); AF_PV(1);
        }
        __syncthreads();
#pragma unroll
        for (int j = 0; j < NQ; ++j) {
            const float ltot = lsum[j] + __shfl_xor(lsum[j], 32);
            const float inv = 1.0f / ltot;
            const int row = vb * SEQ + qw + 32 * j + r32;
            bf16_t* op = Og + (size_t)row * 1024 + hq * 64 + 4 * hi;
#pragma unroll
            for (int db = 0; db < 2; ++db)
#pragma unroll
                for (int q4 = 0; q4 < 4; ++q4) {
                    u32x2 w; w.x = cvtpk_s(oacc[j][db][4 * q4 + 0] * inv, oacc[j][db][4 * q4 + 1] * inv); w.y = cvtpk_s(oacc[j][db][4 * q4 + 2] * inv, oacc[j][db][4 * q4 + 3] * inv);
                    *(u32x2*)(op + 32 * db + 8 * q4) = w;
                }
        }
    }
}

template <int MODE> __device__ __forceinline__ void attn_banded(const bf16_t* __restrict__ Qg, const bf16_t* __restrict__ Kg, const bf16_t* __restrict__ Vg, bf16_t* Og, float* LSE, const float* __restrict__ sinks, int gw, int NGW) {
    int lane = threadIdx.x & 63; asm volatile("" : "+v"(lane));
    const int r32 = lane & 31, hi = lane >> 5;
    constexpr int HQ = (MODE == 1) ? 6 : 16, HKV = (MODE == 1) ? 2 : 4, WIN = (MODE == 1) ? 64 : 128, OPITCH = (MODE == 1) ? 1152 : 1024;
    constexpr int NITEMS = (MODE == 1) ? 3 * 6144 : 16384;
    for (int it = gw; it < NITEMS; it += NGW) {
        int g = 0, vb, hq, qblk;
        if (MODE == 1) { g = it / 6144; const int r = it - g * 6144; const int nqs = 7 - 2 * g;   qblk = r & ((1 << nqs) - 1); const int r2 = r >> nqs; hq = r2 % 6; vb = r2 / 6; }
        else { qblk = it & 127; hq = (it >> 7) & 15; vb = it >> 11; }
        const int gsh = 2 * g, lsh = 12 - gsh, L = 1 << lsh;
        const int kvh = (MODE == 1) ? hq / 3 : hq >> 2;
        const int qw = qblk * 32;
        const size_t gq = (MODE == 1) ? (size_t)g * ((size_t)NBATCH * 6 * SEQ * 64) : 0, gk = (MODE == 1) ? (size_t)g * ((size_t)NBATCH * 2 * SEQ * 64) : 0;
        bf16x8 qf[4];
        { const bf16_t* qp = Qg + gq + ((((size_t)(vb * HQ + hq)) << lsh) + qw + r32) * 64 + 8 * hi;
#pragma unroll
          for (int s = 0; s < 4; ++s) qf[s] = *(const bf16x8*)(qp + 16 * s); }
        const char* kp = (const char*)(Kg + gk + (((size_t)(vb * HKV + kvh)) << lsh) * 64) + lane * 16;
        const char* vp = (const char*)(Vg + gk + ((((size_t)(vb * HKV + kvh)) * 64) << lsh)) + lane * 16;
        int lo = (qw - WIN) >> 6; if (lo < 0) lo = 0;
        int hiT = ((qw + 31 + WIN) >> 6) + 1; if (hiT > (L >> 6)) hiT = L >> 6;
        float slope2;
        if (MODE == 1) slope2 = exp2f(-8.0f * (float)(g * 6 + hq + 1) / 18.0f) * (float)(1 << gsh) * LOG2E;
        else slope2 = exp2f(-8.0f * (float)(hq + 1) / 16.0f) * LOG2E;
        float mrun = NEG_BIG, lrun = 0.f;
        if (MODE == 2) { mrun = sinks[hq] * LOG2E; lrun = (hi == 0) ? 1.f : 0.f; }
        f32x16 oacc[2];
#pragma unroll
        for (int i = 0; i < 16; ++i) { oacc[0][i] = 0.f; oacc[1][i] = 0.f; }
        bf16x8 kf[2][4], vf[2][2][2];
#define AB_LDK(t_) do { const char* b_ = kp + (size_t)(t_) * 8192; _Pragma("unroll") for (int kb = 0; kb < 2; ++kb) _Pragma("unroll") for (int s = 0; s < 4; ++s) kf[kb][s] = *(const bf16x8*)(b_ + kb * 4096 + s * 1024); } while (0)
#define AB_LDV(t_) do { const char* b_ = vp + (size_t)(t_) * 8192; _Pragma("unroll") for (int db = 0; db < 2; ++db) _Pragma("unroll") for (int kb = 0; kb < 2; ++kb) _Pragma("unroll") for (int hh = 0; hh < 2; ++hh) \
            vf[db][kb][hh] = *(const bf16x8*)(b_ + db * 4096 + (2 * kb + hh) * 1024); } while (0)
        AB_LDK(lo); AB_LDV(lo);
#pragma unroll 1
        for (int kt = lo; kt < hiT; ++kt) {
            const int tn = (kt + 1 < hiT) ? kt + 1 : kt;
            f32x16 sacc[2];
#pragma unroll
            for (int kb = 0; kb < 2; ++kb) {
#pragma unroll
                for (int i = 0; i < 16; ++i) sacc[kb][i] = 0.f;
#pragma unroll
                for (int s = 0; s < 4; ++s) sacc[kb] = __builtin_amdgcn_mfma_f32_32x32x16_bf16(kf[kb][s], qf[s], sacc[kb], 0, 0, 0);
            }
            AB_LDK(tn);
            {
                const float fd0 = (float)(64 * kt + 4 * hi - (qw + r32));
#pragma unroll
                for (int kb = 0; kb < 2; ++kb)
#pragma unroll
                    for (int i = 0; i < 16; ++i) {
                        const float dist = fabsf(fd0 + (float)(32 * kb + 8 * (i >> 2) + (i & 3)));
                        sacc[kb][i] = (dist <= (float)WIN) ? (sacc[kb][i] - slope2 * dist) : NEG_BIG;
                    }
            }
            float mx = sacc[0][0];
#pragma unroll
            for (int i = 1; i < 16; ++i) mx = fmaxf(mx, sacc[0][i]);
#pragma unroll
            for (int i = 0; i < 16; ++i) mx = fmaxf(mx, sacc[1][i]);
            mx = fmaxf(mx, __shfl_xor(mx, 32));
            if (__builtin_amdgcn_ballot_w64(mx > mrun) != 0ull) {
                const float mnew = fmaxf(mrun, mx);
                const float alpha = __builtin_amdgcn_exp2f(mrun - mnew);
                mrun = mnew; lrun *= alpha;
#pragma unroll
                for (int i = 0; i < 16; ++i) { oacc[0][i] *= alpha; oacc[1][i] *= alpha; }
            }
            const float mcur = mrun;
            float ps = 0.f;
#pragma unroll
            for (int kb = 0; kb < 2; ++kb)
#pragma unroll
                for (int i = 0; i < 16; ++i) { const float pv = __builtin_amdgcn_exp2f(sacc[kb][i] - mcur); sacc[kb][i] = pv; ps += pv; }
            lrun += ps;
            bf16x8 pf[2][2];
#pragma unroll
            for (int kb = 0; kb < 2; ++kb)
#pragma unroll
                for (int hh = 0; hh < 2; ++hh) {
                    u32x4 w; w.x = cvtpk_s(sacc[kb][8 * hh + 0], sacc[kb][8 * hh + 1]); w.y = cvtpk_s(sacc[kb][8 * hh + 2], sacc[kb][8 * hh + 3]);
                    w.z = cvtpk_s(sacc[kb][8 * hh + 4], sacc[kb][8 * hh + 5]); w.w = cvtpk_s(sacc[kb][8 * hh + 6], sacc[kb][8 * hh + 7]);
                    pf[kb][hh] = __builtin_bit_cast(bf16x8, w);
                }
#pragma unroll
            for (int db = 0; db < 2; ++db)
#pragma unroll
                for (int kb = 0; kb < 2; ++kb)
#pragma unroll
                    for (int hh = 0; hh < 2; ++hh) oacc[db] = __builtin_amdgcn_mfma_f32_32x32x16_bf16(vf[db][kb][hh], pf[kb][hh], oacc[db], 0, 0, 0);
            AB_LDV(tn);
        }
#undef AB_LDK
#undef AB_LDV
        const float ltot = lrun + __shfl_xor(lrun, 32);
        const float inv = 1.0f / ltot;
        int row, hglob;
        if (MODE == 1) { const int dmask = (1 << gsh) - 1; const int b = vb >> gsh, rr = vb & dmask; row = b * SEQ + rr + ((qw + r32) << gsh); hglob = g * 6 + hq; }
        else { row = vb * SEQ + qw + r32; hglob = hq; }
        bf16_t* op = Og + (size_t)row * OPITCH + hglob * 64 + 4 * hi;
#pragma unroll
        for (int db = 0; db < 2; ++db)
#pragma unroll
            for (int q4 = 0; q4 < 4; ++q4) {
                u32x2 w; w.x = cvtpk_s(oacc[db][4 * q4 + 0] * inv, oacc[db][4 * q4 + 1] * inv); w.y = cvtpk_s(oacc[db][4 * q4 + 2] * inv, oacc[db][4 * q4 + 3] * inv);
                *(u32x2*)(op + 32 * db + 8 * q4) = w;
            }
        if (MODE == 1) { if (hi == 0) LSE[(size_t)row * 18 + hglob] = mrun + __builtin_amdgcn_logf(ltot); }
    }
}

__device__ __forceinline__ void mixb_fix(bf16_t* Og, const float* LSE, int gw, int NGW, int lane) {
    asm volatile("" : "+v"(lane));
    for (int m = gw; m < MTOK; m += NGW) {
        const float* ls = LSE + (size_t)m * 18;
#pragma unroll
        for (int c3 = 0; c3 < 3; ++c3) {
            const int c = lane + 64 * c3;
            if (c < 144) {
                const int head = c >> 3, g = head / 6, kr = head - 6 * g;
                const float l0 = ls[kr], l1 = ls[6 + kr], l2 = ls[12 + kr];
                const float mx = fmaxf(l0, fmaxf(l1, l2));
                const float e0 = exp2f(l0 - mx), e1 = exp2f(l1 - mx), e2 = exp2f(l2 - mx);
                const float a = ((g == 0) ? e0 : (g == 1) ? e1 : e2) / (e0 + e1 + e2);
                u32x4* pp = (u32x4*)(Og + (size_t)m * 1152) + c;
                u32x4 w = *pp;
                unsigned ww[4] = {w.x, w.y, w.z, w.w};
#pragma unroll
                for (int k = 0; k < 4; ++k) { const float f0 = __builtin_bit_cast(float, ww[k] << 16) * a, f1 = __builtin_bit_cast(float, ww[k] & 0xffff0000u) * a; ww[k] = cvt_pk_bf16(f0, f1); }
                w.x = ww[0]; w.y = ww[1]; w.z = ww[2]; w.w = ww[3];
                *pp = w;
            }
        }
    }
}

#define XB_TMO      128
#define XB_XCNT(j)  (256  + 64 * (j))
#define XB_XSUB(j)  (1280 + 64 * (j))
#define XB_XGEN(j)  (2304 + 64 * (j))
#define XB_TOP      3328
#define XB_TOPGEN   3392
#define XCD_BAR_WORDS 3456
#define XB_SPIN_CAP (1u << 18)

__device__ __forceinline__ unsigned xb_ld(unsigned* p)              { return __hip_atomic_load(p, __ATOMIC_RELAXED, __HIP_MEMORY_SCOPE_AGENT); }
__device__ __forceinline__ unsigned xb_add(unsigned* p, unsigned v) { return __hip_atomic_fetch_add(p, v, __ATOMIC_RELAXED, __HIP_MEMORY_SCOPE_AGENT); }
__device__ __forceinline__ unsigned xb_xcc_id() { return (unsigned)__builtin_amdgcn_s_getreg((3 << 11) | 20) & 0xFu; }
#define XB_SPIN(cond, bar) do { unsigned _sp = 0; while (cond) { __builtin_amdgcn_s_sleep(1); \
    if ((++_sp & 255u) == 0u) { if (xb_ld(&(bar)[XB_TMO])) break; if (_sp > XB_SPIN_CAP) { atomicAdd(&(bar)[XB_TMO], 1u); break; } } } } while (0)

struct XcdBarrier {
    unsigned* bar; unsigned x;
    volatile LAS unsigned* st;
};

__device__ __forceinline__ XcdBarrier xcd_barrier_post(unsigned* bar, volatile LAS unsigned* st) {
    XcdBarrier b; b.bar = bar; b.x = xb_xcc_id(); b.st = st;
    if (threadIdx.x == 0) (void)xb_add(&bar[XB_XCNT(b.x)], 1u);
    return b;
}
__device__ __forceinline__ void xcd_barrier_complete(unsigned* bar, unsigned x, unsigned& nloc, unsigned& nx) {
    const unsigned G = gridDim.x * gridDim.y * gridDim.z;
    unsigned sum, cnt, mine, sp = 0u;
    for (;;) {
        sum = 0u; cnt = 0u; mine = 0u;
#pragma unroll
        for (unsigned j = 0; j < 16; ++j) { const unsigned c = xb_ld(&bar[XB_XCNT(j)]); sum += c; cnt += (c > 0u) ? 1u : 0u; mine = (j == x) ? c : mine; }
        if (sum == G) break;
        __builtin_amdgcn_s_sleep(1);
        if ((++sp & 255u) == 0u) { if (xb_ld(&bar[XB_TMO])) break; if (sp > XB_SPIN_CAP) { atomicAdd(&bar[XB_TMO], 1u); break; } }
    }
    nloc = mine > 0u ? mine : 1u; nx = cnt > 0u ? cnt : 1u;
}

__device__ __forceinline__ void xcd_barrier(const XcdBarrier& b) {
    asm volatile("s_waitcnt vmcnt(0)" ::: "memory");
    __syncthreads();
    if (threadIdx.x == 0) {
        unsigned* bar = b.bar;
        __builtin_amdgcn_s_waitcnt(0);
        unsigned nloc = b.st[0], nx = b.st[1];
        if (nloc == 0u) { xcd_barrier_complete(bar, b.x, nloc, nx); b.st[0] = nloc; b.st[1] = nx; }
        const unsigned old = xb_add(&bar[XB_XSUB(b.x)], 1u);
        const unsigned gen = old / nloc;
        if (old + 1u == (gen + 1u) * nloc) {
            __builtin_amdgcn_fence(__ATOMIC_RELEASE, "agent");
            asm volatile("s_waitcnt vmcnt(0)" ::: "memory");
            const unsigned og = xb_add(&bar[XB_TOP], 1u);
            const unsigned tg = og / nx;
            if (og + 1u == (tg + 1u) * nx) xb_add(&bar[XB_TOPGEN], 1u);
            else XB_SPIN(xb_ld(&bar[XB_TOPGEN]) == tg, bar);
            __builtin_amdgcn_fence(__ATOMIC_ACQUIRE, "agent");
            xb_add(&bar[XB_XGEN(b.x)], 1u);
            asm volatile("s_waitcnt vmcnt(0)" ::: "memory");
        } else {
            XB_SPIN(xb_ld(&bar[XB_XGEN(b.x)]) == gen, bar);
            __builtin_amdgcn_fence(__ATOMIC_ACQUIRE, "agent");
            asm volatile("s_waitcnt vmcnt(0)" ::: "memory");
        }
    }
    __syncthreads();
}

__device__ __forceinline__ void fill_rstd(LAS unsigned char* lds, const pg8::StaticOrder& S, const float* ssp) {
    LAS float* rs = (LAS float*)(lds + LDS_RSTD);
    int tid = threadIdx.x; asm volatile("" : "+v"(tid));
    for (int i0 = 0; i0 < 8; i0 += 2) {
        pg8::Unit u; const int i = i0 + (tid >> 8);
        if (S.next(i, u)) rs[i * 256 + (tid & 255)] = __builtin_amdgcn_rsqf(row_ss(ssp, u.pm * 256 + (tid & 255)) * (1.0f / DM) + RMS_EPS);
    }
    __syncthreads();
}

__global__ void __launch_bounds__(512, 2) fwd_kernel(Params p) {
    extern __shared__ __attribute__((aligned(16))) unsigned char lds_raw[];
    LAS unsigned char* lds = (LAS unsigned char*)lds_raw;
    cg::grid_group grid = cg::this_grid();
    volatile LAS unsigned* xst = (volatile LAS unsigned*)(lds + LDS_BYTES - 64);
    if (threadIdx.x < 2) xst[threadIdx.x] = 0u;
    __syncthreads();
    XcdBarrier xbar = xcd_barrier_post((unsigned*)(p.ws + WS_BAR), xst);
    {
        LAS float* rope = (LAS float*)(lds + LDS_ROPE); LAS float* gl = (LAS float*)(lds + LDS_GAIN);
        for (int i = threadIdx.x; i < 1024; i += 512) { const int pos = i >> 4, f = i & 15; const float ang = (float)pos * exp2f(-(float)f * 0.83048202372184059f); rope[2 * i] = cosf(ang); rope[2 * i + 1] = sinf(ang); }
        if (threadIdx.x < 256) { const int i = threadIdx.x, ja = i >> 7, qk = (i >> 6) & 1, d = i & 63; gl[i] = (qk == 0 ? p.in[4] : p.in[5])[ja * 64 + d]; }
    }
#define GRID_SYNC() do { asm volatile("s_waitcnt vmcnt(0) lgkmcnt(0)" ::: "memory"); grid.sync(); asm volatile("buffer_inv sc1\n\ts_waitcnt vmcnt(0)" ::: "memory"); GRID_SYNC2(); } while (0)
#define XBAR_SYNC() do { xcd_barrier(xbar); } while (0)
#ifdef PROBE_DUP_SYNC
#define GRID_SYNC2() do { grid.sync(); asm volatile("buffer_inv sc1\n\ts_waitcnt vmcnt(0)" ::: "memory"); } while (0)
#else
#define GRID_SYNC2() do { } while (0)
#endif
    const int wave = __builtin_amdgcn_readfirstlane((int)threadIdx.x >> 6);
#define LANE() ({ int l_ = (int)threadIdx.x & 63; asm volatile("" : "+v"(l_)); l_; })
    const int G = gridDim.x, gw = blockIdx.x * 8 + wave, NGW = G * 8;
    unsigned char* ws = p.ws;
#define GAS __attribute__((address_space(1)))
#define WSP() ({ GAS unsigned char* q_ = (GAS unsigned char*)ws; asm volatile("" : "+s"(q_)); (unsigned char*)q_; })
#define SSP(i) ((float*)(WSP() + WS_SSP) + (size_t)(i) * MTOK * 16)
#define LSE_ ((float*)(WSP() + WS_LSE))
#define WB_ ((bf16_t*)(WSP() + WS_W))
#define HB_ ((bf16_t*)(WSP() + WS_HB))
#define U_ ((bf16_t*)(WSP() + WS_U))
#define Qb_ ((bf16_t*)(WSP() + WS_Q))
#define Kb_ ((bf16_t*)(WSP() + WS_K))
#define Vb_ ((bf16_t*)(WSP() + WS_VT))
#define Ob_ ((bf16_t*)(WSP() + WS_O))
    float* h = p.out;

#ifndef PHMASK
#define PHMASK 0xffff
#endif
    if (PHMASK & 1) prologue(p, lds, gw, NGW, wave, LANE());
#ifdef PROBE_DUP_PRO
    __syncthreads(); prologue(p, lds, gw, NGW, wave, LANE());
#endif
    GRID_SYNC();

#pragma unroll 1
    for (int layer = 0; layer < 4; ++layer) {
        const int kind = (layer == 3) ? 0 : layer;
        const int ja = (layer == 3) ? 1 : 0;
        const size_t weq = (layer == 0) ? WE_QKV0 : (layer == 1) ? WE_QKV1 : (layer == 2) ? WE_QKV2 : WE_QKV3;
        const size_t weo = (layer == 0) ? WE_WO0 : (layer == 1) ? WE_WO1 : (layer == 2) ? WE_WO2 : WE_WO3;
        if (kind == 0 && (PHMASK & 2)) {
            pg8::Gemm g{HB_, WB_ + weq, MTOK, 1536, DM}; pg8::StaticOrder S; S.init(MTOK, 1536, G, (int)blockIdx.x);
            fill_rstd(lds, S, SSP(2 * layer));
            pg8::EpiQKV<0> E{WSP(), lds, ja, 0};
            pg8::gemm_phase<pg8::EpiQKV<0>, pg8::StaticOrder, true, true>(lds, g, S, E);
        } else if (kind == 1 && (PHMASK & 4)) {
            pg8::Gemm g{HB_, WB_ + weq, MTOK, 2048, DM}; pg8::StaticOrder S; S.init(MTOK, 2048, G, (int)blockIdx.x);
            fill_rstd(lds, S, SSP(2 * layer));
            pg8::EpiQKV<1> E{WSP(), lds, 0, 0};
            pg8::gemm_phase<pg8::EpiQKV<1>, pg8::StaticOrder, true, true>(lds, g, S, E);
        } else if (kind == 2 && (PHMASK & 8)) {
            pg8::Gemm g{HB_, WB_ + weq, MTOK, 1536, DM}; pg8::StaticOrder S; S.init(MTOK, 1536, G, (int)blockIdx.x);
            fill_rstd(lds, S, SSP(2 * layer));
            pg8::EpiQKV<2> E{WSP(), lds, 0, 0};
            pg8::gemm_phase<pg8::EpiQKV<2>, pg8::StaticOrder, true, true>(lds, g, S, E);
        }
        XBAR_SYNC();
        if (kind == 0) {
            const LAS float* gl = (const LAS float*)(lds + LDS_GAIN) + ja * 128;
            int lane3 = threadIdx.x & 63; asm volatile("" : "+v"(lane3));
            float gq = fabsf(gl[lane3]), gk = fabsf(gl[64 + lane3]);
#pragma unroll
            for (int o = 1; o < 64; o <<= 1) { gq = fmaxf(gq, __shfl_xor(gq, o)); gk = fmaxf(gk, __shfl_xor(gk, o)); }
            const bool fastp = __builtin_amdgcn_readfirstlane((QSCALE * 64.0f * gq * gk <= 60.0f) ? 1 : 0) != 0;
            if (fastp) { if (PHMASK & 16) attn_dense_fast(lds, Qb_, Kb_, Vb_, Ob_); }
            else if (PHMASK & 16) attn_phase<0>(lds, Qb_, Kb_, Vb_, Ob_, LSE_, nullptr);
#ifdef PROBE_DUP_A
            __syncthreads(); attn_phase<0>(lds, Qb_, Kb_, Vb_, Ob_, LSE_, nullptr);
#endif
        }
        else if (kind == 1) { if (PHMASK & 32) attn_banded<1>(Qb_, Kb_, Vb_, Ob_, LSE_, nullptr, gw, NGW);
#ifdef PROBE_DUP_BC
            __syncthreads(); attn_phase<1>(lds, Qb_, Kb_, Vb_, Ob_, LSE_, nullptr);
#endif
            XBAR_SYNC(); mixb_fix(Ob_, LSE_, gw, NGW, LANE()); }
        else { if (PHMASK & 64) attn_banded<2>(Qb_, Kb_, Vb_, Ob_, LSE_, p.in[10], gw, NGW);
#ifdef PROBE_DUP_BC
            __syncthreads(); attn_phase<2>(lds, Qb_, Kb_, Vb_, Ob_, LSE_, p.in[10]);
#endif
        }
        XBAR_SYNC();
        if (PHMASK & 128) {
            const int Ko = (kind == 1) ? 1152 : 1024;
            pg8::Gemm g{Ob_, WB_ + weo, MTOK, DM, Ko}; pg8::StaticOrder S; S.init(MTOK, DM, G, (int)blockIdx.x);
            pg8::EpiRes E{HB_, SSP(2 * layer + 1)};
            pg8::gemm_phase<pg8::EpiRes, pg8::StaticOrder, true, true>(lds, g, S, E);
        }
        XBAR_SYNC();
        if (PHMASK & 256) {
            pg8::Gemm g{HB_, WB_ + WE_W1 + (size_t)layer * 4096 * 1024, MTOK, DFF, DM}; pg8::StaticOrder S; S.init(MTOK, DFF, G, (int)blockIdx.x);
            fill_rstd(lds, S, SSP(2 * layer + 1));
            pg8::EpiMlp1 E{lds, U_, 0};
            pg8::gemm_phase<pg8::EpiMlp1, pg8::StaticOrder, true, true>(lds, g, S, E);
#ifdef PROBE_DUP_MLP1
            __syncthreads(); pg8::gemm_phase<pg8::EpiMlp1, pg8::StaticOrder, true, true>(lds, g, S, E);
#endif
        }
        XBAR_SYNC();
        if (PHMASK & 512) {
            pg8::Gemm g{U_, WB_ + WE_W2 + (size_t)layer * 4096 * 1024, MTOK, DM, DFF}; pg8::StaticOrder S; S.init(MTOK, DM, G, (int)blockIdx.x);
            pg8::EpiRes E{HB_, SSP(2 * layer + 2)};
            pg8::gemm_phase<pg8::EpiRes, pg8::StaticOrder, true, true>(lds, g, S, E);
        }
        XBAR_SYNC();
    }
    {
        const float* fg = p.in[14]; const float* ss8 = SSP(8); const bf16_t* hbf = HB_;
        const int lane2 = LANE();
        f32x4 gg[4];
#pragma unroll
        for (int j = 0; j < 4; ++j) gg[j] = ((const f32x4*)fg)[4 * lane2 + j];
        for (int m = gw; m < MTOK; m += NGW) {
            const float rstd = __builtin_amdgcn_rsqf(row_ss(ss8, m) * (1.0f / DM) + RMS_EPS);
            const u32x4* hr = (const u32x4*)(hbf + (size_t)m * DM) + 2 * lane2;
            const u32x4 w0 = hr[0], w1 = hr[1];
            const unsigned ww[8] = {w0.x, w0.y, w0.z, w0.w, w1.x, w1.y, w1.z, w1.w};
            f32x4* orow = (f32x4*)(h + (size_t)m * DM) + 4 * lane2;
#pragma unroll
            for (int j = 0; j < 4; ++j) {
                f32x4 v;
                v[0] = __builtin_bit_cast(float, ww[2 * j] << 16); v[1] = __builtin_bit_cast(float, ww[2 * j] & 0xffff0000u);
                v[2] = __builtin_bit_cast(float, ww[2 * j + 1] << 16); v[3] = __builtin_bit_cast(float, ww[2 * j + 1] & 0xffff0000u);
                orow[j] = v * rstd * gg[j];
            }
        }
    }
}

extern "C" void kernel_launch(void* const* d_in, const int* in_sizes, int n_in, void* d_out, int out_size, void* d_ws, size_t ws_size, hipStream_t stream) {
    static int grid = 0;
    if (grid == 0) {
        if (n_in != 15 || out_size != MTOK * DM || ws_size < WS_END) { fprintf(stderr, "kernel_launch: unexpected shapes (n_in %d out %d ws %zu)\n", n_in, out_size, ws_size); grid = -1; return; }
        int dev = 0, cus = 0, per_cu = 0;
        hipGetDevice(&dev);
        hipDeviceGetAttribute(&cus, hipDeviceAttributeMultiprocessorCount, dev);
        if (hipFuncSetAttribute((const void*)fwd_kernel, hipFuncAttributeMaxDynamicSharedMemorySize, LDS_BYTES) != hipSuccess) { fprintf(stderr, "kernel_launch: hipFuncSetAttribute failed\n"); grid = -1; return; }
        if (hipOccupancyMaxActiveBlocksPerMultiprocessor(&per_cu, (const void*)fwd_kernel, 512, LDS_BYTES) != hipSuccess || per_cu < 1) { fprintf(stderr, "kernel_launch: occupancy query gave %d\n", per_cu); per_cu = 1; }
        (void)hipGetLastError();
        grid = cus * per_cu;
    }
    if (grid < 0) return;
    if (hipMemsetAsync((char*)d_ws + WS_BAR, 0, 16384, stream) != hipSuccess) { fprintf(stderr, "kernel_launch: hipMemsetAsync failed\n"); return; }
    Params p{};
    for (int i = 0; i < 15; ++i) p.in[i] = (const float*)d_in[i];
    p.out = (float*)d_out; p.ws = (unsigned char*)d_ws;
    void* args[] = {&p};
    hipError_t e = hipLaunchCooperativeKernel((const void*)fwd_kernel, dim3(grid), dim3(512), args, LDS_BYTES, stream);
    if (e != hipSuccess) fprintf(stderr, "cooperative launch failed: %s (grid %d)\n", hipGetErrorString(e), grid);
}
```
